# Optimizing an MI355X kernel written in HIP

```python
import jax, jax.numpy as jnp
from jax import lax
import numpy as np

D_MODEL = 1024
BATCH = 8
SEQ = 2048
DEPTH = 1
DEC_BATCH = 128
DEC_SEQ = 8
PAST_LEN = 16384
PAGE_SIZE = 128

N_MEM = 256
GLA_HEADS = 4
GLA_DK = D_MODEL // 2 // GLA_HEADS
GLA_DV = D_MODEL // GLA_HEADS
GLA_QK = GLA_HEADS * GLA_DK
GLA_V = GLA_HEADS * GLA_DV
GLA_GATE_RANK = 16
GLA_TAU = 16.0
RET_HEADS = 4
RET_DK = D_MODEL // 2 // RET_HEADS
RET_DV = D_MODEL // RET_HEADS
RET_QK = RET_HEADS * RET_DK
RET_V = RET_HEADS * RET_DV
XA_HEADS = 4
XA_DH = D_MODEL // XA_HEADS
D_FF = 4 * D_MODEL
CHUNK = 64
ROPE_BASE = 10000.0
EPS = 1e-6
IN_WIDTHS = (GLA_QK, GLA_QK, GLA_V, GLA_V, GLA_GATE_RANK, RET_QK, RET_QK, RET_V, RET_V, D_MODEL, D_MODEL)
N_IN = 2 * GLA_QK + 2 * GLA_V + GLA_GATE_RANK + 2 * RET_QK + 2 * RET_V + 2 * D_MODEL

kernel_name = "gla_retnet_parallel_memxattn_decoder_step"


def rmsnorm(x, g):
    xf = x.astype(jnp.float32)
    y = xf * lax.rsqrt(jnp.mean(xf * xf, axis=-1, keepdims=True) + EPS)
    return (y * g.astype(jnp.float32)).astype(x.dtype)


def groupnorm(x, g):
    xf = x.astype(jnp.float32)
    mu = jnp.mean(xf, axis=-1, keepdims=True)
    xc = xf - mu
    y = xc * lax.rsqrt(jnp.mean(xc * xc, axis=-1, keepdims=True) + EPS)
    return (y * g.astype(jnp.float32)).astype(x.dtype)


def rotary(x, pos):
    half = x.shape[-1] // 2
    inv = ROPE_BASE ** (-jnp.arange(half, dtype=jnp.float32) / half)
    ang = pos.astype(jnp.float32)[:, None] * inv[None, :]
    cos = jnp.cos(ang)[None, :, None, :]
    sin = jnp.sin(ang)[None, :, None, :]
    xf = x.astype(jnp.float32)
    x1, x2 = xf[..., :half], xf[..., half:]
    return jnp.concatenate([x1 * cos - x2 * sin, x1 * sin + x2 * cos], axis=-1).astype(x.dtype)


def chunked_decay_linear_attn(q, k, v, log_a, s0):
    B, H, L, dk = q.shape
    c = min(CHUNK, L)
    n = -(-L // c)
    pad = n * c - L

    def prep(t):
        t = t.astype(jnp.float32)
        t = jnp.pad(t, ((0, 0), (0, 0), (0, pad), (0, 0)))
        t = t.reshape(B, H, n, c, t.shape[-1])
        return jnp.moveaxis(t, 2, 0)

    qs, ks, vs, as_ = prep(q), prep(k), prep(v), prep(log_a)
    mask = jnp.tril(jnp.ones((c, c), dtype=bool))

    def step(S, inp):
        qc, kc, vc, ac = inp
        b = jnp.cumsum(ac, axis=2)
        qe = qc * jnp.exp(b)
        ke = kc * jnp.exp(-b)
        scores = jnp.where(mask, jnp.einsum('bhtd,bhsd->bhts', qe, ke), 0.0)
        o = jnp.einsum('bhts,bhsv->bhtv', scores, vc) + jnp.einsum('bhtd,bhdv->bhtv', qe, S)
        b_last = b[:, :, -1:, :]
        kd = kc * jnp.exp(b_last - b)
        S_new = jnp.exp(b_last)[:, :, 0, :, None] * S + jnp.einsum('bhsd,bhsv->bhdv', kd, vc)
        return S_new, o

    S_fin, os_ = lax.scan(step, s0.astype(jnp.float32), (qs, ks, vs, as_))
    o = jnp.moveaxis(os_, 0, 2).reshape(B, H, n * c, -1)[:, :, :L]
    return o, S_fin.astype(s0.dtype)


def memory_kv(mem, g_mem, w_xk, w_xv):
    B = mem.shape[0]
    m = rmsnorm(mem, g_mem)
    k = (m @ w_xk).reshape(B, N_MEM, XA_HEADS, XA_DH)
    v = (m @ w_xv).reshape(B, N_MEM, XA_HEADS, XA_DH)
    return k, v


def mixer_block(h, pos, s_gla, s_ret, w_in, w_gla_a2, b_gla_a, g_gla_head, g_ret_head, w_mix_out):
    B, L, _ = h.shape
    z = h @ w_in
    (gq, gk, gv, gr, ga_low, rq, rk, rv, rg, gate_a, gate_b) = jnp.split(
        z, [int(s) for s in np.cumsum(IN_WIDTHS)[:-1]], axis=-1)

    def to_heads(t, H):
        return t.reshape(B, L, H, -1).transpose(0, 2, 1, 3)

    log_alpha = jax.nn.log_sigmoid((ga_low @ w_gla_a2 + b_gla_a).astype(jnp.float32)) / GLA_TAU
    o_g, s_gla_new = chunked_decay_linear_attn(
        to_heads(gq, GLA_HEADS) * (GLA_DK ** -0.5), to_heads(gk, GLA_HEADS), to_heads(gv, GLA_HEADS),
        to_heads(log_alpha, GLA_HEADS), s_gla)
    o_g = rmsnorm(o_g.transpose(0, 2, 1, 3).astype(h.dtype), g_gla_head).reshape(B, L, GLA_V)
    o_g = o_g * jax.nn.silu(gr)

    rq_h = rotary(rq.reshape(B, L, RET_HEADS, RET_DK), pos).transpose(0, 2, 1, 3)
    rk_h = rotary(rk.reshape(B, L, RET_HEADS, RET_DK), pos).transpose(0, 2, 1, 3) * (RET_DK ** -0.5)
    log_gamma = jnp.log1p(-jnp.exp2(-5.0 - jnp.arange(RET_HEADS, dtype=jnp.float32)))
    log_dec = jnp.broadcast_to(log_gamma[None, :, None, None], (B, RET_HEADS, L, 1))
    o_r, s_ret_new = chunked_decay_linear_attn(rq_h, rk_h, to_heads(rv, RET_HEADS), log_dec, s_ret)
    o_r = groupnorm(o_r.transpose(0, 2, 1, 3).astype(h.dtype), g_ret_head).reshape(B, L, RET_V)
    o_r = o_r * jax.nn.silu(rg)

    merged = jax.nn.sigmoid(gate_a) * o_g + jax.nn.sigmoid(gate_b) * o_r
    return merged @ w_mix_out, s_gla_new, s_ret_new


def cross_attn(h, mem_k, mem_v, w_xq, w_xo):
    B, L, _ = h.shape
    q = (h @ w_xq).reshape(B, L, XA_HEADS, XA_DH)
    s = jnp.einsum('blhd,bmhd->bhlm', q, mem_k).astype(jnp.float32) * (XA_DH ** -0.5)
    p = jax.nn.softmax(s, axis=-1).astype(h.dtype)
    o = jnp.einsum('bhlm,bmhd->blhd', p, mem_v).reshape(B, L, D_MODEL)
    return o @ w_xo


def layer(x, pos, s_gla, s_ret, mem_k, mem_v, w_in, w_gla_a2, b_gla_a, g_gla_head, g_ret_head, w_mix_out,
          w_xq, w_xo, w_up, w_down, g_pre_mix, g_post_mix, g_pre_xa, g_post_xa, g_pre_ffn, g_post_ffn):
    m, s_gla_new, s_ret_new = mixer_block(rmsnorm(x, g_pre_mix), pos, s_gla, s_ret, w_in, w_gla_a2, b_gla_a,
                                          g_gla_head, g_ret_head, w_mix_out)
    x = x + rmsnorm(m, g_post_mix)
    x = x + rmsnorm(cross_attn(rmsnorm(x, g_pre_xa), mem_k, mem_v, w_xq, w_xo), g_post_xa)
    hf = rmsnorm(x, g_pre_ffn)
    x = x + rmsnorm(jnp.square(jax.nn.relu(hf @ w_up)) @ w_down, g_post_ffn)
    return x, s_gla_new, s_ret_new


def setup_inputs(seed: int = 0) -> dict:
    key = jax.random.key(seed)
    ks = jax.random.split(key, 32)
    f32 = jnp.float32

    def w(k, shape, fan_in):
        return jax.random.normal(k, shape, f32) * (fan_in ** -0.5)

    def gain(k, shape):
        return 1.0 + 0.01 * jax.random.normal(k, shape, f32)

    return {
        "x_prompt": jax.random.normal(ks[0], (BATCH, SEQ, D_MODEL), f32),
        "x_sample": jax.random.normal(ks[1], (DEC_BATCH, DEC_SEQ, D_MODEL), f32),
        "state_gla": 0.1 * jax.random.normal(ks[2], (DEPTH, DEC_BATCH, GLA_HEADS, GLA_DK, GLA_DV), f32),
        "state_ret": 0.1 * jax.random.normal(ks[3], (DEPTH, DEC_BATCH, RET_HEADS, RET_DK, RET_DV), f32),
        "cache_mem_k": jax.random.normal(ks[4], (DEPTH, DEC_BATCH, N_MEM, XA_HEADS, XA_DH), f32),
        "cache_mem_v": jax.random.normal(ks[5], (DEPTH, DEC_BATCH, N_MEM, XA_HEADS, XA_DH), f32),
        "mem_prompt": jax.random.normal(ks[6], (BATCH, N_MEM, D_MODEL), f32),
        "w_in": w(ks[7], (DEPTH, D_MODEL, N_IN), D_MODEL),
        "w_gla_a2": w(ks[8], (DEPTH, GLA_GATE_RANK, GLA_QK), GLA_GATE_RANK),
        "b_gla_a": 0.01 * jax.random.normal(ks[9], (DEPTH, GLA_QK), f32),
        "g_gla_head": gain(ks[10], (DEPTH, GLA_HEADS, GLA_DV)),
        "g_ret_head": gain(ks[11], (DEPTH, RET_HEADS, RET_DV)),
        "w_mix_out": w(ks[12], (DEPTH, D_MODEL, D_MODEL), D_MODEL),
        "w_xq": w(ks[13], (DEPTH, D_MODEL, D_MODEL), D_MODEL),
        "w_xk": w(ks[14], (DEPTH, D_MODEL, D_MODEL), D_MODEL),
        "w_xv": w(ks[15], (DEPTH, D_MODEL, D_MODEL), D_MODEL),
        "w_xo": w(ks[16], (DEPTH, D_MODEL, D_MODEL), D_MODEL),
        "g_mem": gain(ks[17], (DEPTH, D_MODEL)),
        "w_up": w(ks[18], (DEPTH, D_MODEL, D_FF), D_MODEL),
        "w_down": w(ks[19], (DEPTH, D_FF, D_MODEL), D_FF),
        "g_pre_mix": gain(ks[20], (DEPTH, D_MODEL)),
        "g_post_mix": gain(ks[21], (DEPTH, D_MODEL)),
        "g_pre_xa": gain(ks[22], (DEPTH, D_MODEL)),
        "g_post_xa": gain(ks[23], (DEPTH, D_MODEL)),
        "g_pre_ffn": gain(ks[24], (DEPTH, D_MODEL)),
        "g_post_ffn": gain(ks[25], (DEPTH, D_MODEL)),
    }


def reference(x_prompt, x_sample, state_gla, state_ret, cache_mem_k, cache_mem_v, mem_prompt,
              w_in, w_gla_a2, b_gla_a, g_gla_head, g_ret_head, w_mix_out,
              w_xq, w_xk, w_xv, w_xo, g_mem, w_up, w_down,
              g_pre_mix, g_post_mix, g_pre_xa, g_post_xa, g_pre_ffn, g_post_ffn):
    Bp, Lp, _ = x_prompt.shape
    pos_p = jnp.arange(Lp, dtype=jnp.int32)
    pos_s = PAST_LEN + jnp.arange(x_sample.shape[1], dtype=jnp.int32)
    zero_gla = jnp.zeros((Bp, GLA_HEADS, GLA_DK, GLA_DV), jnp.float32)
    zero_ret = jnp.zeros((Bp, RET_HEADS, RET_DK, RET_DV), jnp.float32)

    yp, ys = x_prompt, x_sample
    gla_p, ret_p, mk_p, mv_p, gla_s, ret_s = [], [], [], [], [], []
    for l in range(DEPTH):
        shared = (w_in[l], w_gla_a2[l], b_gla_a[l], g_gla_head[l], g_ret_head[l], w_mix_out[l],
                  w_xq[l], w_xo[l], w_up[l], w_down[l],
                  g_pre_mix[l], g_post_mix[l], g_pre_xa[l], g_post_xa[l], g_pre_ffn[l], g_post_ffn[l])
        mk, mv = memory_kv(mem_prompt, g_mem[l], w_xk[l], w_xv[l])
        yp, sg, sr = layer(yp, pos_p, zero_gla, zero_ret, mk, mv, *shared)
        gla_p.append(sg); ret_p.append(sr); mk_p.append(mk); mv_p.append(mv)
        ys, sg2, sr2 = layer(ys, pos_s, state_gla[l], state_ret[l], cache_mem_k[l], cache_mem_v[l], *shared)
        gla_s.append(sg2); ret_s.append(sr2)

    new_state_gla_prompt = jnp.stack(gla_p)
    new_state_ret_prompt = jnp.stack(ret_p)
    new_cache_mem_k_prompt = jnp.stack(mk_p)
    new_cache_mem_v_prompt = jnp.stack(mv_p)
    new_state_gla_sample = jnp.stack(gla_s)
    new_state_ret_sample = jnp.stack(ret_s)
    return (yp, ys, new_state_gla_prompt, new_state_ret_prompt, new_cache_mem_k_prompt, new_cache_mem_v_prompt,
            new_state_gla_sample, new_state_ret_sample)
```

```cpp
#include <hip/hip_runtime.h>
#include <cstdio>
#include <cstdint>

namespace nv {
constexpr int D = 1024, NP = 16384, NS = 1024, NT = NP + NS, NIN = 8208, NMEMROWS = 2048;
constexpr size_t O_YP = 0, O_YS = 16777216, O_SGP = 17825792, O_SRP = 18874368, O_MK = 19922944, O_MV = 22020096, O_SGS = 24117248, O_SRS = 40894464, O_END = 57671680;

__device__ __forceinline__ float block_sum256(float v, float* red) {
#pragma unroll
    for (int o = 32; o >= 1; o >>= 1) v += __shfl_xor(v, o);
    __syncthreads();
    if ((threadIdx.x & 63) == 0) red[threadIdx.x >> 6] = v;
    __syncthreads();
    return (red[0] + red[1]) + (red[2] + red[3]);
}

__global__ __launch_bounds__(256) void rms_rows(const float* xp, const float* xs, const float* g, float* out) {
    __shared__ float red[8];
    const int r = blockIdx.x;
    const float* x = (xs && r >= NP) ? xs + (size_t)(r - NP) * D : xp + (size_t)r * D;
    const float4 v = ((const float4*)x)[threadIdx.x];
    const float s = block_sum256(v.x * v.x + v.y * v.y + v.z * v.z + v.w * v.w, red);
    const float rs = rsqrtf(s * (1.0f / D) + 1e-6f);
    const float4 gg = ((const float4*)g)[threadIdx.x];
    float4 o; o.x = v.x * rs * gg.x; o.y = v.y * rs * gg.y; o.z = v.z * rs * gg.z; o.w = v.w * rs * gg.w;
    ((float4*)(out + (size_t)r * D))[threadIdx.x] = o;
}

__global__ __launch_bounds__(256) void res_norm(const float* xop, const float* xos, const float* t, const float* g1, float* xnew, const float* g2, float* hn) {
    __shared__ float red[8];
    const int r = blockIdx.x;
    const float* xo = (xos && r >= NP) ? xos + (size_t)(r - NP) * D : xop + (size_t)r * D;
    const float4 tv = ((const float4*)(t + (size_t)r * D))[threadIdx.x];
    const float s = block_sum256(tv.x * tv.x + tv.y * tv.y + tv.z * tv.z + tv.w * tv.w, red);
    const float rs = rsqrtf(s * (1.0f / D) + 1e-6f);
    const float4 g = ((const float4*)g1)[threadIdx.x];
    const float4 xv = ((const float4*)xo)[threadIdx.x];
    float4 y; y.x = xv.x + tv.x * rs * g.x; y.y = xv.y + tv.y * rs * g.y; y.z = xv.z + tv.z * rs * g.z; y.w = xv.w + tv.w * rs * g.w;
    ((float4*)(xnew + (size_t)r * D))[threadIdx.x] = y;
    if (hn) {
        const float s2 = block_sum256(y.x * y.x + y.y * y.y + y.z * y.z + y.w * y.w, red);
        const float rs2 = rsqrtf(s2 * (1.0f / D) + 1e-6f);
        const float4 gb = ((const float4*)g2)[threadIdx.x];
        float4 o; o.x = y.x * rs2 * gb.x; o.y = y.y * rs2 * gb.y; o.z = y.z * rs2 * gb.z; o.w = y.w * rs2 * gb.w;
        ((float4*)(hn + (size_t)r * D))[threadIdx.x] = o;
    }
}

template <int ACT>
__global__ __launch_bounds__(256) void gemm_nn(const float* __restrict__ A, int lda, const float* __restrict__ B, int ldb, float* __restrict__ C, int ldc, int M, int N, int K) {
    __shared__ float As[16][68], Bs[16][68];
    const int tid = threadIdx.x, tx = tid & 15, ty = tid >> 4;
    const int m0 = blockIdx.y * 64, n0 = blockIdx.x * 64;
    float acc[4][4];
#pragma unroll
    for (int i = 0; i < 4; ++i)
#pragma unroll
        for (int j = 0; j < 4; ++j) acc[i][j] = 0.f;
    const int ar = tid >> 2, ak = (tid & 3) * 4;
    const int bk = tid >> 4, bn = (tid & 15) * 4;
    const bool bok = (n0 + bn) < N;
    for (int k0 = 0; k0 < K; k0 += 16) {
        const float4 av = *(const float4*)(A + (size_t)(m0 + ar) * lda + k0 + ak);
        float4 bv = make_float4(0.f, 0.f, 0.f, 0.f);
        if (bok) bv = *(const float4*)(B + (size_t)(k0 + bk) * ldb + n0 + bn);
        __syncthreads();
        As[ak + 0][ar] = av.x; As[ak + 1][ar] = av.y; As[ak + 2][ar] = av.z; As[ak + 3][ar] = av.w;
        *(float4*)&Bs[bk][bn] = bv;
        __syncthreads();
#pragma unroll
        for (int kk = 0; kk < 16; ++kk) {
            const float4 a = *(const float4*)&As[kk][ty * 4];
            const float4 b = *(const float4*)&Bs[kk][tx * 4];
            const float aa[4] = {a.x, a.y, a.z, a.w}, bb[4] = {b.x, b.y, b.z, b.w};
#pragma unroll
            for (int i = 0; i < 4; ++i)
#pragma unroll
                for (int j = 0; j < 4; ++j) acc[i][j] += aa[i] * bb[j];
        }
    }
    if ((n0 + tx * 4) < N) {
#pragma unroll
        for (int i = 0; i < 4; ++i) {
            float4 o = make_float4(acc[i][0], acc[i][1], acc[i][2], acc[i][3]);
            if (ACT == 1) { o.x = o.x > 0.f ? o.x * o.x : 0.f; o.y = o.y > 0.f ? o.y * o.y : 0.f; o.z = o.z > 0.f ? o.z * o.z : 0.f; o.w = o.w > 0.f ? o.w * o.w : 0.f; }
            *(float4*)(C + (size_t)(m0 + ty * 4 + i) * ldc + n0 + tx * 4) = o;
        }
    }
}

template <int BR>
__global__ __launch_bounds__(256) void linattn_naive(const float* __restrict__ zb, int ldz, int cq, int ck, int cv, int ca, const float* __restrict__ w2, const float* __restrict__ bb,
                                                     const float* __restrict__ s0, float* __restrict__ s_out, float* __restrict__ o_out, int row0, int L, int pos0) {
    __shared__ __attribute__((aligned(16))) float sq[128], sk[128], sa[128];
    const int b = blockIdx.x >> 2, h = blockIdx.x & 3, n = threadIdx.x;
    float S[128];
#pragma unroll
    for (int d = 0; d < 128; ++d) S[d] = s0 ? s0[((size_t)(b * 4 + h) * 128 + d) * 256 + n] : 0.f;
    const float scale = 0.08838834764831845f;
    for (int t = 0; t < L; ++t) {
        const size_t row = (size_t)row0 + (size_t)b * L + t;
        const float* zr = zb + row * ldz;
        if (n < 128) {
            const int d = n;
            float q, k, a;
            if (BR == 0) {
                q = zr[cq + h * 128 + d] * scale; k = zr[ck + h * 128 + d];
                float x = bb[h * 128 + d];
#pragma unroll
                for (int r = 0; r < 16; ++r) x += zr[ca + r] * w2[r * 512 + h * 128 + d];
                const float ls = fminf(x, 0.f) - log1pf(expf(-fabsf(x)));
                a = expf(ls * (1.0f / 16.0f));
            } else {
                const int i = d & 63;
                const double inv = pow(10000.0, -(double)i / 64.0);
                const double ang = (double)(pos0 + t) * inv;
                const float c = (float)cos(ang), s = (float)sin(ang);
                const float q1 = zr[cq + h * 128 + i], q2 = zr[cq + h * 128 + 64 + i];
                const float k1 = zr[ck + h * 128 + i], k2 = zr[ck + h * 128 + 64 + i];
                q = d < 64 ? q1 * c - q2 * s : q1 * s + q2 * c;
                k = (d < 64 ? k1 * c - k2 * s : k1 * s + k2 * c) * scale;
                a = 1.0f - exp2f(-5.0f - (float)h);
            }
            sq[d] = q; sk[d] = k; sa[d] = a;
        }
        __syncthreads();
        const float v = zr[cv + h * 256 + n];
        float o = 0.f;
#pragma unroll
        for (int d4 = 0; d4 < 32; ++d4) {
            const float4 a4 = *(const float4*)&sa[d4 * 4], k4 = *(const float4*)&sk[d4 * 4], q4 = *(const float4*)&sq[d4 * 4];
            S[d4 * 4 + 0] = a4.x * S[d4 * 4 + 0] + k4.x * v; o += q4.x * S[d4 * 4 + 0];
            S[d4 * 4 + 1] = a4.y * S[d4 * 4 + 1] + k4.y * v; o += q4.y * S[d4 * 4 + 1];
            S[d4 * 4 + 2] = a4.z * S[d4 * 4 + 2] + k4.z * v; o += q4.z * S[d4 * 4 + 2];
            S[d4 * 4 + 3] = a4.w * S[d4 * 4 + 3] + k4.w * v; o += q4.w * S[d4 * 4 + 3];
        }
        o_out[row * 1024 + h * 256 + n] = o;
        __syncthreads();
    }
#pragma unroll
    for (int d = 0; d < 128; ++d) s_out[((size_t)(b * 4 + h) * 128 + d) * 256 + n] = S[d];
}

template <int BR>
__global__ __launch_bounds__(256) void head_norm_gate(float* o, const float* zb, int ldz, int cg, const float* ghead) {
    __shared__ float red[8];
    const size_t row = blockIdx.x; const int n = threadIdx.x;
    for (int h = 0; h < 4; ++h) {
        const float x = o[row * 1024 + h * 256 + n];
        float y;
        if (BR == 0) { const float ms = block_sum256(x * x, red) * (1.0f / 256.0f); y = x * rsqrtf(ms + 1e-6f); }
        else { const float mu = block_sum256(x, red) * (1.0f / 256.0f); const float xc = x - mu; const float var = block_sum256(xc * xc, red) * (1.0f / 256.0f); y = xc * rsqrtf(var + 1e-6f); }
        y *= ghead[h * 256 + n];
        const float g = zb[row * ldz + cg + h * 256 + n];
        y *= g / (1.0f + expf(-g));
        o[row * 1024 + h * 256 + n] = y;
    }
}
__global__ __launch_bounds__(256) void merge_k(float* og, const float* orr, const float* zb, int ldz, int ca, int cb) {
    const size_t row = blockIdx.x;
    for (int c = threadIdx.x; c < 1024; c += 256) {
        const float ga = zb[row * ldz + ca + c], gb = zb[row * ldz + cb + c];
        og[row * 1024 + c] = og[row * 1024 + c] / (1.0f + expf(-ga)) + orr[row * 1024 + c] / (1.0f + expf(-gb));
    }
}

__global__ __launch_bounds__(256) void xattn_naive(const float* __restrict__ q, const float* __restrict__ Kp, const float* __restrict__ Vp, float* __restrict__ o, int row0, int L) {
    __shared__ float sq[8][256]; __shared__ float sp[8][256]; __shared__ float kt[32][257];
    const int tid = threadIdx.x, h = blockIdx.y;
    const int b = (blockIdx.x * 8) / L; const size_t rowbase = (size_t)row0 + (size_t)blockIdx.x * 8;
    for (int tok = 0; tok < 8; ++tok) sq[tok][tid] = q[(rowbase + tok) * 1024 + h * 256 + tid];
    const int tk = tid >> 5, mm = tid & 31;
    for (int mt = 0; mt < 8; ++mt) {
        __syncthreads();
        for (int i = 0; i < 32; ++i) kt[i][tid] = Kp[(((size_t)b * 256 + mt * 32 + i) * 4 + h) * 256 + tid];
        __syncthreads();
        float s = 0.f;
        for (int d = 0; d < 256; ++d) s += sq[tk][d] * kt[mm][d];
        sp[tk][mt * 32 + mm] = s * 0.0625f;
    }
    __syncthreads();
    {
        float v[8], mx = -3.0e38f;
#pragma unroll
        for (int j = 0; j < 8; ++j) { v[j] = sp[tk][mm + 32 * j]; mx = fmaxf(mx, v[j]); }
#pragma unroll
        for (int off = 16; off >= 1; off >>= 1) mx = fmaxf(mx, __shfl_xor(mx, off));
        float sum = 0.f;
#pragma unroll
        for (int j = 0; j < 8; ++j) { v[j] = expf(v[j] - mx); sum += v[j]; }
#pragma unroll
        for (int off = 16; off >= 1; off >>= 1) sum += __shfl_xor(sum, off);
        const float inv = 1.0f / sum;
#pragma unroll
        for (int j = 0; j < 8; ++j) sp[tk][mm + 32 * j] = v[j] * inv;
    }
    __syncthreads();
    float acc[8];
#pragma unroll
    for (int j = 0; j < 8; ++j) acc[j] = 0.f;
    for (int m = 0; m < 256; ++m) {
        const float p = sp[tk][m];
        const float* vr = Vp + (((size_t)b * 256 + m) * 4 + h) * 256 + mm;
#pragma unroll
        for (int j = 0; j < 8; ++j) acc[j] += p * vr[32 * j];
    }
#pragma unroll
    for (int j = 0; j < 8; ++j) o[(rowbase + tk) * 1024 + h * 256 + mm + 32 * j] = acc[j];
}

struct In {
    const float *x_prompt, *x_sample, *state_gla, *state_ret, *cache_k, *cache_v, *mem, *w_in, *w_a2, *b_a, *g_gla, *g_ret, *w_mo, *w_xq, *w_xk, *w_xv, *w_xo, *g_mem, *w_up, *w_down,
        *g_pre_mix, *g_post_mix, *g_pre_xa, *g_post_xa, *g_pre_ffn, *g_post_ffn;
};
inline In make_in(void* const* d) {
    In I; const float** p = (const float**)&I; for (int i = 0; i < 26; ++i) p[i] = (const float*)d[i]; return I;
}

constexpr size_t SZ_ACT = (size_t)NT * D * 4;
constexpr size_t W_A = 0, W_B = W_A + SZ_ACT, SZ_B = (size_t)NT * 3088 * 4, W_C = W_B + SZ_B, W_D = W_C + SZ_ACT, W_E = W_D + SZ_ACT, W_M = W_E + SZ_ACT, W_NEND = W_M + (size_t)NMEMROWS * D * 4;

template <int ACT> inline void gemm(const float* A, int lda, const float* B, int ldb, float* C, int ldc, int M, int N, int K, hipStream_t s) {
    dim3 g((N + 63) / 64, M / 64);
    hipLaunchKernelGGL(gemm_nn<ACT>, g, dim3(256), 0, s, A, lda, B, ldb, C, ldc, M, N, K);
}

inline void forward(const In& I, float* out, unsigned char* ws, hipStream_t s) {
    float* A = (float*)(ws + W_A); float* B = (float*)(ws + W_B); float* C = (float*)(ws + W_C); float* Dd = (float*)(ws + W_D); float* E = (float*)(ws + W_E); float* Mm = (float*)(ws + W_M);
    float* T = B; float* Q = (float*)(ws + W_B + SZ_ACT); float* U = Q;
    hipLaunchKernelGGL(rms_rows, dim3(NT), dim3(256), 0, s, I.x_prompt, I.x_sample, I.g_pre_mix, A);
    hipLaunchKernelGGL(rms_rows, dim3(NMEMROWS), dim3(256), 0, s, I.mem, (const float*)nullptr, I.g_mem, Mm);
    gemm<0>(Mm, D, I.w_xk, D, out + O_MK, D, NMEMROWS, D, D, s);
    gemm<0>(Mm, D, I.w_xv, D, out + O_MV, D, NMEMROWS, D, D, s);
    gemm<0>(A, D, I.w_in, NIN, B, 3088, NT, 3088, D, s);
    hipLaunchKernelGGL(linattn_naive<0>, dim3(32), dim3(256), 0, s, B, 3088, 0, 512, 1024, 3072, I.w_a2, I.b_a, (const float*)nullptr, out + O_SGP, C, 0, 2048, 0);
    hipLaunchKernelGGL(linattn_naive<0>, dim3(512), dim3(256), 0, s, B, 3088, 0, 512, 1024, 3072, I.w_a2, I.b_a, I.state_gla, out + O_SGS, C, NP, 8, 16384);
    hipLaunchKernelGGL(head_norm_gate<0>, dim3(NT), dim3(256), 0, s, C, B, 3088, 2048, I.g_gla);
    gemm<0>(A, D, I.w_in + 3088, NIN, B, 3088, NT, 3072, D, s);
    hipLaunchKernelGGL(linattn_naive<1>, dim3(32), dim3(256), 0, s, B, 3088, 0, 512, 1024, 0, (const float*)nullptr, (const float*)nullptr, (const float*)nullptr, out + O_SRP, Dd, 0, 2048, 0);
    hipLaunchKernelGGL(linattn_naive<1>, dim3(512), dim3(256), 0, s, B, 3088, 0, 512, 1024, 0, (const float*)nullptr, (const float*)nullptr, I.state_ret, out + O_SRS, Dd, NP, 8, 16384);
    hipLaunchKernelGGL(head_norm_gate<1>, dim3(NT), dim3(256), 0, s, Dd, B, 3088, 2048, I.g_ret);
    gemm<0>(A, D, I.w_in + 6160, NIN, B, 3088, NT, 2048, D, s);
    hipLaunchKernelGGL(merge_k, dim3(NT), dim3(256), 0, s, C, Dd, B, 3088, 0, 1024);
    gemm<0>(C, D, I.w_mo, D, T, D, NT, D, D, s);
    hipLaunchKernelGGL(res_norm, dim3(NT), dim3(256), 0, s, I.x_prompt, I.x_sample, T, I.g_post_mix, E, I.g_pre_xa, A);
    gemm<0>(A, D, I.w_xq, D, Q, D, NT, D, D, s);
    hipLaunchKernelGGL(xattn_naive, dim3(NP / 8, 4), dim3(256), 0, s, Q, out + O_MK, out + O_MV, Dd, 0, 2048);
    hipLaunchKernelGGL(xattn_naive, dim3(NS / 8, 4), dim3(256), 0, s, Q, I.cache_k, I.cache_v, Dd, NP, 8);
    gemm<0>(Dd, D, I.w_xo, D, T, D, NT, D, D, s);
    hipLaunchKernelGGL(res_norm, dim3(NT), dim3(256), 0, s, (const float*)E, (const float*)nullptr, T, I.g_post_xa, E, I.g_pre_ffn, A);
    for (int c = 0; c < 4; ++c) {
        const int r0 = c * 4352;
        gemm<1>(A + (size_t)r0 * D, D, I.w_up, 4096, U, 4096, 4352, 4096, D, s);
        gemm<0>(U, 4096, I.w_down, D, T + (size_t)r0 * D, D, 4352, D, 4096, s);
    }
    hipLaunchKernelGGL(res_norm, dim3(NT), dim3(256), 0, s, (const float*)E, (const float*)nullptr, T, I.g_post_ffn, out + O_YP, (const float*)nullptr, (float*)nullptr);
}
}

extern "C" void kernel_launch(void* const* d_in, const int* in_sizes, int n_in, void* d_out, int out_size, void* d_ws, size_t ws_size, hipStream_t stream) {
    if (n_in != 26 || out_size != (int)nv::O_END || ws_size < nv::W_NEND) { fprintf(stderr, "kernel_launch: unexpected sizes n_in %d out %d ws %zu\n", n_in, out_size, ws_size); return; }
    nv::In I = nv::make_in(d_in);
    nv::forward(I, (float*)d_out, (unsigned char*)d_ws, stream);
}
```

```cpp
#include <hip/hip_runtime.h>
#include <cstdio>
#include <cstdint>

namespace pg8 {
#define PG8_LAS __attribute__((address_space(3)))
typedef unsigned short bf16_t;
typedef short bf16x8 __attribute__((ext_vector_type(8)));
typedef float f32x4 __attribute__((ext_vector_type(4)));
typedef unsigned u32x4 __attribute__((ext_vector_type(4)));
typedef unsigned u32x2 __attribute__((ext_vector_type(2)));
constexpr int BM = 256, BK = 64, HALF = 128, HTB = HALF * BK * 2  , STAGE_BYTES = 8 * HTB, NXCD = 8, WGM = 8;

__host__ __device__ __forceinline__ int lds_byte(int r, int c) { const int st = (r >> 4) * 2 + (c >> 5), rr = r & 15, cc = c & 31, ob = rr * 64 + cc * 2; return st * 1024 + (ob ^ (((ob >> 9) & 1) << 5)); }
__host__ __device__ __forceinline__ void stage_rc(int b, int& R, int& C) { const int st = b / 1024, sb = b % 1024, swz = sb ^ (((sb >> 9) & 1) << 5); R = (st >> 1) * 16 + swz / 64; C = (st & 1) * 32 + (swz % 64) / 2; }
__host__ __device__ __forceinline__ int perm32(int rho) { const int n = rho >> 4, i = rho & 15; return 8 * (i >> 2) + 4 * n + (i & 3); }

struct Unit { int pm, pn; };
struct Gemm { const bf16_t* A; const bf16_t* Bt; int M, N, K; };

struct StaticOrder {
    int nM, nN, nwg, G, c;
    __host__ __device__ void init(int M, int N, int G_, int c_) { nM = M / BM; nN = N / BM; nwg = nM * nN; G = G_; c = c_; }
    __host__ __device__ bool next(int i, Unit& u) const {
        if (c < 0) return false;
        const long L = (long)i * G + c; if (L >= nwg) return false;
        int wgid = (int)L; { const int q = nwg / NXCD, r = nwg % NXCD, xcd = wgid % NXCD, off = wgid / NXCD; wgid = (xcd < r ? xcd * (q + 1) : r * (q + 1) + (xcd - r) * q) + off; }
        const int nig = WGM * nN, gid = wgid / nig, fm = gid * WGM, gsz = (nM - fm) < WGM ? (nM - fm) : WGM;
        u.pm = fm + ((wgid % nig) % gsz); u.pn = (wgid % nig) / gsz; return true;
    }
    __device__ __forceinline__ void a_ready(const Unit&) const {}
    __device__ __forceinline__ void done(const Unit&) const {}
};

typedef float f32x2_t __attribute__((ext_vector_type(2))); typedef __bf16 bf16x2_t __attribute__((ext_vector_type(2)));
__device__ __forceinline__ unsigned cvt_pk_bf16(float lo, float hi) { f32x2_t v = {lo, hi}; bf16x2_t b = __builtin_convertvector(v, bf16x2_t); return __builtin_bit_cast(unsigned, b); }

template <int ACT  > struct EpiBf16 {
    static constexpr bool PERM = true, AFTER_DRAIN = false;
    bf16_t* O; int ldc;
    __device__ __forceinline__ void operator()(const f32x4 (&acc)[2][2][4][2], const Unit& u, int wr, int wc, int fr, int fq) const {
        const int row0 = u.pm * BM + wr * 64 + fr; const int col0 = u.pn * BM + wc * 32 + 8 * fq;
#pragma unroll
        for (int ai = 0; ai < 2; ++ai)
#pragma unroll
            for (int m = 0; m < 4; ++m) { bf16_t* rowp = O + (size_t)(row0 + ai * HALF + m * 16) * ldc + col0;
#pragma unroll
                for (int bj = 0; bj < 2; ++bj) { f32x4 v0 = acc[ai][bj][m][0], v1 = acc[ai][bj][m][1];
                    if (ACT == 2) {
#pragma unroll
                        for (int e = 0; e < 4; ++e) { const float a = v0[e] > 0.f ? v0[e] : 0.f, b = v1[e] > 0.f ? v1[e] : 0.f; v0[e] = a * a; v1[e] = b * b; } }
                    u32x4 w; w.x = cvt_pk_bf16(v0[0], v0[1]); w.y = cvt_pk_bf16(v0[2], v0[3]); w.z = cvt_pk_bf16(v1[0], v1[1]); w.w = cvt_pk_bf16(v1[2], v1[3]);
                    *(u32x4*)(rowp + bj * HALF) = w; } }
    }
};
struct EpiF32 {
    static constexpr bool PERM = false, AFTER_DRAIN = false;
    float* O; int ldc;
    __device__ __forceinline__ void operator()(const f32x4 (&acc)[2][2][4][2], const Unit& u, int wr, int wc, int fr, int fq) const {
        const int row0 = u.pm * BM + wr * 64 + fr; const int col0 = u.pn * BM + wc * 32 + 4 * fq;
#pragma unroll
        for (int ai = 0; ai < 2; ++ai)
#pragma unroll
            for (int m = 0; m < 4; ++m) { float* rowp = O + (size_t)(row0 + ai * HALF + m * 16) * ldc + col0;
#pragma unroll
                for (int bj = 0; bj < 2; ++bj)
#pragma unroll
                    for (int n = 0; n < 2; ++n) *(f32x4*)(rowp + bj * HALF + n * 16) = acc[ai][bj][m][n]; }
    }
};
struct EpiKV {
    static constexpr bool PERM = false, AFTER_DRAIN = false;
    float* OK; float* OV; bf16_t* BK_; bf16_t* BV_;
    __device__ __forceinline__ void operator()(const f32x4 (&acc)[2][2][4][2], const Unit& u, int wr, int wc, int fr, int fq) const {
        const int row0 = u.pm * BM + wr * 64 + fr; const bool isv = u.pn >= 4; const int col0 = (u.pn & 3) * BM + wc * 32 + 4 * fq;
        float* Of = isv ? OV : OK; bf16_t* Ob = isv ? BV_ : BK_;
#pragma unroll
        for (int ai = 0; ai < 2; ++ai)
#pragma unroll
            for (int m = 0; m < 4; ++m) { const size_t ro = (size_t)(row0 + ai * HALF + m * 16) * 1024 + col0;
#pragma unroll
                for (int bj = 0; bj < 2; ++bj)
#pragma unroll
                    for (int n = 0; n < 2; ++n) { const f32x4 v = acc[ai][bj][m][n]; *(f32x4*)(Of + ro + bj * HALF + n * 16) = v;
                        u32x2 w; w.x = cvt_pk_bf16(v[0], v[1]); w.y = cvt_pk_bf16(v[2], v[3]); *(u32x2*)(Ob + ro + bj * HALF + n * 16) = w; } }
    }
};

template <class Epi, class Sched, bool ALIGN_EPI = false, bool SP2 = false>
__device__ __forceinline__ void gemm_phase(PG8_LAS unsigned char* lds, const Gemm g, const Sched& S, const Epi& E) {
    int tid = threadIdx.x; asm volatile("" : "+v"(tid));
    const int wid = __builtin_amdgcn_readfirstlane(tid >> 6), lane = tid & 63, wr = wid >> 2, wc = wid & 3, fr = lane & 15, fq = lane >> 4;
    const int K = g.K, nt = K / BK;
    unsigned voffA[2], voffB[2];
#pragma unroll
    for (int i = 0; i < 2; ++i) { int R, C; stage_rc(tid * 16 + i * 8192, R, C); const int Rb = Epi::PERM ? ((R & ~31) + perm32(R & 31)) : R;
        voffA[i] = (unsigned)(R * K + C) * 2u; voffB[i] = (unsigned)(Rb * K + C) * 2u; }
    const size_t kstep = (size_t)(BK * 2);
    const size_t hstep = (size_t)HALF * K * 2;
    const size_t tstep = 2 * hstep;
    const unsigned ldsw = (unsigned)wid * 1024u;
    const int aoff = lds_byte(wr * 64 + fr, fq * 8), boff = lds_byte(wc * 32 + fr, fq * 8);
#define PG8_SA(b, h) (((b) * 2 + (h)) * HTB)
#define PG8_SB(b, h) ((4 + (b) * 2 + (h)) * HTB)
#define PG8_STAGE(bufoff, gbase, voff) do { _Pragma("unroll") for (int _i = 0; _i < 2; ++_i) \
        __builtin_amdgcn_global_load_lds((const unsigned*)((const char*)(gbase) + (voff)[_i]), (PG8_LAS unsigned*)(lds + (bufoff) + ldsw + _i * 8192), 16, 0, 0); } while (0)
#define PG8_LDA(dst, b, h) do { _Pragma("unroll") for (int m = 0; m < 4; ++m) _Pragma("unroll") for (int k = 0; k < 2; ++k) dst[m][k] = *(const PG8_LAS bf16x8*)(lds + PG8_SA(b, h) + aoff + m * 2048 + k * 1024); } while (0)
#define PG8_LDB(dst, b, h) do { _Pragma("unroll") for (int n = 0; n < 2; ++n) _Pragma("unroll") for (int k = 0; k < 2; ++k) dst[n][k] = *(const PG8_LAS bf16x8*)(lds + PG8_SB(b, h) + boff + n * 2048 + k * 1024); } while (0)
#define PG8_MMA(ai, bj, At, Bt) do { __builtin_amdgcn_s_setprio(1); _Pragma("unroll") for (int m = 0; m < 4; ++m) _Pragma("unroll") for (int n = 0; n < 2; ++n) _Pragma("unroll") for (int k = 0; k < 2; ++k) \
        acc[ai][bj][m][n] = __builtin_amdgcn_mfma_f32_16x16x32_bf16(Bt[n][k], At[m][k], acc[ai][bj][m][n], 0, 0, 0); __builtin_amdgcn_s_setprio(0); } while (0)
#define PG8_WAIT_V(n) asm volatile("s_waitcnt vmcnt(" #n ")" ::: "memory")
#define PG8_WAIT_L(n) asm volatile("s_waitcnt lgkmcnt(" #n ")" ::: "memory")
#define PG8_BAR __builtin_amdgcn_s_barrier()
#define PG8_SCHED __builtin_amdgcn_sched_barrier(0)
    Unit cur, nxt; int ui = 0;
    if (!S.next(0, cur)) return;
    f32x4 acc[2][2][4][2];
#pragma unroll
    for (int a = 0; a < 2; ++a)
#pragma unroll
        for (int b = 0; b < 2; ++b)
#pragma unroll
            for (int m = 0; m < 4; ++m)
#pragma unroll
                for (int n = 0; n < 2; ++n) acc[a][b][m][n] = (f32x4){0.f, 0.f, 0.f, 0.f};
    bf16x8 At[4][2], B0[2][2], B1[2][2];
    const char* cA = (const char*)g.A + (size_t)cur.pm * tstep; const char* cB = (const char*)g.Bt + (size_t)cur.pn * tstep;
    S.a_ready(cur);
    if constexpr (SP2) {
        PG8_STAGE(PG8_SB(0, 0), cB, voffB); PG8_STAGE(PG8_SB(0, 1), cB + hstep, voffB); PG8_STAGE(PG8_SA(0, 0), cA, voffA); PG8_STAGE(PG8_SA(0, 1), cA + hstep, voffA);
        if (wr == 1) PG8_BAR;
        PG8_WAIT_V(2); PG8_BAR;
        PG8_STAGE(PG8_SB(1, 0), cB + kstep, voffB); PG8_STAGE(PG8_SA(1, 0), cA + kstep, voffA); PG8_STAGE(PG8_SB(1, 1), cB + hstep + kstep, voffB);
        PG8_WAIT_V(6); PG8_BAR;
    } else {
        PG8_STAGE(PG8_SB(0, 0), cB, voffB); PG8_STAGE(PG8_SA(0, 0), cA, voffA); PG8_STAGE(PG8_SB(0, 1), cB + hstep, voffB); PG8_STAGE(PG8_SA(0, 1), cA + hstep, voffA);
        if (wr == 1) PG8_BAR;
        PG8_WAIT_V(4); PG8_BAR;
        PG8_STAGE(PG8_SB(1, 0), cB + kstep, voffB); PG8_STAGE(PG8_SA(1, 0), cA + kstep, voffA); PG8_STAGE(PG8_SB(1, 1), cB + hstep + kstep, voffB);
        PG8_WAIT_V(6); PG8_BAR;
    }
    for (;;) {
        const bool has_next = S.next(ui + 1, nxt);
        const char* nA = has_next ? (const char*)g.A + (size_t)nxt.pm * tstep : cA; const char* nB = has_next ? (const char*)g.Bt + (size_t)nxt.pn * tstep : cB;
        for (int t = 0; t < nt; t += 2) {
            const bool last = (t == nt - 2);
            const char* a1 = cA + (size_t)(t + 1) * kstep;
            const char* a2 = last ? nA : cA + (size_t)(t + 2) * kstep; const char* b2 = last ? nB : cB + (size_t)(t + 2) * kstep;
            const char* a3 = a2 + kstep; const char* b3 = b2 + kstep;
            if (last && has_next) S.a_ready(nxt);
            if constexpr (SP2) {
            PG8_LDB(B0, 0, 0); PG8_LDB(B1, 0, 1); PG8_SCHED; PG8_LDA(At, 0, 0); PG8_STAGE(PG8_SA(1, 1), a1 + hstep, voffA);
            PG8_WAIT_V(8); PG8_WAIT_L(0); PG8_BAR; PG8_MMA(0, 0, At, B0); PG8_MMA(0, 1, At, B1); PG8_BAR; PG8_SCHED;
            PG8_LDA(At, 0, 1); PG8_STAGE(PG8_SB(0, 0), b2, voffB); PG8_STAGE(PG8_SB(0, 1), b2 + hstep, voffB); PG8_STAGE(PG8_SA(0, 0), a2, voffA);
            PG8_WAIT_V(8); PG8_WAIT_L(0); PG8_BAR; PG8_MMA(1, 0, At, B0); PG8_MMA(1, 1, At, B1); PG8_BAR; PG8_SCHED;
            PG8_LDB(B0, 1, 0); PG8_LDB(B1, 1, 1); PG8_SCHED; PG8_LDA(At, 1, 0); PG8_STAGE(PG8_SA(0, 1), a2 + hstep, voffA);
            PG8_WAIT_V(8); PG8_WAIT_L(0); PG8_BAR; PG8_MMA(0, 0, At, B0); PG8_MMA(0, 1, At, B1); PG8_BAR; PG8_SCHED;
            PG8_LDA(At, 1, 1); PG8_STAGE(PG8_SB(1, 0), b3, voffB); PG8_STAGE(PG8_SB(1, 1), b3 + hstep, voffB); PG8_STAGE(PG8_SA(1, 0), a3, voffA);
            PG8_WAIT_V(8); PG8_WAIT_L(0); PG8_BAR; PG8_MMA(1, 0, At, B0); PG8_MMA(1, 1, At, B1); PG8_BAR; PG8_SCHED;
            } else {
            PG8_LDB(B0, 0, 0); PG8_SCHED; PG8_LDA(At, 0, 0); PG8_STAGE(PG8_SA(1, 1), a1 + hstep, voffA);
            PG8_WAIT_L(8); PG8_BAR; PG8_WAIT_L(0); PG8_MMA(0, 0, At, B0); PG8_BAR; PG8_SCHED;
            PG8_LDB(B1, 0, 1); PG8_STAGE(PG8_SB(0, 0), b2, voffB);
            PG8_BAR; PG8_WAIT_L(0); PG8_MMA(0, 1, At, B1); PG8_BAR;
            PG8_LDA(At, 0, 1); PG8_STAGE(PG8_SA(0, 0), a2, voffA);
            PG8_BAR; PG8_WAIT_L(0); PG8_MMA(1, 0, At, B0); PG8_BAR; PG8_SCHED;
            PG8_STAGE(PG8_SB(0, 1), b2 + hstep, voffB);
            PG8_WAIT_V(6); PG8_BAR; PG8_MMA(1, 1, At, B1); PG8_BAR;
            PG8_LDB(B0, 1, 0); PG8_SCHED; PG8_LDA(At, 1, 0); PG8_STAGE(PG8_SA(0, 1), a2 + hstep, voffA);
            PG8_WAIT_L(8); PG8_BAR; PG8_WAIT_L(0); PG8_MMA(0, 0, At, B0); PG8_BAR; PG8_SCHED;
            PG8_LDB(B1, 1, 1); PG8_STAGE(PG8_SB(1, 0), b3, voffB);
            PG8_BAR; PG8_WAIT_L(0); PG8_MMA(0, 1, At, B1); PG8_BAR;
            PG8_LDA(At, 1, 1); PG8_STAGE(PG8_SA(1, 0), a3, voffA);
            PG8_BAR; PG8_WAIT_L(0); PG8_MMA(1, 0, At, B0); PG8_BAR; PG8_SCHED;
            PG8_STAGE(PG8_SB(1, 1), b3 + hstep, voffB);
            PG8_WAIT_V(6); PG8_BAR; PG8_MMA(1, 1, At, B1); PG8_BAR;
            }
        }
        if constexpr (ALIGN_EPI) { if (wr == 0) PG8_BAR; }
        if constexpr (!Epi::AFTER_DRAIN) { E(acc, cur, wr, wc, fr, fq); S.done(cur); }
        if (!has_next) break;
#pragma unroll
        for (int a = 0; a < 2; ++a)
#pragma unroll
            for (int b = 0; b < 2; ++b)
#pragma unroll
                for (int m = 0; m < 4; ++m)
#pragma unroll
                    for (int n = 0; n < 2; ++n) acc[a][b][m][n] = (f32x4){0.f, 0.f, 0.f, 0.f};
        cur = nxt; cA = nA; cB = nB; ++ui;
        if constexpr (ALIGN_EPI) { if (wr == 1) PG8_BAR; }
    }
    PG8_WAIT_V(0);
    if constexpr (!ALIGN_EPI) { if (wr == 0) PG8_BAR; }
    PG8_BAR;
#undef PG8_SA
#undef PG8_SB
#undef PG8_STAGE
#undef PG8_LDA
#undef PG8_LDB
#undef PG8_MMA
#undef PG8_WAIT_V
#undef PG8_WAIT_L
#undef PG8_BAR
#undef PG8_SCHED
}
}

#include <hip/hip_cooperative_groups.h>
namespace mk {
namespace cg = cooperative_groups;
#define LAS __attribute__((address_space(3)))
#define GAS __attribute__((address_space(1)))
typedef unsigned short bf16;
typedef float f32x4 __attribute__((ext_vector_type(4)));
typedef float f32x16 __attribute__((ext_vector_type(16)));
typedef unsigned u32x4 __attribute__((ext_vector_type(4)));
typedef unsigned u32x2 __attribute__((ext_vector_type(2)));
typedef short bf16x8 __attribute__((ext_vector_type(8)));
typedef short s16x4 __attribute__((ext_vector_type(4)));
typedef short v4i16_t __attribute__((ext_vector_type(4)));

constexpr int NWAVES = 8, NTHR = 512;
constexpr int D = 1024, NP = 16384, NS = 1024, NT = NP + NS, NIN = 8208, NZ = 8192, FF = 4096, NMEM = 2048;
constexpr size_t O_YP = 0, O_YS = 16777216, O_SGP = 17825792, O_SRP = 18874368, O_MK = 19922944, O_MV = 22020096, O_SGS = 24117248, O_SRS = 40894464, O_END = 57671680;
constexpr int ZC_GQ = 0, ZC_GK = 512, ZC_GV = 1024, ZC_GR = 2048, ZC_RQ = 3072, ZC_RK = 3584, ZC_RV = 4096, ZC_RG = 5120, ZC_GA = 6144, ZC_GB = 7168;
constexpr size_t MiB = 1u << 20;
constexpr size_t WS_CTL = 0, WS_WIN = 1 * MiB, WS_WMO = 17 * MiB, WS_WXQ = 21 * MiB, WS_WXKV = 23 * MiB, WS_WXO = 27 * MiB, WS_WUP = 29 * MiB, WS_WDN = 37 * MiB, WS_ROPE = 45 * MiB, WS_GAL = 47 * MiB,
                 WS_MB = 49 * MiB, WS_MKB = 53 * MiB, WS_MVB = 57 * MiB, WS_H = 61 * MiB, WS_Z = 95 * MiB, WS_Q = WS_Z, WS_O = WS_Z + 34 * MiB, WS_U = WS_Z + 68 * MiB, WS_MG = 367 * MiB, WS_T = 435 * MiB, WS_END = 503 * MiB;
constexpr int LDS_BYTES = 147456;
constexpr float EPS = 1e-6f;

__device__ __forceinline__ unsigned pk2(float lo, float hi) { return pg8::cvt_pk_bf16(lo, hi); }
__device__ __forceinline__ float bf2f(unsigned short u) { return __uint_as_float((unsigned)u << 16); }
__device__ __forceinline__ float bflo(unsigned w) { return __uint_as_float(w << 16); }
__device__ __forceinline__ float bfhi(unsigned w) { return __uint_as_float(w & 0xffff0000u); }
__device__ __forceinline__ unsigned short f2bf(float f) { return (unsigned short)(pk2(f, 0.f) & 0xffffu); }
__device__ __forceinline__ float wave_sum(float v) {
#pragma unroll
    for (int o = 1; o < 64; o <<= 1) v += __shfl_xor(v, o);
    return v;
}
#define MFMA32(a, b, c) __builtin_amdgcn_mfma_f32_32x32x16_bf16((a), (b), (c), 0, 0, 0)
__device__ __forceinline__ int crow(int reg, int h) { return (reg & 3) + 8 * (reg >> 2) + 4 * h; }
__device__ __forceinline__ bf16x8 pack8(const f32x16& x, int s) {
    u32x4 p; p.x = pk2(x[8 * s + 0], x[8 * s + 1]); p.y = pk2(x[8 * s + 2], x[8 * s + 3]); p.z = pk2(x[8 * s + 4], x[8 * s + 5]); p.w = pk2(x[8 * s + 6], x[8 * s + 7]);
    return __builtin_bit_cast(bf16x8, p);
}
__device__ __forceinline__ s16x4 vtr(const LAS unsigned char* p) { return __builtin_bit_cast(s16x4, __builtin_amdgcn_ds_read_tr16_b64_v4i16((LAS v4i16_t*)p)); }
__device__ __forceinline__ bf16x8 cat8(s16x4 lo, s16x4 hi) { return __builtin_shufflevector(lo, hi, 0, 1, 2, 3, 4, 5, 6, 7); }

struct Params {
    const float* in[26];
    float* out; unsigned char* ws;
    int stop_after;
    int pad;
};
enum { I_XP = 0, I_XS, I_SG, I_SR, I_CK, I_CV, I_MEM, I_WIN, I_WA2, I_BA, I_GGLA, I_GRET, I_WMO, I_WXQ, I_WXK, I_WXV, I_WXO, I_GMEM, I_WUP, I_WDN, I_GPM, I_GQM, I_GPX, I_GQX, I_GPF, I_GQF };

__device__ __forceinline__ void transpose_item(const float* W, int ldw, int col_off, int N, bf16* WT, int ldt, int row_off, int kcol_off, LAS float* scr, int item, int lane) {
    const int nblk = N / 32, kb = item / nblk, nb = item % nblk, k0 = 64 * kb, n0 = 32 * nb;
#pragma unroll 8
    for (int i = 0; i < 32; ++i) { const int kk = 2 * i + (lane >> 5); scr[kk * 33 + (lane & 31)] = W[(size_t)(k0 + kk) * ldw + col_off + n0 + (lane & 31)]; }
    asm volatile("s_waitcnt lgkmcnt(0)" ::: "memory");
    const int c = lane & 7;
#pragma unroll
    for (int j = 0; j < 4; ++j) { const int n = (lane >> 3) + 8 * j; const LAS float* s = scr + (8 * c) * 33 + n;
        u32x4 o; o.x = pk2(s[0 * 33], s[1 * 33]); o.y = pk2(s[2 * 33], s[3 * 33]); o.z = pk2(s[4 * 33], s[5 * 33]); o.w = pk2(s[6 * 33], s[7 * 33]);
        *(u32x4*)(WT + (size_t)(row_off + n0 + n) * ldt + kcol_off + k0 + 8 * c) = o; }
    asm volatile("s_waitcnt lgkmcnt(0)" ::: "memory");
}

template <bool GA>
__device__ __forceinline__ void rms_row_bf16(const float* xrow, const float* g, bf16* orow, const LAS float* wga, float* garow, int lane) {
    f32x4 v[4]; float s = 0.f;
#pragma unroll
    for (int j = 0; j < 4; ++j) { v[j] = ((const f32x4*)xrow)[lane + 64 * j]; s += (v[j].x * v[j].x + v[j].y * v[j].y) + (v[j].z * v[j].z + v[j].w * v[j].w); }
    const float rs = 1.0f / sqrtf(wave_sum(s) * (1.f / D) + EPS);
#pragma unroll
    for (int j = 0; j < 4; ++j) { const f32x4 gg = ((const f32x4*)g)[lane + 64 * j]; v[j] = v[j] * rs * gg; }
#pragma unroll
    for (int j = 0; j < 4; ++j) { u32x2 w; w.x = pk2(v[j].x, v[j].y); w.y = pk2(v[j].z, v[j].w); ((u32x2*)orow)[lane + 64 * j] = w; }
    if (GA) {
        float mine = 0.f;
#pragma unroll
        for (int r = 0; r < 16; ++r) {
            float a = 0.f;
#pragma unroll
            for (int j = 0; j < 4; ++j) { const f32x4 w = ((const LAS f32x4*)(wga + r * 1024))[lane + 64 * j]; a += (v[j].x * w.x + v[j].y * w.y) + (v[j].z * w.z + v[j].w * w.w); }
            a = wave_sum(a);
            if (lane == r) mine = a;
        }
        if (lane < 16) garow[lane] = mine;
    }
}

__device__ __forceinline__ void phase0(const Params& P, LAS unsigned char* lds, int vcu, int G) {
    int tid = threadIdx.x; asm volatile("" : "+v"(tid));
    const int lane = tid & 63, wave = __builtin_amdgcn_readfirstlane(tid >> 6);
    unsigned char* ws = P.ws;
    LAS float* wga = (LAS float*)lds;
    LAS float* scr = (LAS float*)(lds + 65536 + wave * 8704);
    { const float* W = P.in[I_WIN];
      for (int k = tid; k < 1024; k += NTHR) {
#pragma unroll
          for (int q = 0; q < 4; ++q) { const f32x4 w = *(const f32x4*)(W + (size_t)k * NIN + 3072 + 4 * q); wga[(4 * q + 0) * 1024 + k] = w.x; wga[(4 * q + 1) * 1024 + k] = w.y; wga[(4 * q + 2) * 1024 + k] = w.z; wga[(4 * q + 3) * 1024 + k] = w.w; } } }
    const int gw = vcu * NWAVES + wave, NGW = G * NWAVES;
    constexpr int I_IN = (D / 64) * (NZ / 32), I_SQ = (D / 64) * (D / 32), I_UP = (D / 64) * (FF / 32), I_DN = (FF / 64) * (D / 32);
    constexpr int NITEMS = I_IN + 5 * I_SQ + I_UP + I_DN;
    for (int it = gw; it < NITEMS; it += NGW) {
        int r = it;
        if (r < I_IN) { const int nb = r % (NZ / 32); const int coff = (nb * 32 >= 3072) ? 16 : 0;
            transpose_item(P.in[I_WIN], NIN, coff, NZ, (bf16*)(ws + WS_WIN), D, 0, 0, scr, r, lane); continue; } r -= I_IN;
        if (r < I_SQ) { transpose_item(P.in[I_WMO], D, 0, D, (bf16*)(ws + WS_WMO), 2 * D, 0, 0, scr, r, lane); transpose_item(P.in[I_WMO], D, 0, D, (bf16*)(ws + WS_WMO), 2 * D, 0, D, scr, r, lane); continue; } r -= I_SQ;
        if (r < I_SQ) { transpose_item(P.in[I_WXQ], D, 0, D, (bf16*)(ws + WS_WXQ), D, 0, 0, scr, r, lane); continue; } r -= I_SQ;
        if (r < I_SQ) { transpose_item(P.in[I_WXK], D, 0, D, (bf16*)(ws + WS_WXKV), D, 0, 0, scr, r, lane); continue; } r -= I_SQ;
        if (r < I_SQ) { transpose_item(P.in[I_WXV], D, 0, D, (bf16*)(ws + WS_WXKV), D, D, 0, scr, r, lane); continue; } r -= I_SQ;
        if (r < I_SQ) { transpose_item(P.in[I_WXO], D, 0, D, (bf16*)(ws + WS_WXO), D, 0, 0, scr, r, lane); continue; } r -= I_SQ;
        if (r < I_UP) { transpose_item(P.in[I_WUP], FF, 0, FF, (bf16*)(ws + WS_WUP), D, 0, 0, scr, r, lane); continue; } r -= I_UP;
        transpose_item(P.in[I_WDN], D, 0, D, (bf16*)(ws + WS_WDN), FF, 0, 0, scr, r, lane);
    }
    { float* tab = (float*)(ws + WS_ROPE);
      for (int e = (vcu * NTHR + tid); e < 2056 * 64; e += G * NTHR) { const int p = e >> 6, i = e & 63; const int pos = p < 2048 ? p : 16384 + (p - 2048);
          const float inv = (float)pow(10000.0, -(double)i / 64.0); const float ang = (float)pos * inv;
          tab[2 * e] = (float)cos((double)ang); tab[2 * e + 1] = (float)sin((double)ang); } }
    __syncthreads();
    for (int m = gw; m < NT + NMEM; m += NGW) {
        if (m < NT) { const float* xr = m < NP ? P.in[I_XP] + (size_t)m * D : P.in[I_XS] + (size_t)(m - NP) * D;
            rms_row_bf16<true>(xr, P.in[I_GPM], (bf16*)(ws + WS_H) + (size_t)m * D, wga, (float*)(ws + WS_GAL) + (size_t)m * 16, lane); }
        else { const int r = m - NT; rms_row_bf16<false>(P.in[I_MEM] + (size_t)r * D, P.in[I_GMEM], (bf16*)(ws + WS_MB) + (size_t)r * D, wga, nullptr, lane); }
    }
}

__device__ __forceinline__ void row_phase(const float* xop, const float* xos, const float* t, const float* g1, float* xnew, const float* g2, bf16* hn, int vcu, int G) {
    int tid = threadIdx.x; asm volatile("" : "+v"(tid));
    const int lane = tid & 63, wave = __builtin_amdgcn_readfirstlane(tid >> 6);
    const int gw = vcu * NWAVES + wave, NGW = G * NWAVES;
    for (int m = gw; m < NT; m += NGW) {
        const float* xo = (xos && m >= NP) ? xos + (size_t)(m - NP) * D : xop + (size_t)m * D;
        f32x4 tv[4], xv[4]; float s = 0.f;
#pragma unroll
        for (int j = 0; j < 4; ++j) { tv[j] = ((const f32x4*)(t + (size_t)m * D))[lane + 64 * j]; xv[j] = ((const f32x4*)xo)[lane + 64 * j]; s += (tv[j].x * tv[j].x + tv[j].y * tv[j].y) + (tv[j].z * tv[j].z + tv[j].w * tv[j].w); }
        const float rs = 1.0f / sqrtf(wave_sum(s) * (1.f / D) + EPS);
        float s2 = 0.f;
#pragma unroll
        for (int j = 0; j < 4; ++j) { const f32x4 gg = ((const f32x4*)g1)[lane + 64 * j]; xv[j] = xv[j] + tv[j] * rs * gg; ((f32x4*)(xnew + (size_t)m * D))[lane + 64 * j] = xv[j];
            s2 += (xv[j].x * xv[j].x + xv[j].y * xv[j].y) + (xv[j].z * xv[j].z + xv[j].w * xv[j].w); }
        if (hn) {
            const float rs2 = 1.0f / sqrtf(wave_sum(s2) * (1.f / D) + EPS);
#pragma unroll
            for (int j = 0; j < 4; ++j) { const f32x4 gg = ((const f32x4*)g2)[lane + 64 * j]; const f32x4 o = xv[j] * rs2 * gg; u32x2 w; w.x = pk2(o.x, o.y); w.y = pk2(o.z, o.w); ((u32x2*)(hn + (size_t)m * D))[lane + 64 * j] = w; }
        }
    }
}


constexpr int L_QT = 0, L_KT = 17408, L_KHT = 34816, L_P = 53248, L_OS = 0  , L_V = 66560, L_RQ = 103424, L_RK = 119808, L_GAL = 136192, L_PRE = 140288, L_EBL = 142336, L_P2END = 142848;
constexpr int QT_STR = 272, KHT_STR = 144, P_STR = 144, V_STR = 576, OS_STR = 260;
static_assert(L_P2END <= LDS_BYTES, "P2 LDS map");
__device__ __forceinline__ int dperm(int d) { return (d & ~12) | ((d & 4) << 1) | ((d & 8) >> 1); }

#define LAUNDER(x) asm volatile("" : "+v"(x))
#define P2_PREFETCH(cc_) do { const int rowp_ = row_base + (cc_) * 64; int tid = tid0; LAUNDER(tid); \
    _Pragma("unroll") for (int i = 0; i < 2; ++i) { const int ch = tid + 512 * i, t = ch >> 4, c8 = ch & 15; const bool ok = t < Tv; \
        pq[i] = ok ? *(const u32x4*)(Z + (size_t)(rowp_ + t) * NZ + cq + c8 * 8) : (u32x4){0u, 0u, 0u, 0u}; \
        pk[i] = ok ? *(const u32x4*)(Z + (size_t)(rowp_ + t) * NZ + ck + c8 * 8) : (u32x4){0u, 0u, 0u, 0u}; } \
    _Pragma("unroll") for (int i = 0; i < 4; ++i) { const int ch = tid + 512 * i, t = ch >> 5, c8 = ch & 31; const bool ok = t < Tv; \
        pv[i] = ok ? *(const u32x4*)(Z + (size_t)(rowp_ + t) * NZ + cv + c8 * 8) : (u32x4){0u, 0u, 0u, 0u}; } \
    if (BR == 0) { const int t = tid >> 2, c4 = tid & 3; pga = (tid < 256 && t < Tv) ? *(const f32x4*)(GAL + (size_t)(rowp_ + t) * 16 + c4 * 4) : (f32x4){0.f, 0.f, 0.f, 0.f}; } } while (0)

template <int BR>
__device__ __forceinline__ void chain_unit(const Params& P, LAS unsigned char* lds, int b, int h, int row_base, int nch, int Tv, int pidx0, const float* s0, float* s_out) {
    const int tid0 = threadIdx.x, w = __builtin_amdgcn_readfirstlane(tid0 >> 6);
    const bf16* Z = (const bf16*)(P.ws + WS_Z);
    const float* GAL = (const float*)(P.ws + WS_GAL);
    const float* ROPE = (const float*)(P.ws + WS_ROPE);
    bf16* MG = (bf16*)(P.ws + WS_MG);
    const int cq = (BR == 0 ? ZC_GQ : ZC_RQ) + h * 128, ck = (BR == 0 ? ZC_GK : ZC_RK) + h * 128, cv = (BR == 0 ? ZC_GV : ZC_RV) + h * 256;
    const int cg1 = (BR == 0 ? ZC_GR : ZC_RG) + h * 256, cg2 = (BR == 0 ? ZC_GA : ZC_GB) + h * 256;
    const float* ghead = P.in[BR == 0 ? I_GGLA : I_GRET] + h * 256;
    const float scale = 0.08838834764831845f;
    const float lg = BR == 1 ? log1pf(-exp2f(-5.0f - (float)h)) : 0.f;
    f32x16 S[4];
    { const int r32 = tid0 & 31, hh = (tid0 >> 5) & 1;
#pragma unroll
    for (int T = 0; T < 4; ++T)
#pragma unroll
        for (int rg = 0; rg < 16; ++rg) S[T][rg] = s0 ? s0[((size_t)(b * 4 + h) * 128 + 32 * T + crow(rg, hh)) * 256 + 32 * w + r32] : 0.f; }
    u32x4 pq[2], pk[2], pv[4]; f32x4 pga = (f32x4){0.f, 0.f, 0.f, 0.f};
    P2_PREFETCH(0);
    for (int c = 0; c < nch; ++c) {
        const int rowc = row_base + c * 64;
        { int tid = tid0; LAUNDER(tid);
#pragma unroll
        for (int i = 0; i < 2; ++i) { const int ch = tid + 512 * i, t = ch >> 4, c8 = ch & 15;
            *(LAS u32x4*)(lds + L_RQ + t * 256 + c8 * 16) = pq[i]; *(LAS u32x4*)(lds + L_RK + t * 256 + c8 * 16) = pk[i]; }
#pragma unroll
        for (int i = 0; i < 4; ++i) { const int ch = tid + 512 * i, t = ch >> 5, c8 = ch & 31; *(LAS u32x4*)(lds + L_V + t * V_STR + c8 * 16) = pv[i]; }
        if (BR == 0 && tid < 256) *(LAS f32x4*)(lds + L_GAL + tid * 16) = pga; }
        __syncthreads();
        {
            int tid = tid0; LAUNDER(tid); const int pd = tid & 127, ptq = tid >> 7;
            const int pp = dperm(pd);
            unsigned kh[8];
            if (BR == 0) {
                float la[16];
                {
                    float w2r[16];
#pragma unroll
                    for (int r = 0; r < 16; ++r) w2r[r] = P.in[I_WA2][r * 512 + h * 128 + pd];
                    const float bias = P.in[I_BA][h * 128 + pd];
#pragma unroll
                    for (int i = 0; i < 16; ++i) { const int t = 16 * ptq + i;
                        float x = bias;
#pragma unroll
                        for (int q4 = 0; q4 < 4; ++q4) { const f32x4 g = *(const LAS f32x4*)(lds + L_GAL + t * 64 + q4 * 16); x += g.x * w2r[4 * q4] + g.y * w2r[4 * q4 + 1] + g.z * w2r[4 * q4 + 2] + g.w * w2r[4 * q4 + 3]; }
                        const float ls = fminf(x, 0.f) - __logf(1.0f + __expf(-fabsf(x)));
                        la[i] = t < Tv ? ls * (1.0f / 16.0f) : 0.f; }
                }
#pragma unroll
                for (int i = 1; i < 16; ++i) la[i] += la[i - 1];
                ((LAS float*)(lds + L_PRE))[ptq * 128 + pd] = la[15];
                __syncthreads();
                float base = 0.f, btot = 0.f;
#pragma unroll
                for (int q = 0; q < 4; ++q) { const float v = ((const LAS float*)(lds + L_PRE))[q * 128 + pd]; btot += v; if (q < ptq) base += v; }
                if (ptq == 0) ((LAS float*)(lds + L_EBL))[pd] = __expf(btot);
#pragma unroll
                for (int i = 0; i < 16; ++i) { const int t = 16 * ptq + i; const float bt = base + la[i];
                    const float qv = bf2f(*(const LAS unsigned short*)(lds + L_RQ + t * 256 + pd * 2)), kv = bf2f(*(const LAS unsigned short*)(lds + L_RK + t * 256 + pd * 2));
                    *(LAS unsigned short*)(lds + L_QT + t * QT_STR + pp * 2) = f2bf(qv * (__expf(bt) * scale));
                    *(LAS unsigned short*)(lds + L_KT + t * QT_STR + pp * 2) = f2bf(kv * __expf(-bt));
                    const float k3 = kv * __expf(btot - bt);
                    if (i & 1) kh[i >> 1] = (kh[i >> 1] & 0xffffu) | ((unsigned)f2bf(k3) << 16); else kh[i >> 1] = (unsigned)f2bf(k3); }
            } else {
                const float btot = (float)Tv * lg;
                if (ptq == 0) ((LAS float*)(lds + L_EBL))[pd] = __expf(btot);
                const int fi = pd & 63; const float sgn = pd < 64 ? -1.f : 1.f;
#pragma unroll
                for (int i = 0; i < 16; ++i) { const int t = 16 * ptq + i;
                    const float bt = (float)(t < Tv ? t + 1 : Tv) * lg;
                    const int pidx = pidx0 + c * 64 + (t < Tv ? t : 0);
                    const float cs = ROPE[(size_t)(pidx * 64 + fi) * 2], sn = ROPE[(size_t)(pidx * 64 + fi) * 2 + 1];
                    const float q1 = bf2f(*(const LAS unsigned short*)(lds + L_RQ + t * 256 + pd * 2)), q2 = bf2f(*(const LAS unsigned short*)(lds + L_RQ + t * 256 + (pd ^ 64) * 2));
                    const float k1 = bf2f(*(const LAS unsigned short*)(lds + L_RK + t * 256 + pd * 2)), k2 = bf2f(*(const LAS unsigned short*)(lds + L_RK + t * 256 + (pd ^ 64) * 2));
                    const float qv = q1 * cs + sgn * q2 * sn, kv = k1 * cs + sgn * k2 * sn;
                    *(LAS unsigned short*)(lds + L_QT + t * QT_STR + pp * 2) = f2bf(qv * __expf(bt));
                    *(LAS unsigned short*)(lds + L_KT + t * QT_STR + pp * 2) = f2bf(kv * (__expf(-bt) * scale));
                    const float k3 = kv * (__expf(btot - bt) * scale);
                    if (i & 1) kh[i >> 1] = (kh[i >> 1] & 0xffffu) | ((unsigned)f2bf(k3) << 16); else kh[i >> 1] = (unsigned)f2bf(k3); }
            }
            *(LAS u32x4*)(lds + L_KHT + pd * KHT_STR + ptq * 32) = (u32x4){kh[0], kh[1], kh[2], kh[3]};
            *(LAS u32x4*)(lds + L_KHT + pd * KHT_STR + ptq * 32 + 16) = (u32x4){kh[4], kh[5], kh[6], kh[7]};
        }
        u32x4 g1v[4], g2v[4];
        { int tid = tid0; LAUNDER(tid); const int et = tid >> 3, eseg = tid & 7; const bool ok = et < Tv;
#pragma unroll
          for (int i = 0; i < 4; ++i) { g1v[i] = ok ? *(const u32x4*)(Z + (size_t)(rowc + et) * NZ + cg1 + eseg * 32 + i * 8) : (u32x4){0u, 0u, 0u, 0u};
                                        g2v[i] = ok ? *(const u32x4*)(Z + (size_t)(rowc + et) * NZ + cg2 + eseg * 32 + i * 8) : (u32x4){0u, 0u, 0u, 0u}; } }
        if (c + 1 < nch) P2_PREFETCH(c + 1);
        __syncthreads();
        int lane = tid0 & 63; LAUNDER(lane); const int r32 = lane & 31, hh = lane >> 5;
        {
            const int fr = lane & 15, fq = lane >> 4, tb = w >> 1;
#pragma unroll
            for (int j = 0; j < 2; ++j) { const int sb = 2 * (w & 1) + j;
                pg8::f32x4 acc = (pg8::f32x4){0.f, 0.f, 0.f, 0.f};
                if (sb <= tb) {
#pragma unroll
                    for (int ks = 0; ks < 4; ++ks) {
                        const bf16x8 kf = *(const LAS bf16x8*)(lds + L_KT + (16 * sb + fr) * QT_STR + (32 * ks + 8 * fq) * 2);
                        const bf16x8 qf = *(const LAS bf16x8*)(lds + L_QT + (16 * tb + fr) * QT_STR + (32 * ks + 8 * fq) * 2);
                        acc = __builtin_amdgcn_mfma_f32_16x16x32_bf16(kf, qf, acc, 0, 0, 0);
                    }
                }
                const int tg = 16 * tb + fr;
                float v[4];
#pragma unroll
                for (int e = 0; e < 4; ++e) { const int sg = 16 * sb + 4 * fq + e; v[e] = sg <= tg ? acc[e] : 0.f; }
                u32x2 o; o.x = pk2(v[0], v[1]); o.y = pk2(v[2], v[3]);
                *(LAS u32x2*)(lds + L_P + tg * P_STR + (16 * sb + 4 * fq) * 2) = o;
            }
        }
        bf16x8 vf[4];
        { const int g16 = (lane >> 4) & 1, i16 = lane & 15, q_ = i16 >> 2, p_ = i16 & 3;
          const LAS unsigned char* vb = lds + L_V + (8 * hh + q_) * V_STR + (32 * w + 16 * g16 + 4 * p_) * 2;
#pragma unroll
          for (int ks = 0; ks < 4; ++ks) vf[ks] = cat8(vtr(vb + (16 * ks) * V_STR), vtr(vb + (16 * ks + 4) * V_STR)); }
        f32x16 O[2];
#pragma unroll
        for (int mi = 0; mi < 2; ++mi) {
#pragma unroll
            for (int rg = 0; rg < 16; ++rg) O[mi][rg] = 0.f; }
#pragma unroll
        for (int T = 0; T < 4; ++T)
#pragma unroll
            for (int s = 0; s < 2; ++s) { const bf16x8 sb = pack8(S[T], s);
#pragma unroll
                for (int mi = 0; mi < 2; ++mi) { const bf16x8 qf = *(const LAS bf16x8*)(lds + L_QT + (32 * mi + r32) * QT_STR + (32 * T + 16 * s + 8 * hh) * 2); O[mi] = MFMA32(qf, sb, O[mi]); } }
#pragma unroll
        for (int T = 0; T < 4; ++T) {
#pragma unroll
            for (int rg = 0; rg < 16; ++rg) S[T][rg] *= ((const LAS float*)(lds + L_EBL))[32 * T + crow(rg, hh)];
#pragma unroll
            for (int ks = 0; ks < 4; ++ks) { const bf16x8 kf = *(const LAS bf16x8*)(lds + L_KHT + (32 * T + r32) * KHT_STR + (16 * ks + 8 * hh) * 2); S[T] = MFMA32(kf, vf[ks], S[T]); } }
        __syncthreads();
#pragma unroll
        for (int mi = 0; mi < 2; ++mi)
#pragma unroll
            for (int ks = 0; ks < 4; ++ks) { if (mi == 0 && ks >= 2) continue;
                const bf16x8 pf = *(const LAS bf16x8*)(lds + L_P + (32 * mi + r32) * P_STR + (16 * ks + 8 * hh) * 2); O[mi] = MFMA32(pf, vf[ks], O[mi]); }
        __syncthreads();
#pragma unroll
        for (int mi = 0; mi < 2; ++mi)
#pragma unroll
            for (int rg = 0; rg < 16; ++rg) ((LAS float*)(lds + L_OS))[(32 * mi + crow(rg, hh)) * OS_STR + 32 * w + r32] = O[mi][rg];
        __syncthreads();
        {
            int tid = tid0; LAUNDER(tid); const int et = tid >> 3, eseg = tid & 7;
            f32x4 ov[8];
#pragma unroll
            for (int i = 0; i < 8; ++i) ov[i] = *(const LAS f32x4*)(lds + L_OS + (et * OS_STR + eseg * 32 + i * 4) * 4);
            float mu = 0.f;
            if (BR == 1) { float s = 0.f;
#pragma unroll
                for (int i = 0; i < 8; ++i) s += (ov[i].x + ov[i].y) + (ov[i].z + ov[i].w);
                s += __shfl_xor(s, 1); s += __shfl_xor(s, 2); s += __shfl_xor(s, 4); mu = s * (1.0f / 256.0f); }
            float q = 0.f;
#pragma unroll
            for (int i = 0; i < 8; ++i) { ov[i] = ov[i] - mu; q += (ov[i].x * ov[i].x + ov[i].y * ov[i].y) + (ov[i].z * ov[i].z + ov[i].w * ov[i].w); }
            q += __shfl_xor(q, 1); q += __shfl_xor(q, 2); q += __shfl_xor(q, 4);
            const float rstd = 1.0f / sqrtf(q * (1.0f / 256.0f) + EPS);
            if (et < Tv) {
                bf16* orow = MG + (size_t)(rowc + et) * 2048 + BR * 1024 + h * 256 + eseg * 32;
#pragma unroll
                for (int i = 0; i < 4; ++i) {
                    const f32x4 ga = *(const f32x4*)(ghead + eseg * 32 + i * 8), gb = *(const f32x4*)(ghead + eseg * 32 + i * 8 + 4);
                    const float gg[8] = {ga.x, ga.y, ga.z, ga.w, gb.x, gb.y, gb.z, gb.w};
                    const float oo[8] = {ov[2 * i].x, ov[2 * i].y, ov[2 * i].z, ov[2 * i].w, ov[2 * i + 1].x, ov[2 * i + 1].y, ov[2 * i + 1].z, ov[2 * i + 1].w};
                    const unsigned w1[4] = {g1v[i].x, g1v[i].y, g1v[i].z, g1v[i].w}, w2[4] = {g2v[i].x, g2v[i].y, g2v[i].z, g2v[i].w};
                    float res[8];
#pragma unroll
                    for (int e = 0; e < 8; ++e) { const float a = (e & 1) ? bfhi(w1[e >> 1]) : bflo(w1[e >> 1]); const float gt = (e & 1) ? bfhi(w2[e >> 1]) : bflo(w2[e >> 1]);
                        const float y = oo[e] * rstd * gg[e];
                        res[e] = y * a / ((1.0f + __expf(-a)) * (1.0f + __expf(-gt))); }
                    u32x4 o; o.x = pk2(res[0], res[1]); o.y = pk2(res[2], res[3]); o.z = pk2(res[4], res[5]); o.w = pk2(res[6], res[7]);
                    *(u32x4*)(orow + i * 8) = o;
                }
            }
        }
        __syncthreads();
    }
    const int r32 = tid0 & 31, hh = (tid0 >> 5) & 1;
#pragma unroll
    for (int T = 0; T < 4; ++T)
#pragma unroll
        for (int rg = 0; rg < 16; ++rg) s_out[((size_t)(b * 4 + h) * 128 + 32 * T + crow(rg, hh)) * 256 + 32 * w + r32] = S[T][rg];
}

__device__ __forceinline__ void phase2(const Params& P, LAS unsigned char* lds, int vcu, int G) {
    const bool prompt = vcu < 64; const int nw = G - 64;
    for (int u = prompt ? vcu : vcu - 64; u < (prompt ? 64 : 1024); u += (prompt ? 64 : nw)) {
        const int br = u & 1, h = (u >> 1) & 3, b = u >> 3;
        const int row_base = prompt ? b * 2048 : NP + b * 8, nch = prompt ? 32 : 1, Tv = prompt ? 64 : 8, pidx0 = prompt ? 0 : 2048;
        if (br == 0) chain_unit<0>(P, lds, b, h, row_base, nch, Tv, pidx0, prompt ? nullptr : P.in[I_SG], P.out + (prompt ? O_SGP : O_SGS));
        else         chain_unit<1>(P, lds, b, h, row_base, nch, Tv, pidx0, prompt ? nullptr : P.in[I_SR], P.out + (prompt ? O_SRP : O_SRS));
    }
}

constexpr int A_K = 0, AK_STR = 272, A_V = 34816, AV_STR = 320, A_END = 34816 + 40960;
#define P6_STAGE(src_, mt_, ch_, lbase_, lstr_) do { \
    _Pragma("unroll") for (int i = 0; i < 4; ++i) { const int ch = tid + 512 * i, m = ch >> 4, c8 = ch & 15; \
        const size_t off = (((size_t)b * 256 + 128 * (mt_) + m) * 4 + h) * 256 + 128 * (ch_) + c8 * 8; \
        u32x4 v; \
        if (F32SRC) { const f32x4 a = *(const f32x4*)((const float*)(src_) + off), c = *(const f32x4*)((const float*)(src_) + off + 4); v.x = pk2(a.x, a.y); v.y = pk2(a.z, a.w); v.z = pk2(c.x, c.y); v.w = pk2(c.z, c.w); } \
        else v = *(const u32x4*)((const bf16*)(src_) + off); \
        *(LAS u32x4*)(lds + (lbase_) + m * (lstr_) + c8 * 16) = v; } } while (0)

template <bool F32SRC>
__device__ __forceinline__ void attn_unit(const Params& P, LAS unsigned char* lds, int b, int h, int row0, int nq, const void* Kp, const void* Vp) {
    int tid = threadIdx.x; asm volatile("" : "+v"(tid));
    const int lane = tid & 63, w = __builtin_amdgcn_readfirstlane(tid >> 6), r32 = lane & 31, hh = lane >> 5;
    const bf16* Q = (const bf16*)(P.ws + WS_Q); bf16* Oo = (bf16*)(P.ws + WS_O);
    const bool active = (32 * w) < nq;
    const int t = 32 * w + r32; const bool tok = t < nq;
    f32x16 sT[8];
#pragma unroll
    for (int i = 0; i < 8; ++i)
#pragma unroll
        for (int rg = 0; rg < 16; ++rg) sT[i][rg] = 0.f;
#pragma unroll
    for (int dh = 0; dh < 2; ++dh) {
        bf16x8 qf[8];
#pragma unroll
        for (int ks = 0; ks < 8; ++ks) qf[ks] = tok ? *(const bf16x8*)(Q + (size_t)(row0 + t) * D + h * 256 + 128 * dh + 16 * ks + 8 * hh) : (bf16x8){0, 0, 0, 0, 0, 0, 0, 0};
#pragma unroll
        for (int mt = 0; mt < 2; ++mt) {
            P6_STAGE(Kp, mt, dh, A_K, AK_STR);
            __syncthreads();
            if (active) {
#pragma unroll
                for (int mi = 0; mi < 4; ++mi)
#pragma unroll
                    for (int ks = 0; ks < 8; ++ks) { const bf16x8 kf = *(const LAS bf16x8*)(lds + A_K + (32 * mi + r32) * AK_STR + (16 * ks + 8 * hh) * 2);
                        sT[4 * mt + mi] = MFMA32(kf, qf[ks], sT[4 * mt + mi]); }
            }
            __syncthreads();
        }
    }
    float mx = -3.0e38f;
#pragma unroll
    for (int i = 0; i < 8; ++i)
#pragma unroll
        for (int rg = 0; rg < 16; ++rg) mx = fmaxf(mx, sT[i][rg]);
    mx = fmaxf(mx, __shfl_xor(mx, 32));
    const float c2 = 0.0625f * 1.4426950408889634f;
    float sum = 0.f;
    bf16x8 pf[8][2];
#pragma unroll
    for (int i = 0; i < 8; ++i) {
#pragma unroll
        for (int rg = 0; rg < 16; ++rg) { const float p = __builtin_amdgcn_exp2f((sT[i][rg] - mx) * c2); sT[i][rg] = p; sum += p; }
        pf[i][0] = pack8(sT[i], 0); pf[i][1] = pack8(sT[i], 1); }
    sum += __shfl_xor(sum, 32);
    const float rinv = 1.0f / sum;
    const int g16 = (lane >> 4) & 1, i16 = lane & 15, q_ = i16 >> 2, p_ = i16 & 3;
#pragma unroll
    for (int nh = 0; nh < 2; ++nh) {
        f32x16 oT[4];
#pragma unroll
        for (int i = 0; i < 4; ++i)
#pragma unroll
            for (int rg = 0; rg < 16; ++rg) oT[i][rg] = 0.f;
#pragma unroll
        for (int mt = 0; mt < 2; ++mt) {
            P6_STAGE(Vp, mt, nh, A_V, AV_STR);
            __syncthreads();
            if (active) {
#pragma unroll
                for (int mi = 0; mi < 4; ++mi)
#pragma unroll
                    for (int s = 0; s < 2; ++s) {
                        const bf16x8 pb = pf[4 * mt + mi][s];
#pragma unroll
                        for (int nt = 0; nt < 4; ++nt) {
                            const LAS unsigned char* vb = lds + A_V + (32 * mi + 16 * s + 4 * hh + q_) * AV_STR + (32 * nt + 16 * g16 + 4 * p_) * 2;
                            const bf16x8 va = cat8(vtr(vb), vtr(vb + 8 * AV_STR));
                            oT[nt] = MFMA32(va, pb, oT[nt]);
                        }
                    }
            }
            __syncthreads();
        }
        if (tok) {
            bf16* orow = Oo + (size_t)(row0 + t) * D + h * 256 + 128 * nh;
#pragma unroll
            for (int nt = 0; nt < 4; ++nt)
#pragma unroll
                for (int g = 0; g < 4; ++g) { u32x2 o; o.x = pk2(oT[nt][4 * g] * rinv, oT[nt][4 * g + 1] * rinv); o.y = pk2(oT[nt][4 * g + 2] * rinv, oT[nt][4 * g + 3] * rinv);
                    *(u32x2*)(orow + 32 * nt + 8 * g + 4 * hh) = o; }
        }
    }
}
__device__ __forceinline__ void phase6(const Params& P, LAS unsigned char* lds, int vcu, int G) {
    for (int u = vcu; u < 256 + 512; u += G) {
        if (u < 256) { const int qb = u & 7, h = (u >> 3) & 3, b = u >> 5; attn_unit<false>(P, lds, b, h, b * 2048 + qb * 256, 256, P.ws + WS_MKB, P.ws + WS_MVB); }
        else { const int v = u - 256, h = v & 3, b = v >> 2; attn_unit<true>(P, lds, b, h, NP + b * 8, 8, P.in[I_CK], P.in[I_CV]); }
    }
}

__global__ void __launch_bounds__(NTHR, 2) mega_fwd(Params P) {
    extern __shared__ __attribute__((aligned(16))) unsigned char lds_raw[];
    LAS unsigned char* lds = (LAS unsigned char*)lds_raw;
    cg::grid_group grid = cg::this_grid();
    const int G = gridDim.x; const int bx = blockIdx.x; const int vcu = (G % 8 == 0) ? (bx % 8) * (G / 8) + bx / 8 : bx;
    unsigned char* ws = P.ws;
    const int stop = P.stop_after;
#define SEAM(k) do { if (stop <= (k)) return; grid.sync(); } while (0)
#ifndef NO_P0
    phase0(P, lds, vcu, G);
#endif
    SEAM(0);
    { pg8::Gemm g{(const bf16*)(ws + WS_H), (const bf16*)(ws + WS_WIN), NT, NZ, D}; pg8::StaticOrder S; S.init(NT, NZ, G, bx);
      pg8::EpiBf16<0> E{(bf16*)(ws + WS_Z), NZ};
      pg8::gemm_phase<pg8::EpiBf16<0>, pg8::StaticOrder, true, true>(lds, g, S, E); }
    { pg8::Gemm g{(const bf16*)(ws + WS_MB), (const bf16*)(ws + WS_WXKV), NMEM, 2 * D, D}; pg8::StaticOrder S; S.init(NMEM, 2 * D, G, (bx >= G / 2) ? bx - G / 2 : -1);
      pg8::EpiKV E{P.out + O_MK, P.out + O_MV, (bf16*)(ws + WS_MKB), (bf16*)(ws + WS_MVB)};
      pg8::gemm_phase<pg8::EpiKV, pg8::StaticOrder, true, true>(lds, g, S, E); }
    SEAM(1);
#ifndef NO_P2
    phase2(P, lds, vcu, G);
#endif
    SEAM(2);
    { pg8::Gemm g{(const bf16*)(ws + WS_MG), (const bf16*)(ws + WS_WMO), NT, D, 2 * D}; pg8::StaticOrder S; S.init(NT, D, G, bx);
      pg8::EpiF32 E{(float*)(ws + WS_T), D};
      pg8::gemm_phase<pg8::EpiF32, pg8::StaticOrder, true, true>(lds, g, S, E); }
    SEAM(3);
    row_phase(P.in[I_XP], P.in[I_XS], (const float*)(ws + WS_T), P.in[I_GQM], P.out + O_YP, P.in[I_GPX], (bf16*)(ws + WS_H), vcu, G);
    SEAM(4);
    { pg8::Gemm g{(const bf16*)(ws + WS_H), (const bf16*)(ws + WS_WXQ), NT, D, D}; pg8::StaticOrder S; S.init(NT, D, G, bx);
      pg8::EpiBf16<0> E{(bf16*)(ws + WS_Q), D};
      pg8::gemm_phase<pg8::EpiBf16<0>, pg8::StaticOrder, true, true>(lds, g, S, E); }
    SEAM(5);
#ifndef NO_P6
    phase6(P, lds, vcu, G);
#endif
    SEAM(6);
    { pg8::Gemm g{(const bf16*)(ws + WS_O), (const bf16*)(ws + WS_WXO), NT, D, D}; pg8::StaticOrder S; S.init(NT, D, G, bx);
      pg8::EpiF32 E{(float*)(ws + WS_T), D};
      pg8::gemm_phase<pg8::EpiF32, pg8::StaticOrder, true, true>(lds, g, S, E); }
    SEAM(7);
    row_phase(P.out + O_YP, nullptr, (const float*)(ws + WS_T), P.in[I_GQX], P.out + O_YP, P.in[I_GPF], (bf16*)(ws + WS_H), vcu, G);
    SEAM(8);
    { pg8::Gemm g{(const bf16*)(ws + WS_H), (const bf16*)(ws + WS_WUP), NT, FF, D}; pg8::StaticOrder S; S.init(NT, FF, G, bx);
      pg8::EpiBf16<2> E{(bf16*)(ws + WS_U), FF};
      pg8::gemm_phase<pg8::EpiBf16<2>, pg8::StaticOrder, true, true>(lds, g, S, E); }
    SEAM(9);
    { pg8::Gemm g{(const bf16*)(ws + WS_U), (const bf16*)(ws + WS_WDN), NT, D, FF}; pg8::StaticOrder S; S.init(NT, D, G, bx);
      pg8::EpiF32 E{(float*)(ws + WS_T), D};
      pg8::gemm_phase<pg8::EpiF32, pg8::StaticOrder, true, true>(lds, g, S, E); }
    SEAM(10);
    row_phase(P.out + O_YP, nullptr, (const float*)(ws + WS_T), P.in[I_GQF], P.out + O_YP, nullptr, nullptr, vcu, G);
#undef SEAM
}
}


#ifndef HYBRID
#define HYBRID 0
#endif
extern "C" void kernel_launch(void* const* d_in, const int* in_sizes, int n_in, void* d_out, int out_size, void* d_ws, size_t ws_size, hipStream_t stream) {
    static int grid = 0;
    if (grid == 0) {
        if (n_in != 26 || out_size != (int)mk::O_END || ws_size < mk::WS_END) { fprintf(stderr, "kernel_launch: unexpected sizes n_in %d out %d ws %zu\n", n_in, out_size, ws_size); grid = -1; return; }
        int dev = 0, cus = 0, per_cu = 0;
        if (hipGetDevice(&dev) != hipSuccess || hipDeviceGetAttribute(&cus, hipDeviceAttributeMultiprocessorCount, dev) != hipSuccess) { grid = -1; return; }
        if (hipFuncSetAttribute((const void*)mk::mega_fwd, hipFuncAttributeMaxDynamicSharedMemorySize, mk::LDS_BYTES) != hipSuccess) { fprintf(stderr, "kernel_launch: hipFuncSetAttribute failed\n"); grid = -1; return; }
        if (hipOccupancyMaxActiveBlocksPerMultiprocessor(&per_cu, (const void*)mk::mega_fwd, mk::NTHR, mk::LDS_BYTES) != hipSuccess || per_cu < 1) { fprintf(stderr, "kernel_launch: occupancy query says %d\n", per_cu); grid = -1; (void)hipGetLastError(); return; }
        grid = cus;
    }
    if (grid < 0) return;
    mk::Params p{};
    for (int i = 0; i < 26; ++i) p.in[i] = (const float*)d_in[i];
    p.out = (float*)d_out; p.ws = (unsigned char*)d_ws; p.stop_after = 100; p.pad = 0;
    void* args[] = {&p};
    hipError_t e = hipLaunchCooperativeKernel((const void*)mk::mega_fwd, dim3(grid), dim3(mk::NTHR), args, mk::LDS_BYTES, stream);
    if (e != hipSuccess) fprintf(stderr, "cooperative launch failed: %s (grid %d)\n", hipGetErrorString(e), grid);
}
```

```cpp
#include <hip/hip_runtime.h>
#include <cstdio>
#include <cstdint>

namespace pg8 {
#define PG8_LAS __attribute__((address_space(3)))
typedef unsigned short bf16_t;
typedef short bf16x8 __attribute__((ext_vector_type(8)));
typedef float f32x4 __attribute__((ext_vector_type(4)));
typedef unsigned u32x4 __attribute__((ext_vector_type(4)));
typedef unsigned u32x2 __attribute__((ext_vector_type(2)));
constexpr int BM = 256, BK = 64, HALF = 128, HTB = HALF * BK * 2  , STAGE_BYTES = 8 * HTB, NXCD = 8, WGM = 8;

__host__ __device__ __forceinline__ int lds_byte(int r, int c) { const int st = (r >> 4) * 2 + (c >> 5), rr = r & 15, cc = c & 31, ob = rr * 64 + cc * 2; return st * 1024 + (ob ^ (((ob >> 9) & 1) << 5)); }
__host__ __device__ __forceinline__ void stage_rc(int b, int& R, int& C) { const int st = b / 1024, sb = b % 1024, swz = sb ^ (((sb >> 9) & 1) << 5); R = (st >> 1) * 16 + swz / 64; C = (st & 1) * 32 + (swz % 64) / 2; }
__host__ __device__ __forceinline__ int perm32(int rho) { const int n = rho >> 4, i = rho & 15; return 8 * (i >> 2) + 4 * n + (i & 3); }

struct Unit { int pm, pn; };
struct Gemm { const bf16_t* A; const bf16_t* Bt; int M, N, K; };

struct StaticOrder {
    int nM, nN, nwg, G, c;
    __host__ __device__ void init(int M, int N, int G_, int c_) { nM = M / BM; nN = N / BM; nwg = nM * nN; G = G_; c = c_; }
    __host__ __device__ bool next(int i, Unit& u) const {
        if (c < 0) return false;
        const long L = (long)i * G + c; if (L >= nwg) return false;
        int wgid = (int)L; { const int q = nwg / NXCD, r = nwg % NXCD, xcd = wgid % NXCD, off = wgid / NXCD; wgid = (xcd < r ? xcd * (q + 1) : r * (q + 1) + (xcd - r) * q) + off; }
        const int nig = WGM * nN, gid = wgid / nig, fm = gid * WGM, gsz = (nM - fm) < WGM ? (nM - fm) : WGM;
        u.pm = fm + ((wgid % nig) % gsz); u.pn = (wgid % nig) / gsz; return true;
    }
    __device__ __forceinline__ void a_ready(const Unit&) const {}
    __device__ __forceinline__ void done(const Unit&) const {}
};

typedef float f32x2_t __attribute__((ext_vector_type(2))); typedef __bf16 bf16x2_t __attribute__((ext_vector_type(2)));
__device__ __forceinline__ unsigned cvt_pk_bf16(float lo, float hi) { f32x2_t v = {lo, hi}; bf16x2_t b = __builtin_convertvector(v, bf16x2_t); return __builtin_bit_cast(unsigned, b); }

template <int ACT  > struct EpiBf16 {
    static constexpr bool PERM = true, AFTER_DRAIN = false;
    bf16_t* O; int ldc;
    __device__ __forceinline__ void operator()(const f32x4 (&acc)[2][2][4][2], const Unit& u, int wr, int wc, int fr, int fq) const {
        const int row0 = u.pm * BM + wr * 64 + fr; const int col0 = u.pn * BM + wc * 32 + 8 * fq;
#pragma unroll
        for (int ai = 0; ai < 2; ++ai)
#pragma unroll
            for (int m = 0; m < 4; ++m) { bf16_t* rowp = O + (size_t)(row0 + ai * HALF + m * 16) * ldc + col0;
#pragma unroll
                for (int bj = 0; bj < 2; ++bj) { f32x4 v0 = acc[ai][bj][m][0], v1 = acc[ai][bj][m][1];
                    if (ACT == 2) {
#pragma unroll
                        for (int e = 0; e < 4; ++e) { const float a = v0[e] > 0.f ? v0[e] : 0.f, b = v1[e] > 0.f ? v1[e] : 0.f; v0[e] = a * a; v1[e] = b * b; } }
                    u32x4 w; w.x = cvt_pk_bf16(v0[0], v0[1]); w.y = cvt_pk_bf16(v0[2], v0[3]); w.z = cvt_pk_bf16(v1[0], v1[1]); w.w = cvt_pk_bf16(v1[2], v1[3]);
                    *(u32x4*)(rowp + bj * HALF) = w; } }
    }
};
struct EpiF32 {
    static constexpr bool PERM = false, AFTER_DRAIN = false;
    float* O; int ldc;
    __device__ __forceinline__ void operator()(const f32x4 (&acc)[2][2][4][2], const Unit& u, int wr, int wc, int fr, int fq) const {
        const int row0 = u.pm * BM + wr * 64 + fr; const int col0 = u.pn * BM + wc * 32 + 4 * fq;
#pragma unroll
        for (int ai = 0; ai < 2; ++ai)
#pragma unroll
            for (int m = 0; m < 4; ++m) { float* rowp = O + (size_t)(row0 + ai * HALF + m * 16) * ldc + col0;
#pragma unroll
                for (int bj = 0; bj < 2; ++bj)
#pragma unroll
                    for (int n = 0; n < 2; ++n) *(f32x4*)(rowp + bj * HALF + n * 16) = acc[ai][bj][m][n]; }
    }
};
struct EpiKV {
    static constexpr bool PERM = false, AFTER_DRAIN = false;
    float* OK; float* OV; bf16_t* BK_; bf16_t* BV_;
    __device__ __forceinline__ void operator()(const f32x4 (&acc)[2][2][4][2], const Unit& u, int wr, int wc, int fr, int fq) const {
        const int row0 = u.pm * BM + wr * 64 + fr; const bool isv = u.pn >= 4; const int col0 = (u.pn & 3) * BM + wc * 32 + 4 * fq;
        float* Of = isv ? OV : OK; bf16_t* Ob = isv ? BV_ : BK_;
#pragma unroll
        for (int ai = 0; ai < 2; ++ai)
#pragma unroll
            for (int m = 0; m < 4; ++m) { const size_t ro = (size_t)(row0 + ai * HALF + m * 16) * 1024 + col0;
#pragma unroll
                for (int bj = 0; bj < 2; ++bj)
#pragma unroll
                    for (int n = 0; n < 2; ++n) { const f32x4 v = acc[ai][bj][m][n]; *(f32x4*)(Of + ro + bj * HALF + n * 16) = v;
                        u32x2 w; w.x = cvt_pk_bf16(v[0], v[1]); w.y = cvt_pk_bf16(v[2], v[3]); *(u32x2*)(Ob + ro + bj * HALF + n * 16) = w; } }
    }
};

template <class Epi, class Sched, bool ALIGN_EPI = false, bool SP2 = false>
__device__ __forceinline__ void gemm_phase(PG8_LAS unsigned char* lds, const Gemm g, const Sched& S, const Epi& E) {
    int tid = threadIdx.x; asm volatile("" : "+v"(tid));
    const int wid = __builtin_amdgcn_readfirstlane(tid >> 6), lane = tid & 63, wr = wid >> 2, wc = wid & 3, fr = lane & 15, fq = lane >> 4;
    const int K = g.K, nt = K / BK;
    unsigned voffA[2], voffB[2];
#pragma unroll
    for (int i = 0; i < 2; ++i) { int R, C; stage_rc(tid * 16 + i * 8192, R, C); const int Rb = Epi::PERM ? ((R & ~31) + perm32(R & 31)) : R;
        voffA[i] = (unsigned)(R * K + C) * 2u; voffB[i] = (unsigned)(Rb * K + C) * 2u; }
    const size_t kstep = (size_t)(BK * 2);
    const size_t hstep = (size_t)HALF * K * 2;
    const size_t tstep = 2 * hstep;
    const unsigned ldsw = (unsigned)wid * 1024u;
    const int aoff = lds_byte(wr * 64 + fr, fq * 8), boff = lds_byte(wc * 32 + fr, fq * 8);
#define PG8_SA(b, h) (((b) * 2 + (h)) * HTB)
#define PG8_SB(b, h) ((4 + (b) * 2 + (h)) * HTB)
#define PG8_STAGE(bufoff, gbase, voff) do { _Pragma("unroll") for (int _i = 0; _i < 2; ++_i) \
        __builtin_amdgcn_global_load_lds((const unsigned*)((const char*)(gbase) + (voff)[_i]), (PG8_LAS unsigned*)(lds + (bufoff) + ldsw + _i * 8192), 16, 0, 0); } while (0)
#define PG8_LDA(dst, b, h) do { _Pragma("unroll") for (int m = 0; m < 4; ++m) _Pragma("unroll") for (int k = 0; k < 2; ++k) dst[m][k] = *(const PG8_LAS bf16x8*)(lds + PG8_SA(b, h) + aoff + m * 2048 + k * 1024); } while (0)
#define PG8_LDB(dst, b, h) do { _Pragma("unroll") for (int n = 0; n < 2; ++n) _Pragma("unroll") for (int k = 0; k < 2; ++k) dst[n][k] = *(const PG8_LAS bf16x8*)(lds + PG8_SB(b, h) + boff + n * 2048 + k * 1024); } while (0)
#define PG8_MMA(ai, bj, At, Bt) do { __builtin_amdgcn_s_setprio(1); _Pragma("unroll") for (int m = 0; m < 4; ++m) _Pragma("unroll") for (int n = 0; n < 2; ++n) _Pragma("unroll") for (int k = 0; k < 2; ++k) \
        acc[ai][bj][m][n] = __builtin_amdgcn_mfma_f32_16x16x32_bf16(Bt[n][k], At[m][k], acc[ai][bj][m][n], 0, 0, 0); __builtin_amdgcn_s_setprio(0); } while (0)
#define PG8_WAIT_V(n) asm volatile("s_waitcnt vmcnt(" #n ")" ::: "memory")
#define PG8_WAIT_L(n) asm volatile("s_waitcnt lgkmcnt(" #n ")" ::: "memory")
#define PG8_BAR __builtin_amdgcn_s_barrier()
#define PG8_SCHED __builtin_amdgcn_sched_barrier(0)
    Unit cur, nxt; int ui = 0;
    if (!S.next(0, cur)) return;
    f32x4 acc[2][2][4][2];
#pragma unroll
    for (int a = 0; a < 2; ++a)
#pragma unroll
        for (int b = 0; b < 2; ++b)
#pragma unroll
            for (int m = 0; m < 4; ++m)
#pragma unroll
                for (int n = 0; n < 2; ++n) acc[a][b][m][n] = (f32x4){0.f, 0.f, 0.f, 0.f};
    bf16x8 At[4][2], B0[2][2], B1[2][2];
    const char* cA = (const char*)g.A + (size_t)cur.pm * tstep; const char* cB = (const char*)g.Bt + (size_t)cur.pn * tstep;
    S.a_ready(cur);
    if constexpr (SP2) {
        PG8_STAGE(PG8_SB(0, 0), cB, voffB); PG8_STAGE(PG8_SB(0, 1), cB + hstep, voffB); PG8_STAGE(PG8_SA(0, 0), cA, voffA); PG8_STAGE(PG8_SA(0, 1), cA + hstep, voffA);
        if (wr == 1) PG8_BAR;
        PG8_WAIT_V(2); PG8_BAR;
        PG8_STAGE(PG8_SB(1, 0), cB + kstep, voffB); PG8_STAGE(PG8_SA(1, 0), cA + kstep, voffA); PG8_STAGE(PG8_SB(1, 1), cB + hstep + kstep, voffB);
        PG8_WAIT_V(6); PG8_BAR;
    } else {
        PG8_STAGE(PG8_SB(0, 0), cB, voffB); PG8_STAGE(PG8_SA(0, 0), cA, voffA); PG8_STAGE(PG8_SB(0, 1), cB + hstep, voffB); PG8_STAGE(PG8_SA(0, 1), cA + hstep, voffA);
        if (wr == 1) PG8_BAR;
        PG8_WAIT_V(4); PG8_BAR;
        PG8_STAGE(PG8_SB(1, 0), cB + kstep, voffB); PG8_STAGE(PG8_SA(1, 0), cA + kstep, voffA); PG8_STAGE(PG8_SB(1, 1), cB + hstep + kstep, voffB);
        PG8_WAIT_V(6); PG8_BAR;
    }
    for (;;) {
        const bool has_next = S.next(ui + 1, nxt);
        const char* nA = has_next ? (const char*)g.A + (size_t)nxt.pm * tstep : cA; const char* nB = has_next ? (const char*)g.Bt + (size_t)nxt.pn * tstep : cB;
        for (int t = 0; t < nt; t += 2) {
            const bool last = (t == nt - 2);
            const char* a1 = cA + (size_t)(t + 1) * kstep;
            const char* a2 = last ? nA : cA + (size_t)(t + 2) * kstep; const char* b2 = last ? nB : cB + (size_t)(t + 2) * kstep;
            const char* a3 = a2 + kstep; const char* b3 = b2 + kstep;
            if (last && has_next) S.a_ready(nxt);
            if constexpr (SP2) {
            PG8_LDB(B0, 0, 0); PG8_LDB(B1, 0, 1); PG8_SCHED; PG8_LDA(At, 0, 0); PG8_STAGE(PG8_SA(1, 1), a1 + hstep, voffA);
            PG8_WAIT_V(8); PG8_WAIT_L(0); PG8_BAR; PG8_MMA(0, 0, At, B0); PG8_MMA(0, 1, At, B1); PG8_BAR; PG8_SCHED;
            PG8_LDA(At, 0, 1); PG8_STAGE(PG8_SB(0, 0), b2, voffB); PG8_STAGE(PG8_SB(0, 1), b2 + hstep, voffB); PG8_STAGE(PG8_SA(0, 0), a2, voffA);
            PG8_WAIT_V(8); PG8_WAIT_L(0); PG8_BAR; PG8_MMA(1, 0, At, B0); PG8_MMA(1, 1, At, B1); PG8_BAR; PG8_SCHED;
            PG8_LDB(B0, 1, 0); PG8_LDB(B1, 1, 1); PG8_SCHED; PG8_LDA(At, 1, 0); PG8_STAGE(PG8_SA(0, 1), a2 + hstep, voffA);
            PG8_WAIT_V(8); PG8_WAIT_L(0); PG8_BAR; PG8_MMA(0, 0, At, B0); PG8_MMA(0, 1, At, B1); PG8_BAR; PG8_SCHED;
            PG8_LDA(At, 1, 1); PG8_STAGE(PG8_SB(1, 0), b3, voffB); PG8_STAGE(PG8_SB(1, 1), b3 + hstep, voffB); PG8_STAGE(PG8_SA(1, 0), a3, voffA);
            PG8_WAIT_V(8); PG8_WAIT_L(0); PG8_BAR; PG8_MMA(1, 0, At, B0); PG8_MMA(1, 1, At, B1); PG8_BAR; PG8_SCHED;
            } else {
            PG8_LDB(B0, 0, 0); PG8_SCHED; PG8_LDA(At, 0, 0); PG8_STAGE(PG8_SA(1, 1), a1 + hstep, voffA);
            PG8_WAIT_L(8); PG8_BAR; PG8_WAIT_L(0); PG8_MMA(0, 0, At, B0); PG8_BAR; PG8_SCHED;
            PG8_LDB(B1, 0, 1); PG8_STAGE(PG8_SB(0, 0), b2, voffB);
            PG8_BAR; PG8_WAIT_L(0); PG8_MMA(0, 1, At, B1); PG8_BAR;
            PG8_LDA(At, 0, 1); PG8_STAGE(PG8_SA(0, 0), a2, voffA);
            PG8_BAR; PG8_WAIT_L(0); PG8_MMA(1, 0, At, B0); PG8_BAR; PG8_SCHED;
            PG8_STAGE(PG8_SB(0, 1), b2 + hstep, voffB);
            PG8_WAIT_V(6); PG8_BAR; PG8_MMA(1, 1, At, B1); PG8_BAR;
            PG8_LDB(B0, 1, 0); PG8_SCHED; PG8_LDA(At, 1, 0); PG8_STAGE(PG8_SA(0, 1), a2 + hstep, voffA);
            PG8_WAIT_L(8); PG8_BAR; PG8_WAIT_L(0); PG8_MMA(0, 0, At, B0); PG8_BAR; PG8_SCHED;
            PG8_LDB(B1, 1, 1); PG8_STAGE(PG8_SB(1, 0), b3, voffB);
            PG8_BAR; PG8_WAIT_L(0); PG8_MMA(0, 1, At, B1); PG8_BAR;
            PG8_LDA(At, 1, 1); PG8_STAGE(PG8_SA(1, 0), a3, voffA);
            PG8_BAR; PG8_WAIT_L(0); PG8_MMA(1, 0, At, B0); PG8_BAR; PG8_SCHED;
            PG8_STAGE(PG8_SB(1, 1), b3 + hstep, voffB);
            PG8_WAIT_V(6); PG8_BAR; PG8_MMA(1, 1, At, B1); PG8_BAR;
            }
        }
        if constexpr (ALIGN_EPI) { if (wr == 0) PG8_BAR; }
        if constexpr (!Epi::AFTER_DRAIN) { E(acc, cur, wr, wc, fr, fq); S.done(cur); }
        if (!has_next) break;
#pragma unroll
        for (int a = 0; a < 2; ++a)
#pragma unroll
            for (int b = 0; b < 2; ++b)
#pragma unroll
                for (int m = 0; m < 4; ++m)
#pragma unroll
                    for (int n = 0; n < 2; ++n) acc[a][b][m][n] = (f32x4){0.f, 0.f, 0.f, 0.f};
        cur = nxt; cA = nA; cB = nB; ++ui;
        if constexpr (ALIGN_EPI) { if (wr == 1) PG8_BAR; }
    }
    PG8_WAIT_V(0);
    if constexpr (!ALIGN_EPI) { if (wr == 0) PG8_BAR; }
    PG8_BAR;
#undef PG8_SA
#undef PG8_SB
#undef PG8_STAGE
#undef PG8_LDA
#undef PG8_LDB
#undef PG8_MMA
#undef PG8_WAIT_V
#undef PG8_WAIT_L
#undef PG8_BAR
#undef PG8_SCHED
}
}

#include <hip/hip_cooperative_groups.h>
namespace mk {
namespace cg = cooperative_groups;
#define LAS __attribute__((address_space(3)))
#define GAS __attribute__((address_space(1)))
typedef unsigned short bf16;
typedef float f32x4 __attribute__((ext_vector_type(4)));
typedef float f32x16 __attribute__((ext_vector_type(16)));
typedef unsigned u32x4 __attribute__((ext_vector_type(4)));
typedef unsigned u32x2 __attribute__((ext_vector_type(2)));
typedef short bf16x8 __attribute__((ext_vector_type(8)));
typedef short s16x4 __attribute__((ext_vector_type(4)));
typedef short v4i16_t __attribute__((ext_vector_type(4)));

constexpr int NWAVES = 8, NTHR = 512;
constexpr int D = 1024, NP = 16384, NS = 1024, NT = NP + NS, NIN = 8208, NZ = 8192, FF = 4096, NMEM = 2048;
constexpr size_t O_YP = 0, O_YS = 16777216, O_SGP = 17825792, O_SRP = 18874368, O_MK = 19922944, O_MV = 22020096, O_SGS = 24117248, O_SRS = 40894464, O_END = 57671680;
constexpr int ZC_GQ = 0, ZC_GK = 512, ZC_GV = 1024, ZC_GR = 2048, ZC_RQ = 3072, ZC_RK = 3584, ZC_RV = 4096, ZC_RG = 5120, ZC_GA = 6144, ZC_GB = 7168;
constexpr size_t MiB = 1u << 20;
constexpr size_t WS_CTL = 0, WS_WIN = 1 * MiB, WS_WMO = 17 * MiB, WS_WXQ = 21 * MiB, WS_WXKV = 23 * MiB, WS_WXO = 27 * MiB, WS_WUP = 29 * MiB, WS_WDN = 37 * MiB, WS_ROPE = 45 * MiB, WS_GAL = 47 * MiB,
                 WS_MB = 49 * MiB, WS_MKB = 53 * MiB, WS_MVB = 57 * MiB, WS_H = 61 * MiB, WS_Z = 95 * MiB, WS_Q = WS_Z, WS_O = WS_Z + 34 * MiB, WS_U = WS_Z + 68 * MiB, WS_MG = 367 * MiB, WS_T = 435 * MiB, WS_END = 503 * MiB;
constexpr int LDS_BYTES = 147456, MISC_OFF = LDS_BYTES - 64;
constexpr float EPS = 1e-6f;

__device__ __forceinline__ unsigned pk2(float lo, float hi) { return pg8::cvt_pk_bf16(lo, hi); }
__device__ __forceinline__ float bf2f(unsigned short u) { return __uint_as_float((unsigned)u << 16); }
__device__ __forceinline__ float bflo(unsigned w) { return __uint_as_float(w << 16); }
__device__ __forceinline__ float bfhi(unsigned w) { return __uint_as_float(w & 0xffff0000u); }
__device__ __forceinline__ unsigned short f2bf(float f) { return (unsigned short)(pk2(f, 0.f) & 0xffffu); }
__device__ __forceinline__ float wave_sum(float v) {
#pragma unroll
    for (int o = 1; o < 64; o <<= 1) v += __shfl_xor(v, o);
    return v;
}
#define MFMA32(a, b, c) __builtin_amdgcn_mfma_f32_32x32x16_bf16((a), (b), (c), 0, 0, 0)
__device__ __forceinline__ int crow(int reg, int h) { return (reg & 3) + 8 * (reg >> 2) + 4 * h; }
__device__ __forceinline__ bf16x8 pack8(const f32x16& x, int s) {
    u32x4 p; p.x = pk2(x[8 * s + 0], x[8 * s + 1]); p.y = pk2(x[8 * s + 2], x[8 * s + 3]); p.z = pk2(x[8 * s + 4], x[8 * s + 5]); p.w = pk2(x[8 * s + 6], x[8 * s + 7]);
    return __builtin_bit_cast(bf16x8, p);
}
__device__ __forceinline__ s16x4 vtr(const LAS unsigned char* p) { return __builtin_bit_cast(s16x4, __builtin_amdgcn_ds_read_tr16_b64_v4i16((LAS v4i16_t*)p)); }
__device__ __forceinline__ bf16x8 cat8(s16x4 lo, s16x4 hi) { return __builtin_shufflevector(lo, hi, 0, 1, 2, 3, 4, 5, 6, 7); }

struct Params {
    const float* in[26];
    float* out; unsigned char* ws;
    int stop_after;
    int pad;
};
enum { I_XP = 0, I_XS, I_SG, I_SR, I_CK, I_CV, I_MEM, I_WIN, I_WA2, I_BA, I_GGLA, I_GRET, I_WMO, I_WXQ, I_WXK, I_WXV, I_WXO, I_GMEM, I_WUP, I_WDN, I_GPM, I_GQM, I_GPX, I_GQX, I_GPF, I_GQF };

__device__ __forceinline__ void transpose_item(const float* W, int ldw, int col_off, int N, bf16* WT, int ldt, int row_off, int kcol_off, LAS float* scr, int item, int lane) {
    const int nblk = N / 32, kb = item / nblk, nb = item % nblk, k0 = 64 * kb, n0 = 32 * nb;
#pragma unroll 8
    for (int i = 0; i < 32; ++i) { const int kk = 2 * i + (lane >> 5); scr[kk * 33 + (lane & 31)] = W[(size_t)(k0 + kk) * ldw + col_off + n0 + (lane & 31)]; }
    asm volatile("s_waitcnt lgkmcnt(0)" ::: "memory");
    const int c = lane & 7;
#pragma unroll
    for (int j = 0; j < 4; ++j) { const int n = (lane >> 3) + 8 * j; const LAS float* s = scr + (8 * c) * 33 + n;
        u32x4 o; o.x = pk2(s[0 * 33], s[1 * 33]); o.y = pk2(s[2 * 33], s[3 * 33]); o.z = pk2(s[4 * 33], s[5 * 33]); o.w = pk2(s[6 * 33], s[7 * 33]);
        *(u32x4*)(WT + (size_t)(row_off + n0 + n) * ldt + kcol_off + k0 + 8 * c) = o; }
    asm volatile("s_waitcnt lgkmcnt(0)" ::: "memory");
}

template <bool GA>
__device__ __forceinline__ void rms_row_bf16(const float* xrow, const float* g, bf16* orow, const LAS float* wga, float* garow, int lane) {
    f32x4 v[4]; float s = 0.f;
#pragma unroll
    for (int j = 0; j < 4; ++j) { v[j] = ((const f32x4*)xrow)[lane + 64 * j]; s += (v[j].x * v[j].x + v[j].y * v[j].y) + (v[j].z * v[j].z + v[j].w * v[j].w); }
    const float rs = 1.0f / sqrtf(wave_sum(s) * (1.f / D) + EPS);
#pragma unroll
    for (int j = 0; j < 4; ++j) { const f32x4 gg = ((const f32x4*)g)[lane + 64 * j]; v[j] = v[j] * rs * gg; }
#pragma unroll
    for (int j = 0; j < 4; ++j) { u32x2 w; w.x = pk2(v[j].x, v[j].y); w.y = pk2(v[j].z, v[j].w); ((u32x2*)orow)[lane + 64 * j] = w; }
    if (GA) {
        float mine = 0.f;
#pragma unroll
        for (int r = 0; r < 16; ++r) {
            float a = 0.f;
#pragma unroll
            for (int j = 0; j < 4; ++j) { const f32x4 w = ((const LAS f32x4*)(wga + r * 1024))[lane + 64 * j]; a += (v[j].x * w.x + v[j].y * w.y) + (v[j].z * w.z + v[j].w * w.w); }
            a = wave_sum(a);
            if (lane == r) mine = a;
        }
        if (lane < 16) garow[lane] = mine;
    }
}

__device__ __forceinline__ void phase0(const Params& P, LAS unsigned char* lds, int vcu, int G) {
    int tid = threadIdx.x; asm volatile("" : "+v"(tid));
    const int lane = tid & 63, wave = __builtin_amdgcn_readfirstlane(tid >> 6);
    unsigned char* ws = P.ws;
    LAS float* wga = (LAS float*)lds;
    LAS float* scr = (LAS float*)(lds + 65536 + wave * 8704);
    { const float* W = P.in[I_WIN];
      for (int k = tid; k < 1024; k += NTHR) {
#pragma unroll
          for (int q = 0; q < 4; ++q) { const f32x4 w = *(const f32x4*)(W + (size_t)k * NIN + 3072 + 4 * q); wga[(4 * q + 0) * 1024 + k] = w.x; wga[(4 * q + 1) * 1024 + k] = w.y; wga[(4 * q + 2) * 1024 + k] = w.z; wga[(4 * q + 3) * 1024 + k] = w.w; } } }
    const int gw = vcu * NWAVES + wave, NGW = G * NWAVES;
    constexpr int I_IN = (D / 64) * (NZ / 32), I_SQ = (D / 64) * (D / 32), I_UP = (D / 64) * (FF / 32), I_DN = (FF / 64) * (D / 32);
    constexpr int NITEMS = I_IN + 5 * I_SQ + I_UP + I_DN;
    for (int it = gw; it < NITEMS; it += NGW) {
        int r = it;
        if (r < I_IN) { const int nb = r % (NZ / 32); const int coff = (nb * 32 >= 3072) ? 16 : 0;
            transpose_item(P.in[I_WIN], NIN, coff, NZ, (bf16*)(ws + WS_WIN), D, 0, 0, scr, r, lane); continue; } r -= I_IN;
        if (r < I_SQ) { transpose_item(P.in[I_WMO], D, 0, D, (bf16*)(ws + WS_WMO), 2 * D, 0, 0, scr, r, lane); transpose_item(P.in[I_WMO], D, 0, D, (bf16*)(ws + WS_WMO), 2 * D, 0, D, scr, r, lane); continue; } r -= I_SQ;
        if (r < I_SQ) { transpose_item(P.in[I_WXQ], D, 0, D, (bf16*)(ws + WS_WXQ), D, 0, 0, scr, r, lane); continue; } r -= I_SQ;
        if (r < I_SQ) { transpose_item(P.in[I_WXK], D, 0, D, (bf16*)(ws + WS_WXKV), D, 0, 0, scr, r, lane); continue; } r -= I_SQ;
        if (r < I_SQ) { transpose_item(P.in[I_WXV], D, 0, D, (bf16*)(ws + WS_WXKV), D, D, 0, scr, r, lane); continue; } r -= I_SQ;
        if (r < I_SQ) { transpose_item(P.in[I_WXO], D, 0, D, (bf16*)(ws + WS_WXO), D, 0, 0, scr, r, lane); continue; } r -= I_SQ;
        if (r < I_UP) { transpose_item(P.in[I_WUP], FF, 0, FF, (bf16*)(ws + WS_WUP), D, 0, 0, scr, r, lane); continue; } r -= I_UP;
        transpose_item(P.in[I_WDN], D, 0, D, (bf16*)(ws + WS_WDN), FF, 0, 0, scr, r, lane);
    }
    { float* tab = (float*)(ws + WS_ROPE);
      for (int e = (vcu * NTHR + tid); e < 2056 * 64; e += G * NTHR) { const int p = e >> 6, i = e & 63; const int pos = p < 2048 ? p : 16384 + (p - 2048);
          const float inv = (float)pow(10000.0, -(double)i / 64.0); const float ang = (float)pos * inv;
          tab[2 * e] = (float)cos((double)ang); tab[2 * e + 1] = (float)sin((double)ang); } }
    __syncthreads();
    for (int m = gw; m < NT + NMEM; m += NGW) {
        if (m < NT) { const float* xr = m < NP ? P.in[I_XP] + (size_t)m * D : P.in[I_XS] + (size_t)(m - NP) * D;
            rms_row_bf16<true>(xr, P.in[I_GPM], (bf16*)(ws + WS_H) + (size_t)m * D, wga, (float*)(ws + WS_GAL) + (size_t)m * 16, lane); }
        else { const int r = m - NT; rms_row_bf16<false>(P.in[I_MEM] + (size_t)r * D, P.in[I_GMEM], (bf16*)(ws + WS_MB) + (size_t)r * D, wga, nullptr, lane); }
    }
}

__device__ __forceinline__ void row_phase(const float* xop, const float* xos, const float* t, const float* g1, float* xnew, const float* g2, bf16* hn, int vcu, int G) {
    int tid = threadIdx.x; asm volatile("" : "+v"(tid));
    const int lane = tid & 63, wave = __builtin_amdgcn_readfirstlane(tid >> 6);
    const int gw = vcu * NWAVES + wave, NGW = G * NWAVES;
    for (int m = gw; m < NT; m += NGW) {
        const float* xo = (xos && m >= NP) ? xos + (size_t)(m - NP) * D : xop + (size_t)m * D;
        f32x4 tv[4], xv[4]; float s = 0.f;
#pragma unroll
        for (int j = 0; j < 4; ++j) { tv[j] = ((const f32x4*)(t + (size_t)m * D))[lane + 64 * j]; xv[j] = ((const f32x4*)xo)[lane + 64 * j]; s += (tv[j].x * tv[j].x + tv[j].y * tv[j].y) + (tv[j].z * tv[j].z + tv[j].w * tv[j].w); }
        const float rs = 1.0f / sqrtf(wave_sum(s) * (1.f / D) + EPS);
        float s2 = 0.f;
#pragma unroll
        for (int j = 0; j < 4; ++j) { const f32x4 gg = ((const f32x4*)g1)[lane + 64 * j]; xv[j] = xv[j] + tv[j] * rs * gg; ((f32x4*)(xnew + (size_t)m * D))[lane + 64 * j] = xv[j];
            s2 += (xv[j].x * xv[j].x + xv[j].y * xv[j].y) + (xv[j].z * xv[j].z + xv[j].w * xv[j].w); }
        if (hn) {
            const float rs2 = 1.0f / sqrtf(wave_sum(s2) * (1.f / D) + EPS);
#pragma unroll
            for (int j = 0; j < 4; ++j) { const f32x4 gg = ((const f32x4*)g2)[lane + 64 * j]; const f32x4 o = xv[j] * rs2 * gg; u32x2 w; w.x = pk2(o.x, o.y); w.y = pk2(o.z, o.w); ((u32x2*)(hn + (size_t)m * D))[lane + 64 * j] = w; }
        }
    }
}


#define XB_TMO      128
#define XB_XCNT(j)  (256  + 64 * (j))
#define XB_XSUB(j)  (1280 + 64 * (j))
#define XB_XGEN(j)  (2304 + 64 * (j))
#define XB_TOP      3328
#define XB_TOPGEN   3392
#define XCD_BAR_WORDS 3456
#define XB_SPIN_CAP (1u << 22)
__device__ __forceinline__ unsigned xb_ld(unsigned* p)              { return __hip_atomic_load(p, __ATOMIC_RELAXED, __HIP_MEMORY_SCOPE_AGENT); }
__device__ __forceinline__ unsigned xb_add(unsigned* p, unsigned v) { return __hip_atomic_fetch_add(p, v, __ATOMIC_RELAXED, __HIP_MEMORY_SCOPE_AGENT); }
__device__ __forceinline__ unsigned xb_xcc_id() { return (unsigned)__builtin_amdgcn_s_getreg((3 << 11) | 20) & 0xFu; }
#define XB_SPIN(cond, bar) do { unsigned _sp = 0; while (cond) { __builtin_amdgcn_s_sleep(1); \
    if ((++_sp & 255u) == 0u) { if (xb_ld(&(bar)[XB_TMO])) break; if (_sp > XB_SPIN_CAP) { atomicAdd(&(bar)[XB_TMO], 1u); break; } } } } while (0)
struct XcdBarrier { unsigned* bar; unsigned x; volatile LAS unsigned* st; };
__device__ __forceinline__ XcdBarrier xcd_barrier_post(unsigned* bar, volatile LAS unsigned* st) {
    XcdBarrier b; b.bar = bar; b.x = xb_xcc_id(); b.st = st;
    if (threadIdx.x == 0) (void)xb_add(&bar[XB_XCNT(b.x)], 1u);
    return b;
}
__device__ __forceinline__ void xcd_barrier_complete(unsigned* bar, unsigned x, unsigned& nloc, unsigned& nx) {
    const unsigned G = gridDim.x * gridDim.y * gridDim.z;
    unsigned sum, cnt, mine, sp = 0u;
    for (;;) {
        sum = 0u; cnt = 0u; mine = 0u;
#pragma unroll
        for (unsigned j = 0; j < 16; ++j) { const unsigned c = xb_ld(&bar[XB_XCNT(j)]); sum += c; cnt += (c > 0u) ? 1u : 0u; mine = (j == x) ? c : mine; }
        if (sum == G) break;
        __builtin_amdgcn_s_sleep(1);
        if ((++sp & 255u) == 0u) { if (xb_ld(&bar[XB_TMO])) break; if (sp > XB_SPIN_CAP) { atomicAdd(&bar[XB_TMO], 1u); break; } }
    }
    nloc = mine > 0u ? mine : 1u; nx = cnt > 0u ? cnt : 1u;
}
__device__ __forceinline__ void xcd_barrier(const XcdBarrier& b) {
    asm volatile("s_waitcnt vmcnt(0)" ::: "memory");
    __syncthreads();
    if (threadIdx.x == 0) {
        unsigned* bar = b.bar;
        __builtin_amdgcn_s_waitcnt(0);
        unsigned nloc = b.st[0], nx = b.st[1];
        if (nloc == 0u) { xcd_barrier_complete(bar, b.x, nloc, nx); b.st[0] = nloc; b.st[1] = nx; }
        const unsigned old = xb_add(&bar[XB_XSUB(b.x)], 1u);
        const unsigned gen = old / nloc;
        if (old + 1u == (gen + 1u) * nloc) {
            __builtin_amdgcn_fence(__ATOMIC_RELEASE, "agent");
            asm volatile("s_waitcnt vmcnt(0)" ::: "memory");
            const unsigned og = xb_add(&bar[XB_TOP], 1u);
            const unsigned tg = og / nx;
            if (og + 1u == (tg + 1u) * nx) xb_add(&bar[XB_TOPGEN], 1u);
            else XB_SPIN(xb_ld(&bar[XB_TOPGEN]) == tg, bar);
            __builtin_amdgcn_fence(__ATOMIC_ACQUIRE, "agent");
            xb_add(&bar[XB_XGEN(b.x)], 1u);
            asm volatile("s_waitcnt vmcnt(0)" ::: "memory");
        } else {
            XB_SPIN(xb_ld(&bar[XB_XGEN(b.x)]) == gen, bar);
            __builtin_amdgcn_fence(__ATOMIC_ACQUIRE, "agent");
            asm volatile("s_waitcnt vmcnt(0)" ::: "memory");
        }
    }
    __syncthreads();
}

constexpr int SG_STR = 68, SG_SLAB = 64 * SG_STR * 4;
static_assert(8 * SG_SLAB <= LDS_BYTES - 64, "small-gemm LDS");
struct SEpiF32 { float* O; int ldc;
    __device__ __forceinline__ void operator()(int row, int col, const float (&v)[8]) const { float* p = O + (size_t)row * ldc + col; *(f32x4*)p = (f32x4){v[0], v[1], v[2], v[3]}; *(f32x4*)(p + 4) = (f32x4){v[4], v[5], v[6], v[7]}; } };
struct SEpiBf16 { bf16* O; int ldc;
    __device__ __forceinline__ void operator()(int row, int col, const float (&v)[8]) const { u32x4 o; o.x = pk2(v[0], v[1]); o.y = pk2(v[2], v[3]); o.z = pk2(v[4], v[5]); o.w = pk2(v[6], v[7]); *(u32x4*)(O + (size_t)row * ldc + col) = o; } };
template <class SEpi>
__device__ __forceinline__ void small_gemm(LAS unsigned char* lds, const bf16* A, const bf16* Bt, int K, int N, int vcu, int G, const SEpi& E) {
    int tid = threadIdx.x; asm volatile("" : "+v"(tid));
    const int lane = tid & 63, w = __builtin_amdgcn_readfirstlane(tid >> 6), r32 = lane & 31, hh = lane >> 5;
    const int nun = 16 * (N / 64), kw = K / 8;
    for (int u = vcu; u < nun; u += G) {
        const int tm = u & 15, tn = u >> 4;
        f32x16 acc[2][2];
#pragma unroll
        for (int i = 0; i < 2; ++i)
#pragma unroll
            for (int j = 0; j < 2; ++j)
#pragma unroll
                for (int rg = 0; rg < 16; ++rg) acc[i][j][rg] = 0.f;
        const bf16* Ap = A + (size_t)(tm * 64 + r32) * K + w * kw + 8 * hh;
        const bf16* Bp = Bt + (size_t)(tn * 64 + r32) * K + w * kw + 8 * hh;
        const size_t r32k = (size_t)32 * K;
#pragma unroll 4
        for (int ks = 0; ks < kw / 16; ++ks) {
            const bf16x8 a0 = *(const bf16x8*)(Ap + ks * 16), a1 = *(const bf16x8*)(Ap + r32k + ks * 16);
            const bf16x8 b0 = *(const bf16x8*)(Bp + ks * 16), b1 = *(const bf16x8*)(Bp + r32k + ks * 16);
            acc[0][0] = MFMA32(a0, b0, acc[0][0]); acc[0][1] = MFMA32(a0, b1, acc[0][1]); acc[1][0] = MFMA32(a1, b0, acc[1][0]); acc[1][1] = MFMA32(a1, b1, acc[1][1]);
        }
        LAS float* slab = (LAS float*)(lds + w * SG_SLAB);
#pragma unroll
        for (int i = 0; i < 2; ++i)
#pragma unroll
            for (int j = 0; j < 2; ++j)
#pragma unroll
                for (int rg = 0; rg < 16; ++rg) slab[(32 * i + crow(rg, hh)) * SG_STR + 32 * j + r32] = acc[i][j][rg];
        __syncthreads();
        { const int row = tid >> 3, c8 = (tid & 7) * 8;
          f32x4 s0 = (f32x4){0.f, 0.f, 0.f, 0.f}, s1 = s0;
#pragma unroll
          for (int q = 0; q < 8; ++q) { const LAS float* p = (const LAS float*)(lds + q * SG_SLAB) + row * SG_STR + c8; s0 += *(const LAS f32x4*)p; s1 += *(const LAS f32x4*)(p + 4); }
          const float v[8] = {s0.x, s0.y, s0.z, s0.w, s1.x, s1.y, s1.z, s1.w};
          E(tm * 64 + row, tn * 64 + c8, v); }
        __syncthreads();
    }
}

constexpr int L_QT = 0, L_KT = 17408, L_KHT = 34816, L_P = 53248, L_OS = 0  , L_V = 66560, L_RQ = 103424, L_RK = 119808, L_GAL = 136192, L_PRE = 140288, L_EBL = 142336, L_P2END = 142848;
constexpr int QT_STR = 272, KHT_STR = 144, P_STR = 144, V_STR = 576, OS_STR = 260;
static_assert(L_P2END <= LDS_BYTES, "P2 LDS map");
__device__ __forceinline__ int dperm(int d) { return (d & ~12) | ((d & 4) << 1) | ((d & 8) >> 1); }

#define LAUNDER(x) asm volatile("" : "+v"(x))
#define P2_PREFETCH(cc_) do { const int rowp_ = row_base + (cc_) * 64; int tid = tid0; LAUNDER(tid); \
    _Pragma("unroll") for (int i = 0; i < 2; ++i) { const int ch = tid + 512 * i, t = ch >> 4, c8 = ch & 15; const bool ok = t < Tv; \
        pq[i] = ok ? *(const u32x4*)(Z + (size_t)(rowp_ + t) * NZ + cq + c8 * 8) : (u32x4){0u, 0u, 0u, 0u}; \
        pk[i] = ok ? *(const u32x4*)(Z + (size_t)(rowp_ + t) * NZ + ck + c8 * 8) : (u32x4){0u, 0u, 0u, 0u}; } \
    _Pragma("unroll") for (int i = 0; i < 4; ++i) { const int ch = tid + 512 * i, t = ch >> 5, c8 = ch & 31; const bool ok = t < Tv; \
        pv[i] = ok ? *(const u32x4*)(Z + (size_t)(rowp_ + t) * NZ + cv + c8 * 8) : (u32x4){0u, 0u, 0u, 0u}; } \
    if (BR == 0) { const int t = tid >> 2, c4 = tid & 3; pga = (tid < 256 && t < Tv) ? *(const f32x4*)(GAL + (size_t)(rowp_ + t) * 16 + c4 * 4) : (f32x4){0.f, 0.f, 0.f, 0.f}; } } while (0)

template <int BR>
__device__ __forceinline__ void chain_unit(const Params& P, LAS unsigned char* lds, int b, int h, int row_base, int nch, int Tv, int pidx0, const float* s0, float* s_out) {
    const int tid0 = threadIdx.x, w = __builtin_amdgcn_readfirstlane(tid0 >> 6);
    const bf16* Z = (const bf16*)(P.ws + WS_Z);
    const float* GAL = (const float*)(P.ws + WS_GAL);
    const float* ROPE = (const float*)(P.ws + WS_ROPE);
    bf16* MG = (bf16*)(P.ws + WS_MG);
    const int cq = (BR == 0 ? ZC_GQ : ZC_RQ) + h * 128, ck = (BR == 0 ? ZC_GK : ZC_RK) + h * 128, cv = (BR == 0 ? ZC_GV : ZC_RV) + h * 256;
    const int cg1 = (BR == 0 ? ZC_GR : ZC_RG) + h * 256, cg2 = (BR == 0 ? ZC_GA : ZC_GB) + h * 256;
    const float* ghead = P.in[BR == 0 ? I_GGLA : I_GRET] + h * 256;
    const float scale = 0.08838834764831845f;
    const float lg = BR == 1 ? log1pf(-exp2f(-5.0f - (float)h)) : 0.f;
    f32x16 S[4];
    { const int r32 = tid0 & 31, hh = (tid0 >> 5) & 1;
#pragma unroll
    for (int T = 0; T < 4; ++T)
#pragma unroll
        for (int rg = 0; rg < 16; ++rg) S[T][rg] = s0 ? s0[((size_t)(b * 4 + h) * 128 + 32 * T + crow(rg, hh)) * 256 + 32 * w + r32] : 0.f; }
    u32x4 pq[2], pk[2], pv[4]; f32x4 pga = (f32x4){0.f, 0.f, 0.f, 0.f};
    P2_PREFETCH(0);
    for (int c = 0; c < nch; ++c) {
        const int rowc = row_base + c * 64;
        { int tid = tid0; LAUNDER(tid);
#pragma unroll
        for (int i = 0; i < 2; ++i) { const int ch = tid + 512 * i, t = ch >> 4, c8 = ch & 15;
            *(LAS u32x4*)(lds + L_RQ + t * 256 + c8 * 16) = pq[i]; *(LAS u32x4*)(lds + L_RK + t * 256 + c8 * 16) = pk[i]; }
#pragma unroll
        for (int i = 0; i < 4; ++i) { const int ch = tid + 512 * i, t = ch >> 5, c8 = ch & 31; *(LAS u32x4*)(lds + L_V + t * V_STR + c8 * 16) = pv[i]; }
        if (BR == 0 && tid < 256) *(LAS f32x4*)(lds + L_GAL + tid * 16) = pga; }
        __syncthreads();
        {
            int tid = tid0; LAUNDER(tid); const int pd = tid & 127, ptq = tid >> 7;
            const int pp = dperm(pd);
            unsigned kh[8];
            if (BR == 0) {
                float la[16];
                {
                    float w2r[16];
#pragma unroll
                    for (int r = 0; r < 16; ++r) w2r[r] = P.in[I_WA2][r * 512 + h * 128 + pd];
                    const float bias = P.in[I_BA][h * 128 + pd];
#pragma unroll
                    for (int i = 0; i < 16; ++i) { const int t = 16 * ptq + i;
                        float x = bias;
#pragma unroll
                        for (int q4 = 0; q4 < 4; ++q4) { const f32x4 g = *(const LAS f32x4*)(lds + L_GAL + t * 64 + q4 * 16); x += g.x * w2r[4 * q4] + g.y * w2r[4 * q4 + 1] + g.z * w2r[4 * q4 + 2] + g.w * w2r[4 * q4 + 3]; }
                        const float ls = fminf(x, 0.f) - __logf(1.0f + __expf(-fabsf(x)));
                        la[i] = t < Tv ? ls * (1.0f / 16.0f) : 0.f; }
                }
#pragma unroll
                for (int i = 1; i < 16; ++i) la[i] += la[i - 1];
                ((LAS float*)(lds + L_PRE))[ptq * 128 + pd] = la[15];
                __syncthreads();
                float base = 0.f, btot = 0.f;
#pragma unroll
                for (int q = 0; q < 4; ++q) { const float v = ((const LAS float*)(lds + L_PRE))[q * 128 + pd]; btot += v; if (q < ptq) base += v; }
                if (ptq == 0) ((LAS float*)(lds + L_EBL))[pd] = __expf(btot);
#pragma unroll
                for (int i = 0; i < 16; ++i) { const int t = 16 * ptq + i; const float bt = base + la[i];
                    const float qv = bf2f(*(const LAS unsigned short*)(lds + L_RQ + t * 256 + pd * 2)), kv = bf2f(*(const LAS unsigned short*)(lds + L_RK + t * 256 + pd * 2));
                    *(LAS unsigned short*)(lds + L_QT + t * QT_STR + pp * 2) = f2bf(qv * (__expf(bt) * scale));
                    *(LAS unsigned short*)(lds + L_KT + t * QT_STR + pp * 2) = f2bf(kv * __expf(-bt));
                    const float k3 = kv * __expf(btot - bt);
                    if (i & 1) kh[i >> 1] = (kh[i >> 1] & 0xffffu) | ((unsigned)f2bf(k3) << 16); else kh[i >> 1] = (unsigned)f2bf(k3); }
            } else {
                const float btot = (float)Tv * lg;
                if (ptq == 0) ((LAS float*)(lds + L_EBL))[pd] = __expf(btot);
                const int fi = pd & 63; const float sgn = pd < 64 ? -1.f : 1.f;
#pragma unroll
                for (int i = 0; i < 16; ++i) { const int t = 16 * ptq + i;
                    const float bt = (float)(t < Tv ? t + 1 : Tv) * lg;
                    const int pidx = pidx0 + c * 64 + (t < Tv ? t : 0);
                    const float cs = ROPE[(size_t)(pidx * 64 + fi) * 2], sn = ROPE[(size_t)(pidx * 64 + fi) * 2 + 1];
                    const float q1 = bf2f(*(const LAS unsigned short*)(lds + L_RQ + t * 256 + pd * 2)), q2 = bf2f(*(const LAS unsigned short*)(lds + L_RQ + t * 256 + (pd ^ 64) * 2));
                    const float k1 = bf2f(*(const LAS unsigned short*)(lds + L_RK + t * 256 + pd * 2)), k2 = bf2f(*(const LAS unsigned short*)(lds + L_RK + t * 256 + (pd ^ 64) * 2));
                    const float qv = q1 * cs + sgn * q2 * sn, kv = k1 * cs + sgn * k2 * sn;
                    *(LAS unsigned short*)(lds + L_QT + t * QT_STR + pp * 2) = f2bf(qv * __expf(bt));
                    *(LAS unsigned short*)(lds + L_KT + t * QT_STR + pp * 2) = f2bf(kv * (__expf(-bt) * scale));
                    const float k3 = kv * (__expf(btot - bt) * scale);
                    if (i & 1) kh[i >> 1] = (kh[i >> 1] & 0xffffu) | ((unsigned)f2bf(k3) << 16); else kh[i >> 1] = (unsigned)f2bf(k3); }
            }
            *(LAS u32x4*)(lds + L_KHT + pd * KHT_STR + ptq * 32) = (u32x4){kh[0], kh[1], kh[2], kh[3]};
            *(LAS u32x4*)(lds + L_KHT + pd * KHT_STR + ptq * 32 + 16) = (u32x4){kh[4], kh[5], kh[6], kh[7]};
        }
        u32x4 g1v[4], g2v[4];
        { int tid = tid0; LAUNDER(tid); const int et = tid >> 3, eseg = tid & 7; const bool ok = et < Tv;
#pragma unroll
          for (int i = 0; i < 4; ++i) { g1v[i] = ok ? *(const u32x4*)(Z + (size_t)(rowc + et) * NZ + cg1 + eseg * 32 + i * 8) : (u32x4){0u, 0u, 0u, 0u};
                                        g2v[i] = ok ? *(const u32x4*)(Z + (size_t)(rowc + et) * NZ + cg2 + eseg * 32 + i * 8) : (u32x4){0u, 0u, 0u, 0u}; } }
        if (c + 1 < nch) P2_PREFETCH(c + 1);
        __syncthreads();
        int lane = tid0 & 63; LAUNDER(lane); const int r32 = lane & 31, hh = lane >> 5;
        {
            const int fr = lane & 15, fq = lane >> 4, tb = w >> 1;
#pragma unroll
            for (int j = 0; j < 2; ++j) { const int sb = 2 * (w & 1) + j;
                pg8::f32x4 acc = (pg8::f32x4){0.f, 0.f, 0.f, 0.f};
                if (sb <= tb) {
#pragma unroll
                    for (int ks = 0; ks < 4; ++ks) {
                        const bf16x8 kf = *(const LAS bf16x8*)(lds + L_KT + (16 * sb + fr) * QT_STR + (32 * ks + 8 * fq) * 2);
                        const bf16x8 qf = *(const LAS bf16x8*)(lds + L_QT + (16 * tb + fr) * QT_STR + (32 * ks + 8 * fq) * 2);
                        acc = __builtin_amdgcn_mfma_f32_16x16x32_bf16(kf, qf, acc, 0, 0, 0);
                    }
                }
                const int tg = 16 * tb + fr;
                float v[4];
#pragma unroll
                for (int e = 0; e < 4; ++e) { const int sg = 16 * sb + 4 * fq + e; v[e] = sg <= tg ? acc[e] : 0.f; }
                u32x2 o; o.x = pk2(v[0], v[1]); o.y = pk2(v[2], v[3]);
                *(LAS u32x2*)(lds + L_P + tg * P_STR + (16 * sb + 4 * fq) * 2) = o;
            }
        }
        bf16x8 vf[4];
        { const int g16 = (lane >> 4) & 1, i16 = lane & 15, q_ = i16 >> 2, p_ = i16 & 3;
          const LAS unsigned char* vb = lds + L_V + (8 * hh + q_) * V_STR + (32 * w + 16 * g16 + 4 * p_) * 2;
#pragma unroll
          for (int ks = 0; ks < 4; ++ks) vf[ks] = cat8(vtr(vb + (16 * ks) * V_STR), vtr(vb + (16 * ks + 4) * V_STR)); }
        f32x16 O[2];
#pragma unroll
        for (int mi = 0; mi < 2; ++mi) {
#pragma unroll
            for (int rg = 0; rg < 16; ++rg) O[mi][rg] = 0.f; }
#pragma unroll
        for (int T = 0; T < 4; ++T)
#pragma unroll
            for (int s = 0; s < 2; ++s) { const bf16x8 sb = pack8(S[T], s);
#pragma unroll
                for (int mi = 0; mi < 2; ++mi) { const bf16x8 qf = *(const LAS bf16x8*)(lds + L_QT + (32 * mi + r32) * QT_STR + (32 * T + 16 * s + 8 * hh) * 2); O[mi] = MFMA32(qf, sb, O[mi]); } }
#pragma unroll
        for (int T = 0; T < 4; ++T) {
#pragma unroll
            for (int rg = 0; rg < 16; ++rg) S[T][rg] *= ((const LAS float*)(lds + L_EBL))[32 * T + crow(rg, hh)];
#pragma unroll
            for (int ks = 0; ks < 4; ++ks) { const bf16x8 kf = *(const LAS bf16x8*)(lds + L_KHT + (32 * T + r32) * KHT_STR + (16 * ks + 8 * hh) * 2); S[T] = MFMA32(kf, vf[ks], S[T]); } }
        __syncthreads();
#pragma unroll
        for (int mi = 0; mi < 2; ++mi)
#pragma unroll
            for (int ks = 0; ks < 4; ++ks) { if (mi == 0 && ks >= 2) continue;
                const bf16x8 pf = *(const LAS bf16x8*)(lds + L_P + (32 * mi + r32) * P_STR + (16 * ks + 8 * hh) * 2); O[mi] = MFMA32(pf, vf[ks], O[mi]); }
        __syncthreads();
#pragma unroll
        for (int mi = 0; mi < 2; ++mi)
#pragma unroll
            for (int rg = 0; rg < 16; ++rg) ((LAS float*)(lds + L_OS))[(32 * mi + crow(rg, hh)) * OS_STR + 32 * w + r32] = O[mi][rg];
        __syncthreads();
        {
            int tid = tid0; LAUNDER(tid); const int et = tid >> 3, eseg = tid & 7;
            f32x4 ov[8];
#pragma unroll
            for (int i = 0; i < 8; ++i) ov[i] = *(const LAS f32x4*)(lds + L_OS + (et * OS_STR + eseg * 32 + i * 4) * 4);
            float mu = 0.f;
            if (BR == 1) { float s = 0.f;
#pragma unroll
                for (int i = 0; i < 8; ++i) s += (ov[i].x + ov[i].y) + (ov[i].z + ov[i].w);
                s += __shfl_xor(s, 1); s += __shfl_xor(s, 2); s += __shfl_xor(s, 4); mu = s * (1.0f / 256.0f); }
            float q = 0.f;
#pragma unroll
            for (int i = 0; i < 8; ++i) { ov[i] = ov[i] - mu; q += (ov[i].x * ov[i].x + ov[i].y * ov[i].y) + (ov[i].z * ov[i].z + ov[i].w * ov[i].w); }
            q += __shfl_xor(q, 1); q += __shfl_xor(q, 2); q += __shfl_xor(q, 4);
            const float rstd = 1.0f / sqrtf(q * (1.0f / 256.0f) + EPS);
            if (et < Tv) {
                bf16* orow = MG + (size_t)(rowc + et) * 2048 + BR * 1024 + h * 256 + eseg * 32;
#pragma unroll
                for (int i = 0; i < 4; ++i) {
                    const f32x4 ga = *(const f32x4*)(ghead + eseg * 32 + i * 8), gb = *(const f32x4*)(ghead + eseg * 32 + i * 8 + 4);
                    const float gg[8] = {ga.x, ga.y, ga.z, ga.w, gb.x, gb.y, gb.z, gb.w};
                    const float oo[8] = {ov[2 * i].x, ov[2 * i].y, ov[2 * i].z, ov[2 * i].w, ov[2 * i + 1].x, ov[2 * i + 1].y, ov[2 * i + 1].z, ov[2 * i + 1].w};
                    const unsigned w1[4] = {g1v[i].x, g1v[i].y, g1v[i].z, g1v[i].w}, w2[4] = {g2v[i].x, g2v[i].y, g2v[i].z, g2v[i].w};
                    float res[8];
#pragma unroll
                    for (int e = 0; e < 8; ++e) { const float a = (e & 1) ? bfhi(w1[e >> 1]) : bflo(w1[e >> 1]); const float gt = (e & 1) ? bfhi(w2[e >> 1]) : bflo(w2[e >> 1]);
                        const float y = oo[e] * rstd * gg[e];
                        res[e] = y * a / ((1.0f + __expf(-a)) * (1.0f + __expf(-gt))); }
                    u32x4 o; o.x = pk2(res[0], res[1]); o.y = pk2(res[2], res[3]); o.z = pk2(res[4], res[5]); o.w = pk2(res[6], res[7]);
                    *(u32x4*)(orow + i * 8) = o;
                }
            }
        }
        __syncthreads();
    }
    const int r32 = tid0 & 31, hh = (tid0 >> 5) & 1;
#pragma unroll
    for (int T = 0; T < 4; ++T)
#pragma unroll
        for (int rg = 0; rg < 16; ++rg) s_out[((size_t)(b * 4 + h) * 128 + 32 * T + crow(rg, hh)) * 256 + 32 * w + r32] = S[T][rg];
}

__device__ __forceinline__ void phase2(const Params& P, LAS unsigned char* lds, int vcu, int G) {
    const bool prompt = vcu < 64; const int nw = G - 64;
    for (int u = prompt ? vcu : vcu - 64; u < (prompt ? 64 : 1024); u += (prompt ? 64 : nw)) {
        const int br = u & 1, h = (u >> 1) & 3, b = u >> 3;
        const int row_base = prompt ? b * 2048 : NP + b * 8, nch = prompt ? 32 : 1, Tv = prompt ? 64 : 8, pidx0 = prompt ? 0 : 2048;
        if (br == 0) chain_unit<0>(P, lds, b, h, row_base, nch, Tv, pidx0, prompt ? nullptr : P.in[I_SG], P.out + (prompt ? O_SGP : O_SGS));
        else         chain_unit<1>(P, lds, b, h, row_base, nch, Tv, pidx0, prompt ? nullptr : P.in[I_SR], P.out + (prompt ? O_SRP : O_SRS));
    }
}

constexpr int A_K = 0, AK_STR = 272, A_V = 34816, AV_STR = 320, A_END = 34816 + 40960;
#define P6_STAGE(src_, mt_, ch_, lbase_, lstr_) do { \
    _Pragma("unroll") for (int i = 0; i < 4; ++i) { const int ch = tid + 512 * i, m = ch >> 4, c8 = ch & 15; \
        const size_t off = (((size_t)b * 256 + 128 * (mt_) + m) * 4 + h) * 256 + 128 * (ch_) + c8 * 8; \
        u32x4 v; \
        if (F32SRC) { const f32x4 a = *(const f32x4*)((const float*)(src_) + off), c = *(const f32x4*)((const float*)(src_) + off + 4); v.x = pk2(a.x, a.y); v.y = pk2(a.z, a.w); v.z = pk2(c.x, c.y); v.w = pk2(c.z, c.w); } \
        else v = *(const u32x4*)((const bf16*)(src_) + off); \
        *(LAS u32x4*)(lds + (lbase_) + m * (lstr_) + c8 * 16) = v; } } while (0)

template <bool F32SRC>
__device__ __forceinline__ void attn_unit(const Params& P, LAS unsigned char* lds, int b, int h, int row0, int nq, const void* Kp, const void* Vp) {
    int tid = threadIdx.x; asm volatile("" : "+v"(tid));
    const int lane = tid & 63, w = __builtin_amdgcn_readfirstlane(tid >> 6), r32 = lane & 31, hh = lane >> 5;
    const bf16* Q = (const bf16*)(P.ws + WS_Q); bf16* Oo = (bf16*)(P.ws + WS_O);
    const bool active = (32 * w) < nq;
    const int t = 32 * w + r32; const bool tok = t < nq;
    f32x16 sT[8];
#pragma unroll
    for (int i = 0; i < 8; ++i)
#pragma unroll
        for (int rg = 0; rg < 16; ++rg) sT[i][rg] = 0.f;
#pragma unroll
    for (int dh = 0; dh < 2; ++dh) {
        bf16x8 qf[8];
#pragma unroll
        for (int ks = 0; ks < 8; ++ks) qf[ks] = tok ? *(const bf16x8*)(Q + (size_t)(row0 + t) * D + h * 256 + 128 * dh + 16 * ks + 8 * hh) : (bf16x8){0, 0, 0, 0, 0, 0, 0, 0};
#pragma unroll
        for (int mt = 0; mt < 2; ++mt) {
            P6_STAGE(Kp, mt, dh, A_K, AK_STR);
            __syncthreads();
            if (active) {
#pragma unroll
                for (int mi = 0; mi < 4; ++mi)
#pragma unroll
                    for (int ks = 0; ks < 8; ++ks) { const bf16x8 kf = *(const LAS bf16x8*)(lds + A_K + (32 * mi + r32) * AK_STR + (16 * ks + 8 * hh) * 2);
                        sT[4 * mt + mi] = MFMA32(kf, qf[ks], sT[4 * mt + mi]); }
            }
            __syncthreads();
        }
    }
    float mx = -3.0e38f;
#pragma unroll
    for (int i = 0; i < 8; ++i)
#pragma unroll
        for (int rg = 0; rg < 16; ++rg) mx = fmaxf(mx, sT[i][rg]);
    mx = fmaxf(mx, __shfl_xor(mx, 32));
    const float c2 = 0.0625f * 1.4426950408889634f;
    float sum = 0.f;
    bf16x8 pf[8][2];
#pragma unroll
    for (int i = 0; i < 8; ++i) {
#pragma unroll
        for (int rg = 0; rg < 16; ++rg) { const float p = __builtin_amdgcn_exp2f((sT[i][rg] - mx) * c2); sT[i][rg] = p; sum += p; }
        pf[i][0] = pack8(sT[i], 0); pf[i][1] = pack8(sT[i], 1); }
    sum += __shfl_xor(sum, 32);
    const float rinv = 1.0f / sum;
    const int g16 = (lane >> 4) & 1, i16 = lane & 15, q_ = i16 >> 2, p_ = i16 & 3;
#pragma unroll
    for (int nh = 0; nh < 2; ++nh) {
        f32x16 oT[4];
#pragma unroll
        for (int i = 0; i < 4; ++i)
#pragma unroll
            for (int rg = 0; rg < 16; ++rg) oT[i][rg] = 0.f;
#pragma unroll
        for (int mt = 0; mt < 2; ++mt) {
            P6_STAGE(Vp, mt, nh, A_V, AV_STR);
            __syncthreads();
            if (active) {
#pragma unroll
                for (int mi = 0; mi < 4; ++mi)
#pragma unroll
                    for (int s = 0; s < 2; ++s) {
                        const bf16x8 pb = pf[4 * mt + mi][s];
#pragma unroll
                        for (int nt = 0; nt < 4; ++nt) {
                            const LAS unsigned char* vb = lds + A_V + (32 * mi + 16 * s + 4 * hh + q_) * AV_STR + (32 * nt + 16 * g16 + 4 * p_) * 2;
                            const bf16x8 va = cat8(vtr(vb), vtr(vb + 8 * AV_STR));
                            oT[nt] = MFMA32(va, pb, oT[nt]);
                        }
                    }
            }
            __syncthreads();
        }
        if (tok) {
            bf16* orow = Oo + (size_t)(row0 + t) * D + h * 256 + 128 * nh;
#pragma unroll
            for (int nt = 0; nt < 4; ++nt)
#pragma unroll
                for (int g = 0; g < 4; ++g) { u32x2 o; o.x = pk2(oT[nt][4 * g] * rinv, oT[nt][4 * g + 1] * rinv); o.y = pk2(oT[nt][4 * g + 2] * rinv, oT[nt][4 * g + 3] * rinv);
                    *(u32x2*)(orow + 32 * nt + 8 * g + 4 * hh) = o; }
        }
    }
}
__device__ __forceinline__ void phase6(const Params& P, LAS unsigned char* lds, int vcu, int G) {
    for (int u = vcu; u < 256 + 512; u += G) {
        if (u < 256) { const int qb = u & 7, h = (u >> 3) & 3, b = u >> 5; attn_unit<false>(P, lds, b, h, b * 2048 + qb * 256, 256, P.ws + WS_MKB, P.ws + WS_MVB); }
        else { const int v = u - 256, h = v & 3, b = v >> 2; attn_unit<true>(P, lds, b, h, NP + b * 8, 8, P.in[I_CK], P.in[I_CV]); }
    }
}

__global__ void __launch_bounds__(NTHR, 2) mega_fwd(Params P) {
    extern __shared__ __attribute__((aligned(16))) unsigned char lds_raw[];
    LAS unsigned char* lds = (LAS unsigned char*)lds_raw;
    cg::grid_group grid = cg::this_grid();
    if (threadIdx.x < 16) ((LAS unsigned*)(lds + MISC_OFF))[threadIdx.x] = 0u;
    __syncthreads();
    const XcdBarrier xbar = xcd_barrier_post((unsigned*)(P.ws + WS_CTL) + 1024, (volatile LAS unsigned*)(lds + MISC_OFF));
    const int G = gridDim.x; const int bx = blockIdx.x; const int vcu = (G % 8 == 0) ? (bx % 8) * (G / 8) + bx / 8 : bx;
    unsigned char* ws = P.ws;
    const int stop = P.stop_after;
#define SEAM(k) do { if (stop <= (k)) return; if ((k) == 0) grid.sync(); else xcd_barrier(xbar); } while (0)
#ifndef NO_P0
    phase0(P, lds, vcu, G);
#endif
    SEAM(0);
    { pg8::Gemm g{(const bf16*)(ws + WS_H), (const bf16*)(ws + WS_WIN), NT, NZ, D}; pg8::StaticOrder S; S.init(NT, NZ, G, bx);
      pg8::EpiBf16<0> E{(bf16*)(ws + WS_Z), NZ};
      pg8::gemm_phase<pg8::EpiBf16<0>, pg8::StaticOrder, true, true>(lds, g, S, E); }
    { pg8::Gemm g{(const bf16*)(ws + WS_MB), (const bf16*)(ws + WS_WXKV), NMEM, 2 * D, D}; pg8::StaticOrder S; S.init(NMEM, 2 * D, G, (bx >= G / 2) ? bx - G / 2 : -1);
      pg8::EpiKV E{P.out + O_MK, P.out + O_MV, (bf16*)(ws + WS_MKB), (bf16*)(ws + WS_MVB)};
      pg8::gemm_phase<pg8::EpiKV, pg8::StaticOrder, true, true>(lds, g, S, E); }
    SEAM(1);
#ifndef NO_P2
    phase2(P, lds, vcu, G);
#endif
    SEAM(2);
    { pg8::Gemm g{(const bf16*)(ws + WS_MG), (const bf16*)(ws + WS_WMO), NP, D, 2 * D}; pg8::StaticOrder S; S.init(NP, D, G, bx);
      pg8::EpiF32 E{(float*)(ws + WS_T), D};
      pg8::gemm_phase<pg8::EpiF32, pg8::StaticOrder, true, true>(lds, g, S, E); }
    small_gemm(lds, (const bf16*)(ws + WS_MG) + (size_t)NP * 2 * D, (const bf16*)(ws + WS_WMO), 2 * D, D, vcu, G, SEpiF32{(float*)(ws + WS_T) + (size_t)NP * D, D});
    SEAM(3);
    row_phase(P.in[I_XP], P.in[I_XS], (const float*)(ws + WS_T), P.in[I_GQM], P.out + O_YP, P.in[I_GPX], (bf16*)(ws + WS_H), vcu, G);
    SEAM(4);
    { pg8::Gemm g{(const bf16*)(ws + WS_H), (const bf16*)(ws + WS_WXQ), NP, D, D}; pg8::StaticOrder S; S.init(NP, D, G, bx);
      pg8::EpiBf16<0> E{(bf16*)(ws + WS_Q), D};
      pg8::gemm_phase<pg8::EpiBf16<0>, pg8::StaticOrder, true, true>(lds, g, S, E); }
    small_gemm(lds, (const bf16*)(ws + WS_H) + (size_t)NP * D, (const bf16*)(ws + WS_WXQ), D, D, vcu, G, SEpiBf16{(bf16*)(ws + WS_Q) + (size_t)NP * D, D});
    SEAM(5);
#ifndef NO_P6
    phase6(P, lds, vcu, G);
#endif
    SEAM(6);
    { pg8::Gemm g{(const bf16*)(ws + WS_O), (const bf16*)(ws + WS_WXO), NP, D, D}; pg8::StaticOrder S; S.init(NP, D, G, bx);
      pg8::EpiF32 E{(float*)(ws + WS_T), D};
      pg8::gemm_phase<pg8::EpiF32, pg8::StaticOrder, true, true>(lds, g, S, E); }
    small_gemm(lds, (const bf16*)(ws + WS_O) + (size_t)NP * D, (const bf16*)(ws + WS_WXO), D, D, vcu, G, SEpiF32{(float*)(ws + WS_T) + (size_t)NP * D, D});
    SEAM(7);
    row_phase(P.out + O_YP, nullptr, (const float*)(ws + WS_T), P.in[I_GQX], P.out + O_YP, P.in[I_GPF], (bf16*)(ws + WS_H), vcu, G);
    SEAM(8);
    { pg8::Gemm g{(const bf16*)(ws + WS_H), (const bf16*)(ws + WS_WUP), NT, FF, D}; pg8::StaticOrder S; S.init(NT, FF, G, bx);
      pg8::EpiBf16<2> E{(bf16*)(ws + WS_U), FF};
      pg8::gemm_phase<pg8::EpiBf16<2>, pg8::StaticOrder, true, true>(lds, g, S, E); }
    SEAM(9);
    { pg8::Gemm g{(const bf16*)(ws + WS_U), (const bf16*)(ws + WS_WDN), NP, D, FF}; pg8::StaticOrder S; S.init(NP, D, G, bx);
      pg8::EpiF32 E{(float*)(ws + WS_T), D};
      pg8::gemm_phase<pg8::EpiF32, pg8::StaticOrder, true, true>(lds, g, S, E); }
    small_gemm(lds, (const bf16*)(ws + WS_U) + (size_t)NP * FF, (const bf16*)(ws + WS_WDN), FF, D, vcu, G, SEpiF32{(float*)(ws + WS_T) + (size_t)NP * D, D});
    SEAM(10);
    row_phase(P.out + O_YP, nullptr, (const float*)(ws + WS_T), P.in[I_GQF], P.out + O_YP, nullptr, nullptr, vcu, G);
#undef SEAM
}
}


#ifndef HYBRID
#define HYBRID 0
#endif
extern "C" void kernel_launch(void* const* d_in, const int* in_sizes, int n_in, void* d_out, int out_size, void* d_ws, size_t ws_size, hipStream_t stream) {
    static int grid = 0;
    if (grid == 0) {
        if (n_in != 26 || out_size != (int)mk::O_END || ws_size < mk::WS_END) { fprintf(stderr, "kernel_launch: unexpected sizes n_in %d out %d ws %zu\n", n_in, out_size, ws_size); grid = -1; return; }
        int dev = 0, cus = 0, per_cu = 0;
        if (hipGetDevice(&dev) != hipSuccess || hipDeviceGetAttribute(&cus, hipDeviceAttributeMultiprocessorCount, dev) != hipSuccess) { grid = -1; return; }
        if (hipFuncSetAttribute((const void*)mk::mega_fwd, hipFuncAttributeMaxDynamicSharedMemorySize, mk::LDS_BYTES) != hipSuccess) { fprintf(stderr, "kernel_launch: hipFuncSetAttribute failed\n"); grid = -1; return; }
        if (hipOccupancyMaxActiveBlocksPerMultiprocessor(&per_cu, (const void*)mk::mega_fwd, mk::NTHR, mk::LDS_BYTES) != hipSuccess || per_cu < 1) { fprintf(stderr, "kernel_launch: occupancy query says %d\n", per_cu); grid = -1; (void)hipGetLastError(); return; }
        grid = cus;
    }
    if (grid < 0) return;
    if (hipMemsetAsync((char*)d_ws + mk::WS_CTL, 0, 65536, stream) != hipSuccess) { fprintf(stderr, "kernel_launch: memset failed\n"); return; }
    mk::Params p{};
    for (int i = 0; i < 26; ++i) p.in[i] = (const float*)d_in[i];
    p.out = (float*)d_out; p.ws = (unsigned char*)d_ws; p.stop_after = 100; p.pad = 0;
    void* args[] = {&p};
    hipError_t e = hipLaunchCooperativeKernel((const void*)mk::mega_fwd, dim3(grid), dim3(mk::NTHR), args, mk::LDS_BYTES, stream);
    if (e != hipSuccess) fprintf(stderr, "cooperative launch failed: %s (grid %d)\n", hipGetErrorString(e), grid);
}
```

```cpp
#include <hip/hip_runtime.h>
#include <cstdio>
#include <cstdint>

namespace pg8 {
#define PG8_LAS __attribute__((address_space(3)))
typedef unsigned short bf16_t;
typedef short bf16x8 __attribute__((ext_vector_type(8)));
typedef float f32x4 __attribute__((ext_vector_type(4)));
typedef unsigned u32x4 __attribute__((ext_vector_type(4)));
typedef unsigned u32x2 __attribute__((ext_vector_type(2)));
constexpr int BM = 256, BK = 64, HALF = 128, HTB = HALF * BK * 2  , STAGE_BYTES = 8 * HTB, NXCD = 8, WGM = 8;

__host__ __device__ __forceinline__ int lds_byte(int r, int c) { const int st = (r >> 4) * 2 + (c >> 5), rr = r & 15, cc = c & 31, ob = rr * 64 + cc * 2; return st * 1024 + (ob ^ (((ob >> 9) & 1) << 5)); }
__host__ __device__ __forceinline__ void stage_rc(int b, int& R, int& C) { const int st = b / 1024, sb = b % 1024, swz = sb ^ (((sb >> 9) & 1) << 5); R = (st >> 1) * 16 + swz / 64; C = (st & 1) * 32 + (swz % 64) / 2; }
__host__ __device__ __forceinline__ int perm32(int rho) { const int n = rho >> 4, i = rho & 15; return 8 * (i >> 2) + 4 * n + (i & 3); }

struct Unit { int pm, pn; };
struct Gemm { const bf16_t* A; const bf16_t* Bt; int M, N, K; };

struct StaticOrder {
    int nM, nN, nwg, G, c;
    __host__ __device__ void init(int M, int N, int G_, int c_) { nM = M / BM; nN = N / BM; nwg = nM * nN; G = G_; c = c_; }
    __host__ __device__ bool next(int i, Unit& u) const {
        if (c < 0) return false;
        const long L = (long)i * G + c; if (L >= nwg) return false;
        int wgid = (int)L; { const int q = nwg / NXCD, r = nwg % NXCD, xcd = wgid % NXCD, off = wgid / NXCD; wgid = (xcd < r ? xcd * (q + 1) : r * (q + 1) + (xcd - r) * q) + off; }
        const int nig = WGM * nN, gid = wgid / nig, fm = gid * WGM, gsz = (nM - fm) < WGM ? (nM - fm) : WGM;
        u.pm = fm + ((wgid % nig) % gsz); u.pn = (wgid % nig) / gsz; return true;
    }
    __device__ __forceinline__ void a_ready(const Unit&) const {}
    __device__ __forceinline__ void done(const Unit&) const {}
};

typedef float f32x2_t __attribute__((ext_vector_type(2))); typedef __bf16 bf16x2_t __attribute__((ext_vector_type(2)));
__device__ __forceinline__ unsigned cvt_pk_bf16(float lo, float hi) { f32x2_t v = {lo, hi}; bf16x2_t b = __builtin_convertvector(v, bf16x2_t); return __builtin_bit_cast(unsigned, b); }

template <int ACT  > struct EpiBf16 {
    static constexpr bool PERM = true, AFTER_DRAIN = false;
    bf16_t* O; int ldc;
    __device__ __forceinline__ void operator()(const f32x4 (&acc)[2][2][4][2], const Unit& u, int wr, int wc, int fr, int fq) const {
        const int row0 = u.pm * BM + wr * 64 + fr; const int col0 = u.pn * BM + wc * 32 + 8 * fq;
#pragma unroll
        for (int ai = 0; ai < 2; ++ai)
#pragma unroll
            for (int m = 0; m < 4; ++m) { bf16_t* rowp = O + (size_t)(row0 + ai * HALF + m * 16) * ldc + col0;
#pragma unroll
                for (int bj = 0; bj < 2; ++bj) { f32x4 v0 = acc[ai][bj][m][0], v1 = acc[ai][bj][m][1];
                    if (ACT == 2) {
#pragma unroll
                        for (int e = 0; e < 4; ++e) { const float a = v0[e] > 0.f ? v0[e] : 0.f, b = v1[e] > 0.f ? v1[e] : 0.f; v0[e] = a * a; v1[e] = b * b; } }
                    u32x4 w; w.x = cvt_pk_bf16(v0[0], v0[1]); w.y = cvt_pk_bf16(v0[2], v0[3]); w.z = cvt_pk_bf16(v1[0], v1[1]); w.w = cvt_pk_bf16(v1[2], v1[3]);
                    *(u32x4*)(rowp + bj * HALF) = w; } }
    }
};
struct EpiF32 {
    static constexpr bool PERM = false, AFTER_DRAIN = false;
    float* O; int ldc;
    __device__ __forceinline__ void operator()(const f32x4 (&acc)[2][2][4][2], const Unit& u, int wr, int wc, int fr, int fq) const {
        const int row0 = u.pm * BM + wr * 64 + fr; const int col0 = u.pn * BM + wc * 32 + 4 * fq;
#pragma unroll
        for (int ai = 0; ai < 2; ++ai)
#pragma unroll
            for (int m = 0; m < 4; ++m) { float* rowp = O + (size_t)(row0 + ai * HALF + m * 16) * ldc + col0;
#pragma unroll
                for (int bj = 0; bj < 2; ++bj)
#pragma unroll
                    for (int n = 0; n < 2; ++n) *(f32x4*)(rowp + bj * HALF + n * 16) = acc[ai][bj][m][n]; }
    }
};
struct EpiKV {
    static constexpr bool PERM = false, AFTER_DRAIN = false;
    float* OK; float* OV; bf16_t* BK_; bf16_t* BV_;
    __device__ __forceinline__ void operator()(const f32x4 (&acc)[2][2][4][2], const Unit& u, int wr, int wc, int fr, int fq) const {
        const int row0 = u.pm * BM + wr * 64 + fr; const bool isv = u.pn >= 4; const int col0 = (u.pn & 3) * BM + wc * 32 + 4 * fq;
        float* Of = isv ? OV : OK; bf16_t* Ob = isv ? BV_ : BK_;
#pragma unroll
        for (int ai = 0; ai < 2; ++ai)
#pragma unroll
            for (int m = 0; m < 4; ++m) { const size_t ro = (size_t)(row0 + ai * HALF + m * 16) * 1024 + col0;
#pragma unroll
                for (int bj = 0; bj < 2; ++bj)
#pragma unroll
                    for (int n = 0; n < 2; ++n) { const f32x4 v = acc[ai][bj][m][n]; *(f32x4*)(Of + ro + bj * HALF + n * 16) = v;
                        u32x2 w; w.x = cvt_pk_bf16(v[0], v[1]); w.y = cvt_pk_bf16(v[2], v[3]); *(u32x2*)(Ob + ro + bj * HALF + n * 16) = w; } }
    }
};

template <class Epi, class Sched, bool ALIGN_EPI = false, bool SP2 = false>
__device__ __forceinline__ void gemm_phase(PG8_LAS unsigned char* lds, const Gemm g, const Sched& S, const Epi& E) {
    int tid = threadIdx.x; asm volatile("" : "+v"(tid));
    const int wid = __builtin_amdgcn_readfirstlane(tid >> 6), lane = tid & 63, wr = wid >> 2, wc = wid & 3, fr = lane & 15, fq = lane >> 4;
    const int K = g.K, nt = K / BK;
    unsigned voffA[2], voffB[2];
#pragma unroll
    for (int i = 0; i < 2; ++i) { int R, C; stage_rc(tid * 16 + i * 8192, R, C); const int Rb = Epi::PERM ? ((R & ~31) + perm32(R & 31)) : R;
        voffA[i] = (unsigned)(R * K + C) * 2u; voffB[i] = (unsigned)(Rb * K + C) * 2u; }
    const size_t kstep = (size_t)(BK * 2);
    const size_t hstep = (size_t)HALF * K * 2;
    const size_t tstep = 2 * hstep;
    const unsigned ldsw = (unsigned)wid * 1024u;
    const int aoff = lds_byte(wr * 64 + fr, fq * 8), boff = lds_byte(wc * 32 + fr, fq * 8);
#define PG8_SA(b, h) (((b) * 2 + (h)) * HTB)
#define PG8_SB(b, h) ((4 + (b) * 2 + (h)) * HTB)
#define PG8_STAGE(bufoff, gbase, voff) do { _Pragma("unroll") for (int _i = 0; _i < 2; ++_i) \
        __builtin_amdgcn_global_load_lds((const unsigned*)((const char*)(gbase) + (voff)[_i]), (PG8_LAS unsigned*)(lds + (bufoff) + ldsw + _i * 8192), 16, 0, 0); } while (0)
#define PG8_LDA(dst, b, h) do { _Pragma("unroll") for (int m = 0; m < 4; ++m) _Pragma("unroll") for (int k = 0; k < 2; ++k) dst[m][k] = *(const PG8_LAS bf16x8*)(lds + PG8_SA(b, h) + aoff + m * 2048 + k * 1024); } while (0)
#define PG8_LDB(dst, b, h) do { _Pragma("unroll") for (int n = 0; n < 2; ++n) _Pragma("unroll") for (int k = 0; k < 2; ++k) dst[n][k] = *(const PG8_LAS bf16x8*)(lds + PG8_SB(b, h) + boff + n * 2048 + k * 1024); } while (0)
#define PG8_MMA(ai, bj, At, Bt) do { __builtin_amdgcn_s_setprio(1); _Pragma("unroll") for (int m = 0; m < 4; ++m) _Pragma("unroll") for (int n = 0; n < 2; ++n) _Pragma("unroll") for (int k = 0; k < 2; ++k) \
        acc[ai][bj][m][n] = __builtin_amdgcn_mfma_f32_16x16x32_bf16(Bt[n][k], At[m][k], acc[ai][bj][m][n], 0, 0, 0); __builtin_amdgcn_s_setprio(0); } while (0)
#define PG8_WAIT_V(n) asm volatile("s_waitcnt vmcnt(" #n ")" ::: "memory")
#define PG8_WAIT_L(n) asm volatile("s_waitcnt lgkmcnt(" #n ")" ::: "memory")
#define PG8_BAR __builtin_amdgcn_s_barrier()
#define PG8_SCHED __builtin_amdgcn_sched_barrier(0)
    Unit cur, nxt; int ui = 0;
    if (!S.next(0, cur)) return;
    f32x4 acc[2][2][4][2];
#pragma unroll
    for (int a = 0; a < 2; ++a)
#pragma unroll
        for (int b = 0; b < 2; ++b)
#pragma unroll
            for (int m = 0; m < 4; ++m)
#pragma unroll
                for (int n = 0; n < 2; ++n) acc[a][b][m][n] = (f32x4){0.f, 0.f, 0.f, 0.f};
    bf16x8 At[4][2], B0[2][2], B1[2][2];
    const char* cA = (const char*)g.A + (size_t)cur.pm * tstep; const char* cB = (const char*)g.Bt + (size_t)cur.pn * tstep;
    S.a_ready(cur);
    if constexpr (SP2) {
        PG8_STAGE(PG8_SB(0, 0), cB, voffB); PG8_STAGE(PG8_SB(0, 1), cB + hstep, voffB); PG8_STAGE(PG8_SA(0, 0), cA, voffA); PG8_STAGE(PG8_SA(0, 1), cA + hstep, voffA);
        if (wr == 1) PG8_BAR;
        PG8_WAIT_V(2); PG8_BAR;
        PG8_STAGE(PG8_SB(1, 0), cB + kstep, voffB); PG8_STAGE(PG8_SA(1, 0), cA + kstep, voffA); PG8_STAGE(PG8_SB(1, 1), cB + hstep + kstep, voffB);
        PG8_WAIT_V(6); PG8_BAR;
    } else {
        PG8_STAGE(PG8_SB(0, 0), cB, voffB); PG8_STAGE(PG8_SA(0, 0), cA, voffA); PG8_STAGE(PG8_SB(0, 1), cB + hstep, voffB); PG8_STAGE(PG8_SA(0, 1), cA + hstep, voffA);
        if (wr == 1) PG8_BAR;
        PG8_WAIT_V(4); PG8_BAR;
        PG8_STAGE(PG8_SB(1, 0), cB + kstep, voffB); PG8_STAGE(PG8_SA(1, 0), cA + kstep, voffA); PG8_STAGE(PG8_SB(1, 1), cB + hstep + kstep, voffB);
        PG8_WAIT_V(6); PG8_BAR;
    }
    for (;;) {
        const bool has_next = S.next(ui + 1, nxt);
        const char* nA = has_next ? (const char*)g.A + (size_t)nxt.pm * tstep : cA; const char* nB = has_next ? (const char*)g.Bt + (size_t)nxt.pn * tstep : cB;
        for (int t = 0; t < nt; t += 2) {
            const bool last = (t == nt - 2);
            const char* a1 = cA + (size_t)(t + 1) * kstep;
            const char* a2 = last ? nA : cA + (size_t)(t + 2) * kstep; const char* b2 = last ? nB : cB + (size_t)(t + 2) * kstep;
            const char* a3 = a2 + kstep; const char* b3 = b2 + kstep;
            if (last && has_next) S.a_ready(nxt);
            if constexpr (SP2) {
            PG8_LDB(B0, 0, 0); PG8_LDB(B1, 0, 1); PG8_SCHED; PG8_LDA(At, 0, 0); PG8_STAGE(PG8_SA(1, 1), a1 + hstep, voffA);
            PG8_WAIT_V(8); PG8_WAIT_L(0); PG8_BAR; PG8_MMA(0, 0, At, B0); PG8_MMA(0, 1, At, B1); PG8_BAR; PG8_SCHED;
            PG8_LDA(At, 0, 1); PG8_STAGE(PG8_SB(0, 0), b2, voffB); PG8_STAGE(PG8_SB(0, 1), b2 + hstep, voffB); PG8_STAGE(PG8_SA(0, 0), a2, voffA);
            PG8_WAIT_V(8); PG8_WAIT_L(0); PG8_BAR; PG8_MMA(1, 0, At, B0); PG8_MMA(1, 1, At, B1); PG8_BAR; PG8_SCHED;
            PG8_LDB(B0, 1, 0); PG8_LDB(B1, 1, 1); PG8_SCHED; PG8_LDA(At, 1, 0); PG8_STAGE(PG8_SA(0, 1), a2 + hstep, voffA);
            PG8_WAIT_V(8); PG8_WAIT_L(0); PG8_BAR; PG8_MMA(0, 0, At, B0); PG8_MMA(0, 1, At, B1); PG8_BAR; PG8_SCHED;
            PG8_LDA(At, 1, 1); PG8_STAGE(PG8_SB(1, 0), b3, voffB); PG8_STAGE(PG8_SB(1, 1), b3 + hstep, voffB); PG8_STAGE(PG8_SA(1, 0), a3, voffA);
            PG8_WAIT_V(8); PG8_WAIT_L(0); PG8_BAR; PG8_MMA(1, 0, At, B0); PG8_MMA(1, 1, At, B1); PG8_BAR; PG8_SCHED;
            } else {
            PG8_LDB(B0, 0, 0); PG8_SCHED; PG8_LDA(At, 0, 0); PG8_STAGE(PG8_SA(1, 1), a1 + hstep, voffA);
            PG8_WAIT_L(8); PG8_BAR; PG8_WAIT_L(0); PG8_MMA(0, 0, At, B0); PG8_BAR; PG8_SCHED;
            PG8_LDB(B1, 0, 1); PG8_STAGE(PG8_SB(0, 0), b2, voffB);
            PG8_BAR; PG8_WAIT_L(0); PG8_MMA(0, 1, At, B1); PG8_BAR;
            PG8_LDA(At, 0, 1); PG8_STAGE(PG8_SA(0, 0), a2, voffA);
            PG8_BAR; PG8_WAIT_L(0); PG8_MMA(1, 0, At, B0); PG8_BAR; PG8_SCHED;
            PG8_STAGE(PG8_SB(0, 1), b2 + hstep, voffB);
            PG8_WAIT_V(6); PG8_BAR; PG8_MMA(1, 1, At, B1); PG8_BAR;
            PG8_LDB(B0, 1, 0); PG8_SCHED; PG8_LDA(At, 1, 0); PG8_STAGE(PG8_SA(0, 1), a2 + hstep, voffA);
            PG8_WAIT_L(8); PG8_BAR; PG8_WAIT_L(0); PG8_MMA(0, 0, At, B0); PG8_BAR; PG8_SCHED;
            PG8_LDB(B1, 1, 1); PG8_STAGE(PG8_SB(1, 0), b3, voffB);
            PG8_BAR; PG8_WAIT_L(0); PG8_MMA(0, 1, At, B1); PG8_BAR;
            PG8_LDA(At, 1, 1); PG8_STAGE(PG8_SA(1, 0), a3, voffA);
            PG8_BAR; PG8_WAIT_L(0); PG8_MMA(1, 0, At, B0); PG8_BAR; PG8_SCHED;
            PG8_STAGE(PG8_SB(1, 1), b3 + hstep, voffB);
            PG8_WAIT_V(6); PG8_BAR; PG8_MMA(1, 1, At, B1); PG8_BAR;
            }
        }
        if constexpr (ALIGN_EPI) { if (wr == 0) PG8_BAR; }
        if constexpr (!Epi::AFTER_DRAIN) { E(acc, cur, wr, wc, fr, fq); S.done(cur); }
        if (!has_next) break;
#pragma unroll
        for (int a = 0; a < 2; ++a)
#pragma unroll
            for (int b = 0; b < 2; ++b)
#pragma unroll
                for (int m = 0; m < 4; ++m)
#pragma unroll
                    for (int n = 0; n < 2; ++n) acc[a][b][m][n] = (f32x4){0.f, 0.f, 0.f, 0.f};
        cur = nxt; cA = nA; cB = nB; ++ui;
        if constexpr (ALIGN_EPI) { if (wr == 1) PG8_BAR; }
    }
    PG8_WAIT_V(0);
    if constexpr (!ALIGN_EPI) { if (wr == 0) PG8_BAR; }
    PG8_BAR;
#undef PG8_SA
#undef PG8_SB
#undef PG8_STAGE
#undef PG8_LDA
#undef PG8_LDB
#undef PG8_MMA
#undef PG8_WAIT_V
#undef PG8_WAIT_L
#undef PG8_BAR
#undef PG8_SCHED
}
}

#include <hip/hip_cooperative_groups.h>
namespace mk {
namespace cg = cooperative_groups;
#define LAS __attribute__((address_space(3)))
#define GAS __attribute__((address_space(1)))
typedef unsigned short bf16;
typedef float f32x4 __attribute__((ext_vector_type(4)));
typedef float f32x16 __attribute__((ext_vector_type(16)));
typedef unsigned u32x4 __attribute__((ext_vector_type(4)));
typedef unsigned u32x2 __attribute__((ext_vector_type(2)));
typedef short bf16x8 __attribute__((ext_vector_type(8)));
typedef short s16x4 __attribute__((ext_vector_type(4)));
typedef short v4i16_t __attribute__((ext_vector_type(4)));

constexpr int NWAVES = 8, NTHR = 512;
constexpr int D = 1024, NP = 16384, NS = 1024, NT = NP + NS, NIN = 8208, NZ = 8192, FF = 4096, NMEM = 2048;
constexpr size_t O_YP = 0, O_YS = 16777216, O_SGP = 17825792, O_SRP = 18874368, O_MK = 19922944, O_MV = 22020096, O_SGS = 24117248, O_SRS = 40894464, O_END = 57671680;
constexpr int ZC_GQ = 0, ZC_GK = 512, ZC_GV = 1024, ZC_GR = 2048, ZC_RQ = 3072, ZC_RK = 3584, ZC_RV = 4096, ZC_RG = 5120, ZC_GA = 6144, ZC_GB = 7168;
constexpr size_t MiB = 1u << 20;
constexpr size_t WS_CTL = 0, WS_WIN = 1 * MiB, WS_WMO = 17 * MiB, WS_WXQ = 21 * MiB, WS_WXKV = 23 * MiB, WS_WXO = 27 * MiB, WS_WUP = 29 * MiB, WS_WDN = 37 * MiB, WS_ROPE = 45 * MiB, WS_GAL = 47 * MiB,
                 WS_MB = 49 * MiB, WS_MKB = 53 * MiB, WS_MVB = 57 * MiB, WS_H = 61 * MiB, WS_Z = 95 * MiB, WS_Q = WS_Z, WS_O = WS_Z + 34 * MiB, WS_U = WS_Z + 68 * MiB, WS_MG = 367 * MiB, WS_T = 435 * MiB, WS_END = 540 * MiB;
constexpr int LDS_BYTES = 147456, MISC_OFF = LDS_BYTES - 64;
constexpr float EPS = 1e-6f;

__device__ __forceinline__ unsigned pk2(float lo, float hi) { return pg8::cvt_pk_bf16(lo, hi); }
__device__ __forceinline__ float bf2f(unsigned short u) { return __uint_as_float((unsigned)u << 16); }
__device__ __forceinline__ float bflo(unsigned w) { return __uint_as_float(w << 16); }
__device__ __forceinline__ float bfhi(unsigned w) { return __uint_as_float(w & 0xffff0000u); }
__device__ __forceinline__ unsigned short f2bf(float f) { return (unsigned short)(pk2(f, 0.f) & 0xffffu); }
__device__ __forceinline__ float wave_sum(float v) {
#pragma unroll
    for (int o = 1; o < 64; o <<= 1) v += __shfl_xor(v, o);
    return v;
}
#define MFMA32(a, b, c) __builtin_amdgcn_mfma_f32_32x32x16_bf16((a), (b), (c), 0, 0, 0)
__device__ __forceinline__ int crow(int reg, int h) { return (reg & 3) + 8 * (reg >> 2) + 4 * h; }
__device__ __forceinline__ bf16x8 pack8(const f32x16& x, int s) {
    u32x4 p; p.x = pk2(x[8 * s + 0], x[8 * s + 1]); p.y = pk2(x[8 * s + 2], x[8 * s + 3]); p.z = pk2(x[8 * s + 4], x[8 * s + 5]); p.w = pk2(x[8 * s + 6], x[8 * s + 7]);
    return __builtin_bit_cast(bf16x8, p);
}
__device__ __forceinline__ s16x4 vtr(const LAS unsigned char* p) { return __builtin_bit_cast(s16x4, __builtin_amdgcn_ds_read_tr16_b64_v4i16((LAS v4i16_t*)p)); }
__device__ __forceinline__ bf16x8 cat8(s16x4 lo, s16x4 hi) { return __builtin_shufflevector(lo, hi, 0, 1, 2, 3, 4, 5, 6, 7); }

struct Params {
    const float* in[26];
    float* out; unsigned char* ws; float* yout;
    int stop_after;
    int pad;
};
enum { I_XP = 0, I_XS, I_SG, I_SR, I_CK, I_CV, I_MEM, I_WIN, I_WA2, I_BA, I_GGLA, I_GRET, I_WMO, I_WXQ, I_WXK, I_WXV, I_WXO, I_GMEM, I_WUP, I_WDN, I_GPM, I_GQM, I_GPX, I_GQX, I_GPF, I_GQF };

__device__ __forceinline__ void transpose_item(const float* W, int ldw, int col_off, int N, bf16* WT, int ldt, int row_off, int kcol_off, LAS float* scr, int item, int lane) {
    const int nblk = N / 32, kb = item / nblk, nb = item % nblk, k0 = 64 * kb, n0 = 32 * nb;
#pragma unroll 8
    for (int i = 0; i < 32; ++i) { const int kk = 2 * i + (lane >> 5); scr[kk * 33 + (lane & 31)] = W[(size_t)(k0 + kk) * ldw + col_off + n0 + (lane & 31)]; }
    asm volatile("s_waitcnt lgkmcnt(0)" ::: "memory");
    const int c = lane & 7;
#pragma unroll
    for (int j = 0; j < 4; ++j) { const int n = (lane >> 3) + 8 * j; const LAS float* s = scr + (8 * c) * 33 + n;
        u32x4 o; o.x = pk2(s[0 * 33], s[1 * 33]); o.y = pk2(s[2 * 33], s[3 * 33]); o.z = pk2(s[4 * 33], s[5 * 33]); o.w = pk2(s[6 * 33], s[7 * 33]);
        *(u32x4*)(WT + (size_t)(row_off + n0 + n) * ldt + kcol_off + k0 + 8 * c) = o; }
    asm volatile("s_waitcnt lgkmcnt(0)" ::: "memory");
}

template <bool GA>
__device__ __forceinline__ void rms_row_bf16(const float* xrow, const float* g, bf16* orow, const LAS float* wga, float* garow, int lane) {
    f32x4 v[4]; float s = 0.f;
#pragma unroll
    for (int j = 0; j < 4; ++j) { v[j] = ((const f32x4*)xrow)[lane + 64 * j]; s += (v[j].x * v[j].x + v[j].y * v[j].y) + (v[j].z * v[j].z + v[j].w * v[j].w); }
    const float rs = 1.0f / sqrtf(wave_sum(s) * (1.f / D) + EPS);
#pragma unroll
    for (int j = 0; j < 4; ++j) { const f32x4 gg = ((const f32x4*)g)[lane + 64 * j]; v[j] = v[j] * rs * gg; }
#pragma unroll
    for (int j = 0; j < 4; ++j) { u32x2 w; w.x = pk2(v[j].x, v[j].y); w.y = pk2(v[j].z, v[j].w); ((u32x2*)orow)[lane + 64 * j] = w; }
    if (GA) {
        float mine = 0.f;
#pragma unroll
        for (int r = 0; r < 16; ++r) {
            float a = 0.f;
#pragma unroll
            for (int j = 0; j < 4; ++j) { const f32x4 w = ((const LAS f32x4*)(wga + r * 1024))[lane + 64 * j]; a += (v[j].x * w.x + v[j].y * w.y) + (v[j].z * w.z + v[j].w * w.w); }
            a = wave_sum(a);
            if (lane == r) mine = a;
        }
        if (lane < 16) garow[lane] = mine;
    }
}

__device__ __forceinline__ void phase0(const Params& P, LAS unsigned char* lds, int vcu, int G) {
    int tid = threadIdx.x; asm volatile("" : "+v"(tid));
    const int lane = tid & 63, wave = __builtin_amdgcn_readfirstlane(tid >> 6);
    unsigned char* ws = P.ws;
    LAS float* wga = (LAS float*)lds;
    LAS float* scr = (LAS float*)(lds + 65536 + wave * 8704);
    { const float* W = P.in[I_WIN];
      for (int k = tid; k < 1024; k += NTHR) {
#pragma unroll
          for (int q = 0; q < 4; ++q) { const f32x4 w = *(const f32x4*)(W + (size_t)k * NIN + 3072 + 4 * q); wga[(4 * q + 0) * 1024 + k] = w.x; wga[(4 * q + 1) * 1024 + k] = w.y; wga[(4 * q + 2) * 1024 + k] = w.z; wga[(4 * q + 3) * 1024 + k] = w.w; } } }
    const int gw = vcu * NWAVES + wave, NGW = G * NWAVES;
    constexpr int I_IN = (D / 64) * (NZ / 32), I_SQ = (D / 64) * (D / 32), I_UP = (D / 64) * (FF / 32), I_DN = (FF / 64) * (D / 32);
    constexpr int NITEMS = I_IN + 5 * I_SQ + I_UP + I_DN;
    for (int it = gw; it < NITEMS; it += NGW) {
        int r = it;
        if (r < I_IN) { const int nb = r % (NZ / 32); const int coff = (nb * 32 >= 3072) ? 16 : 0;
            transpose_item(P.in[I_WIN], NIN, coff, NZ, (bf16*)(ws + WS_WIN), D, 0, 0, scr, r, lane); continue; } r -= I_IN;
        if (r < I_SQ) { transpose_item(P.in[I_WMO], D, 0, D, (bf16*)(ws + WS_WMO), 2 * D, 0, 0, scr, r, lane); transpose_item(P.in[I_WMO], D, 0, D, (bf16*)(ws + WS_WMO), 2 * D, 0, D, scr, r, lane); continue; } r -= I_SQ;
        if (r < I_SQ) { transpose_item(P.in[I_WXQ], D, 0, D, (bf16*)(ws + WS_WXQ), D, 0, 0, scr, r, lane); continue; } r -= I_SQ;
        if (r < I_SQ) { transpose_item(P.in[I_WXK], D, 0, D, (bf16*)(ws + WS_WXKV), D, 0, 0, scr, r, lane); continue; } r -= I_SQ;
        if (r < I_SQ) { transpose_item(P.in[I_WXV], D, 0, D, (bf16*)(ws + WS_WXKV), D, D, 0, scr, r, lane); continue; } r -= I_SQ;
        if (r < I_SQ) { transpose_item(P.in[I_WXO], D, 0, D, (bf16*)(ws + WS_WXO), D, 0, 0, scr, r, lane); continue; } r -= I_SQ;
        if (r < I_UP) { transpose_item(P.in[I_WUP], FF, 0, FF, (bf16*)(ws + WS_WUP), D, 0, 0, scr, r, lane); continue; } r -= I_UP;
        transpose_item(P.in[I_WDN], D, 0, D, (bf16*)(ws + WS_WDN), FF, 0, 0, scr, r, lane);
    }
    { float* tab = (float*)(ws + WS_ROPE);
      for (int e = (vcu * NTHR + tid); e < 2056 * 64; e += G * NTHR) { const int p = e >> 6, i = e & 63; const int pos = p < 2048 ? p : 16384 + (p - 2048);
          const float inv = (float)pow(10000.0, -(double)i / 64.0); const float ang = (float)pos * inv;
          tab[2 * e] = (float)cos((double)ang); tab[2 * e + 1] = (float)sin((double)ang); } }
    __syncthreads();
    for (int m = gw; m < NT + NMEM; m += NGW) {
        if (m < NT) { const float* xr = m < NP ? P.in[I_XP] + (size_t)m * D : P.in[I_XS] + (size_t)(m - NP) * D;
            rms_row_bf16<true>(xr, P.in[I_GPM], (bf16*)(ws + WS_H) + (size_t)m * D, wga, (float*)(ws + WS_GAL) + (size_t)m * 16, lane); }
        else { const int r = m - NT; rms_row_bf16<false>(P.in[I_MEM] + (size_t)r * D, P.in[I_GMEM], (bf16*)(ws + WS_MB) + (size_t)r * D, wga, nullptr, lane); }
    }
}

__device__ __forceinline__ void row_phase(const float* xop, const float* xos, const float* t, const float* g1, float* xnew, const float* g2, bf16* hn, int vcu, int G) {
    int tid = threadIdx.x; asm volatile("" : "+v"(tid));
    const int lane = tid & 63, wave = __builtin_amdgcn_readfirstlane(tid >> 6);
    const int gw = vcu * NWAVES + wave, NGW = G * NWAVES;
    for (int m = gw; m < NT; m += NGW) {
        const float* xo = (xos && m >= NP) ? xos + (size_t)(m - NP) * D : xop + (size_t)m * D;
        f32x4 tv[4], xv[4]; float s = 0.f;
#pragma unroll
        for (int j = 0; j < 4; ++j) { tv[j] = ((const f32x4*)(t + (size_t)m * D))[lane + 64 * j]; xv[j] = ((const f32x4*)xo)[lane + 64 * j]; s += (tv[j].x * tv[j].x + tv[j].y * tv[j].y) + (tv[j].z * tv[j].z + tv[j].w * tv[j].w); }
        const float rs = 1.0f / sqrtf(wave_sum(s) * (1.f / D) + EPS);
        float s2 = 0.f;
#pragma unroll
        for (int j = 0; j < 4; ++j) { const f32x4 gg = ((const f32x4*)g1)[lane + 64 * j]; xv[j] = xv[j] + tv[j] * rs * gg; ((f32x4*)(xnew + (size_t)m * D))[lane + 64 * j] = xv[j];
            s2 += (xv[j].x * xv[j].x + xv[j].y * xv[j].y) + (xv[j].z * xv[j].z + xv[j].w * xv[j].w); }
        if (hn) {
            const float rs2 = 1.0f / sqrtf(wave_sum(s2) * (1.f / D) + EPS);
#pragma unroll
            for (int j = 0; j < 4; ++j) { const f32x4 gg = ((const f32x4*)g2)[lane + 64 * j]; const f32x4 o = xv[j] * rs2 * gg; u32x2 w; w.x = pk2(o.x, o.y); w.y = pk2(o.z, o.w); ((u32x2*)(hn + (size_t)m * D))[lane + 64 * j] = w; }
        }
    }
}


#define XB_TMO      128
#define XB_XCNT(j)  (256  + 64 * (j))
#define XB_XSUB(j)  (1280 + 64 * (j))
#define XB_XGEN(j)  (2304 + 64 * (j))
#define XB_TOP      3328
#define XB_TOPGEN   3392
#define XCD_BAR_WORDS 3456
#define XB_SPIN_CAP (1u << 22)
__device__ __forceinline__ unsigned xb_ld(unsigned* p)              { return __hip_atomic_load(p, __ATOMIC_RELAXED, __HIP_MEMORY_SCOPE_AGENT); }
__device__ __forceinline__ unsigned xb_add(unsigned* p, unsigned v) { return __hip_atomic_fetch_add(p, v, __ATOMIC_RELAXED, __HIP_MEMORY_SCOPE_AGENT); }
__device__ __forceinline__ unsigned xb_xcc_id() { return (unsigned)__builtin_amdgcn_s_getreg((3 << 11) | 20) & 0xFu; }
#define XB_SPIN(cond, bar) do { unsigned _sp = 0; while (cond) { __builtin_amdgcn_s_sleep(1); \
    if ((++_sp & 255u) == 0u) { if (xb_ld(&(bar)[XB_TMO])) break; if (_sp > XB_SPIN_CAP) { atomicAdd(&(bar)[XB_TMO], 1u); break; } } } } while (0)
struct XcdBarrier { unsigned* bar; unsigned x; volatile LAS unsigned* st; };
__device__ __forceinline__ XcdBarrier xcd_barrier_post(unsigned* bar, volatile LAS unsigned* st) {
    XcdBarrier b; b.bar = bar; b.x = xb_xcc_id(); b.st = st;
    if (threadIdx.x == 0) (void)xb_add(&bar[XB_XCNT(b.x)], 1u);
    return b;
}
__device__ __forceinline__ void xcd_barrier_complete(unsigned* bar, unsigned x, unsigned& nloc, unsigned& nx) {
    const unsigned G = gridDim.x * gridDim.y * gridDim.z;
    unsigned sum, cnt, mine, sp = 0u;
    for (;;) {
        sum = 0u; cnt = 0u; mine = 0u;
#pragma unroll
        for (unsigned j = 0; j < 16; ++j) { const unsigned c = xb_ld(&bar[XB_XCNT(j)]); sum += c; cnt += (c > 0u) ? 1u : 0u; mine = (j == x) ? c : mine; }
        if (sum == G) break;
        __builtin_amdgcn_s_sleep(1);
        if ((++sp & 255u) == 0u) { if (xb_ld(&bar[XB_TMO])) break; if (sp > XB_SPIN_CAP) { atomicAdd(&bar[XB_TMO], 1u); break; } }
    }
    nloc = mine > 0u ? mine : 1u; nx = cnt > 0u ? cnt : 1u;
}
__device__ __forceinline__ void xcd_barrier(const XcdBarrier& b) {
    asm volatile("s_waitcnt vmcnt(0)" ::: "memory");
    __syncthreads();
    if (threadIdx.x == 0) {
        unsigned* bar = b.bar;
        __builtin_amdgcn_s_waitcnt(0);
        unsigned nloc = b.st[0], nx = b.st[1];
        if (nloc == 0u) { xcd_barrier_complete(bar, b.x, nloc, nx); b.st[0] = nloc; b.st[1] = nx; }
        const unsigned old = xb_add(&bar[XB_XSUB(b.x)], 1u);
        const unsigned gen = old / nloc;
        if (old + 1u == (gen + 1u) * nloc) {
            __builtin_amdgcn_fence(__ATOMIC_RELEASE, "agent");
            asm volatile("s_waitcnt vmcnt(0)" ::: "memory");
            const unsigned og = xb_add(&bar[XB_TOP], 1u);
            const unsigned tg = og / nx;
            if (og + 1u == (tg + 1u) * nx) xb_add(&bar[XB_TOPGEN], 1u);
            else XB_SPIN(xb_ld(&bar[XB_TOPGEN]) == tg, bar);
            __builtin_amdgcn_fence(__ATOMIC_ACQUIRE, "agent");
            xb_add(&bar[XB_XGEN(b.x)], 1u);
            asm volatile("s_waitcnt vmcnt(0)" ::: "memory");
        } else {
            XB_SPIN(xb_ld(&bar[XB_XGEN(b.x)]) == gen, bar);
            __builtin_amdgcn_fence(__ATOMIC_ACQUIRE, "agent");
            asm volatile("s_waitcnt vmcnt(0)" ::: "memory");
        }
    }
    __syncthreads();
}

constexpr int SG_STR = 68, SG_SLAB = 64 * SG_STR * 4;
static_assert(8 * SG_SLAB <= LDS_BYTES - 64, "small-gemm LDS");
struct SEpiF32 { float* O; int ldc;
    __device__ __forceinline__ void operator()(int row, int col, const float (&v)[8]) const { float* p = O + (size_t)row * ldc + col; *(f32x4*)p = (f32x4){v[0], v[1], v[2], v[3]}; *(f32x4*)(p + 4) = (f32x4){v[4], v[5], v[6], v[7]}; } };
struct SEpiBf16 { bf16* O; int ldc;
    __device__ __forceinline__ void operator()(int row, int col, const float (&v)[8]) const { u32x4 o; o.x = pk2(v[0], v[1]); o.y = pk2(v[2], v[3]); o.z = pk2(v[4], v[5]); o.w = pk2(v[6], v[7]); *(u32x4*)(O + (size_t)row * ldc + col) = o; } };
template <class SEpi>
__device__ __forceinline__ void small_gemm(LAS unsigned char* lds, const bf16* A, const bf16* Bt, int K, int N, int vcu, int G, const SEpi& E) {
    int tid = threadIdx.x; asm volatile("" : "+v"(tid));
    const int lane = tid & 63, w = __builtin_amdgcn_readfirstlane(tid >> 6), r32 = lane & 31, hh = lane >> 5;
    const int nun = 16 * (N / 64), kw = K / 8;
    for (int u = vcu; u < nun; u += G) {
        const int tm = u & 15, tn = u >> 4;
        f32x16 acc[2][2];
#pragma unroll
        for (int i = 0; i < 2; ++i)
#pragma unroll
            for (int j = 0; j < 2; ++j)
#pragma unroll
                for (int rg = 0; rg < 16; ++rg) acc[i][j][rg] = 0.f;
        const bf16* Ap = A + (size_t)(tm * 64 + r32) * K + w * kw + 8 * hh;
        const bf16* Bp = Bt + (size_t)(tn * 64 + r32) * K + w * kw + 8 * hh;
        const size_t r32k = (size_t)32 * K;
#pragma unroll 4
        for (int ks = 0; ks < kw / 16; ++ks) {
            const bf16x8 a0 = *(const bf16x8*)(Ap + ks * 16), a1 = *(const bf16x8*)(Ap + r32k + ks * 16);
            const bf16x8 b0 = *(const bf16x8*)(Bp + ks * 16), b1 = *(const bf16x8*)(Bp + r32k + ks * 16);
            acc[0][0] = MFMA32(a0, b0, acc[0][0]); acc[0][1] = MFMA32(a0, b1, acc[0][1]); acc[1][0] = MFMA32(a1, b0, acc[1][0]); acc[1][1] = MFMA32(a1, b1, acc[1][1]);
        }
        LAS float* slab = (LAS float*)(lds + w * SG_SLAB);
#pragma unroll
        for (int i = 0; i < 2; ++i)
#pragma unroll
            for (int j = 0; j < 2; ++j)
#pragma unroll
                for (int rg = 0; rg < 16; ++rg) slab[(32 * i + crow(rg, hh)) * SG_STR + 32 * j + r32] = acc[i][j][rg];
        __syncthreads();
        { const int row = tid >> 3, c8 = (tid & 7) * 8;
          f32x4 s0 = (f32x4){0.f, 0.f, 0.f, 0.f}, s1 = s0;
#pragma unroll
          for (int q = 0; q < 8; ++q) { const LAS float* p = (const LAS float*)(lds + q * SG_SLAB) + row * SG_STR + c8; s0 += *(const LAS f32x4*)p; s1 += *(const LAS f32x4*)(p + 4); }
          const float v[8] = {s0.x, s0.y, s0.z, s0.w, s1.x, s1.y, s1.z, s1.w};
          E(tm * 64 + row, tn * 64 + c8, v); }
        __syncthreads();
    }
}

constexpr int L_QT = 0, L_KT = 17408, L_KHT = 34816, L_EBL = 53248, L_IMG = 53760;
constexpr int QT_STR = 272, KHT_STR = 144, P_STR = 144, V_STR = 576;
constexpr int LA_RQ = 53760, LA_RK = 70144, LA_GAL = 86528, LA_PRE = 90624, LA_END = 92672;
constexpr int LB_P = 53760, LB_V = 62976, LB_END = 99840;
constexpr int REC_BYTES = L_IMG, REC_CHUNKS = REC_BYTES / 16  , SREC_BYTES = 6912, SREC_CHUNKS = 432;
constexpr size_t WS_REC = WS_T, WS_SREC = WS_H;
static_assert(WS_REC + (size_t)2048 * REC_BYTES <= WS_END && (size_t)1024 * SREC_BYTES <= 34 * MiB, "record space");
__device__ __forceinline__ int dperm(int d) { return (d & ~12) | ((d & 4) << 1) | ((d & 8) >> 1); }
#define LAUNDER(x) asm volatile("" : "+v"(x))

template <int BR>
__device__ __forceinline__ void prep_unit(const Params& P, LAS unsigned char* lds, int h, int rowc, int Tv, int pidx, unsigned char* rec, bool compact) {
    const int tid0 = threadIdx.x;
    const bf16* Z = (const bf16*)(P.ws + WS_Z);
    const float* GAL = (const float*)(P.ws + WS_GAL);
    const float* ROPE = (const float*)(P.ws + WS_ROPE);
    const int cq = (BR == 0 ? ZC_GQ : ZC_RQ) + h * 128, ck = (BR == 0 ? ZC_GK : ZC_RK) + h * 128;
    const float scale = 0.08838834764831845f;
    const float lg = BR == 1 ? log1pf(-exp2f(-5.0f - (float)h)) : 0.f;
    { int tid = tid0; LAUNDER(tid);
#pragma unroll
      for (int i = 0; i < 2; ++i) { const int ch = tid + 512 * i, t = ch >> 4, c8 = ch & 15; const bool ok = t < Tv;
          const u32x4 q = ok ? *(const u32x4*)(Z + (size_t)(rowc + t) * NZ + cq + c8 * 8) : (u32x4){0u, 0u, 0u, 0u};
          const u32x4 k = ok ? *(const u32x4*)(Z + (size_t)(rowc + t) * NZ + ck + c8 * 8) : (u32x4){0u, 0u, 0u, 0u};
          *(LAS u32x4*)(lds + LA_RQ + t * 256 + c8 * 16) = q; *(LAS u32x4*)(lds + LA_RK + t * 256 + c8 * 16) = k; }
      if (BR == 0 && tid < 256) { const int t = tid >> 2, c4 = tid & 3; *(LAS f32x4*)(lds + LA_GAL + tid * 16) = t < Tv ? *(const f32x4*)(GAL + (size_t)(rowc + t) * 16 + c4 * 4) : (f32x4){0.f, 0.f, 0.f, 0.f}; } }
    __syncthreads();
    {
        int tid = tid0; LAUNDER(tid); const int pd = tid & 127, ptq = tid >> 7;
        const int pp = dperm(pd);
        const bool work = (16 * ptq) < Tv;
        unsigned kh[8];
#pragma unroll
        for (int i = 0; i < 8; ++i) kh[i] = 0u;
        if (BR == 0) {
            float la[16];
#pragma unroll
            for (int i = 0; i < 16; ++i) la[i] = 0.f;
            if (work) {
                float w2r[16];
#pragma unroll
                for (int r = 0; r < 16; ++r) w2r[r] = P.in[I_WA2][r * 512 + h * 128 + pd];
                const float bias = P.in[I_BA][h * 128 + pd];
#pragma unroll
                for (int i = 0; i < 16; ++i) { const int t = 16 * ptq + i;
                    float x = bias;
#pragma unroll
                    for (int q4 = 0; q4 < 4; ++q4) { const f32x4 g = *(const LAS f32x4*)(lds + LA_GAL + t * 64 + q4 * 16); x += g.x * w2r[4 * q4] + g.y * w2r[4 * q4 + 1] + g.z * w2r[4 * q4 + 2] + g.w * w2r[4 * q4 + 3]; }
                    const float ls = fminf(x, 0.f) - __logf(1.0f + __expf(-fabsf(x)));
                    la[i] = t < Tv ? ls * (1.0f / 16.0f) : 0.f; }
#pragma unroll
                for (int i = 1; i < 16; ++i) la[i] += la[i - 1];
            }
            ((LAS float*)(lds + LA_PRE))[ptq * 128 + pd] = la[15];
            __syncthreads();
            float base = 0.f, btot = 0.f;
#pragma unroll
            for (int q = 0; q < 4; ++q) { const float v = ((const LAS float*)(lds + LA_PRE))[q * 128 + pd]; btot += v; if (q < ptq) base += v; }
            if (ptq == 0) ((LAS float*)(lds + L_EBL))[pd] = __expf(btot);
            if (work) {
#pragma unroll
                for (int i = 0; i < 16; ++i) { const int t = 16 * ptq + i; const float bt = base + la[i];
                    const float qv = bf2f(*(const LAS unsigned short*)(lds + LA_RQ + t * 256 + pd * 2)), kv = bf2f(*(const LAS unsigned short*)(lds + LA_RK + t * 256 + pd * 2));
                    *(LAS unsigned short*)(lds + L_QT + t * QT_STR + pp * 2) = f2bf(qv * (__expf(bt) * scale));
                    *(LAS unsigned short*)(lds + L_KT + t * QT_STR + pp * 2) = f2bf(kv * __expf(-bt));
                    const float k3 = kv * __expf(btot - bt);
                    if (i & 1) kh[i >> 1] = (kh[i >> 1] & 0xffffu) | ((unsigned)f2bf(k3) << 16); else kh[i >> 1] = (unsigned)f2bf(k3); }
            }
        } else {
            const float btot = (float)Tv * lg;
            if (ptq == 0) ((LAS float*)(lds + L_EBL))[pd] = __expf(btot);
            if (work) {
                const int fi = pd & 63; const float sgn = pd < 64 ? -1.f : 1.f;
#pragma unroll
                for (int i = 0; i < 16; ++i) { const int t = 16 * ptq + i;
                    const float bt = (float)(t < Tv ? t + 1 : Tv) * lg;
                    const int pi = pidx + (t < Tv ? t : 0);
                    const float cs = ROPE[(size_t)(pi * 64 + fi) * 2], sn = ROPE[(size_t)(pi * 64 + fi) * 2 + 1];
                    const float q1 = bf2f(*(const LAS unsigned short*)(lds + LA_RQ + t * 256 + pd * 2)), q2 = bf2f(*(const LAS unsigned short*)(lds + LA_RQ + t * 256 + (pd ^ 64) * 2));
                    const float k1 = bf2f(*(const LAS unsigned short*)(lds + LA_RK + t * 256 + pd * 2)), k2 = bf2f(*(const LAS unsigned short*)(lds + LA_RK + t * 256 + (pd ^ 64) * 2));
                    const float qv = q1 * cs + sgn * q2 * sn, kv = k1 * cs + sgn * k2 * sn;
                    *(LAS unsigned short*)(lds + L_QT + t * QT_STR + pp * 2) = f2bf(qv * __expf(bt));
                    *(LAS unsigned short*)(lds + L_KT + t * QT_STR + pp * 2) = f2bf(kv * (__expf(-bt) * scale));
                    const float k3 = kv * (__expf(btot - bt) * scale);
                    if (i & 1) kh[i >> 1] = (kh[i >> 1] & 0xffffu) | ((unsigned)f2bf(k3) << 16); else kh[i >> 1] = (unsigned)f2bf(k3); }
            }
        }
        if (work) {
            *(LAS u32x4*)(lds + L_KHT + pd * KHT_STR + ptq * 32) = (u32x4){kh[0], kh[1], kh[2], kh[3]};
            *(LAS u32x4*)(lds + L_KHT + pd * KHT_STR + ptq * 32 + 16) = (u32x4){kh[4], kh[5], kh[6], kh[7]};
        }
    }
    __syncthreads();
    { int tid = tid0; LAUNDER(tid);
      if (!compact) {
#pragma unroll
          for (int i = 0; i < 7; ++i) { const int ch = tid + 512 * i; if (ch < REC_CHUNKS) *(u32x4*)(rec + (size_t)ch * 16) = *(const LAS u32x4*)(lds + ch * 16); }
      } else if (tid < SREC_CHUNKS) {
          int src;
          if (tid < 136) src = L_QT + tid * 16; else if (tid < 272) src = L_KT + (tid - 136) * 16; else if (tid < 400) src = L_KHT + (tid - 272) * KHT_STR; else src = L_EBL + (tid - 400) * 16;
          *(u32x4*)(rec + (size_t)tid * 16) = *(const LAS u32x4*)(lds + src);
      } }
}
__device__ __forceinline__ void phase2a(const Params& P, LAS unsigned char* lds, int vcu, int G) {
    for (int u = vcu; u < 2048 + 1024; u += G) {
        const bool prompt = u < 2048;
        const int v = prompt ? u : u - 2048;
        const int c = prompt ? (v & 31) : 0, br = prompt ? ((v >> 5) & 1) : (v & 1), h = prompt ? ((v >> 6) & 3) : ((v >> 1) & 3), b = prompt ? (v >> 8) : (v >> 3);
        const int rowc = prompt ? b * 2048 + c * 64 : NP + b * 8, Tv = prompt ? 64 : 8, pidx = prompt ? c * 64 : 2048;
        unsigned char* rec = prompt ? P.ws + WS_REC + (size_t)v * REC_BYTES : P.ws + WS_SREC + (size_t)v * SREC_BYTES;
        if (br == 0) prep_unit<0>(P, lds, h, rowc, Tv, pidx, rec, !prompt); else prep_unit<1>(P, lds, h, rowc, Tv, pidx, rec, !prompt);
        __syncthreads();
    }
}

__device__ __forceinline__ void chain_unit(const Params& P, LAS unsigned char* lds, int br, int b, int h, int row_base, int nch, int Tv, const unsigned char* rec0, bool compact, const float* s0, float* s_out) {
    const int tid0 = threadIdx.x, w = __builtin_amdgcn_readfirstlane(tid0 >> 6);
    const bf16* Z = (const bf16*)(P.ws + WS_Z);
    bf16* MG = (bf16*)(P.ws + WS_MG);
    const int cv = (br == 0 ? ZC_GV : ZC_RV) + h * 256;
    f32x16 S[4];
    { int t0 = tid0; LAUNDER(t0); const int r32 = t0 & 31, hh = (t0 >> 5) & 1;
#pragma unroll
      for (int T = 0; T < 4; ++T)
#pragma unroll
          for (int rg = 0; rg < 16; ++rg) S[T][rg] = s0 ? s0[((size_t)(b * 4 + h) * 128 + 32 * T + crow(rg, hh)) * 256 + 32 * w + r32] : 0.f; }
    u32x4 pr[7], pv[4];
#define P2B_PREFETCH(cc_) do { int tid = tid0; LAUNDER(tid); const int rowp_ = row_base + (cc_) * 64; \
    if (!compact) { const unsigned char* rc_ = rec0 + (size_t)(cc_) * REC_BYTES; \
        _Pragma("unroll") for (int i = 0; i < 7; ++i) { const int ch = tid + 512 * i; pr[i] = ch < REC_CHUNKS ? *(const u32x4*)(rc_ + (size_t)ch * 16) : (u32x4){0u, 0u, 0u, 0u}; } } \
    else pr[0] = tid < SREC_CHUNKS ? *(const u32x4*)(rec0 + (size_t)tid * 16) : (u32x4){0u, 0u, 0u, 0u}; \
    _Pragma("unroll") for (int i = 0; i < 4; ++i) { const int ch = tid + 512 * i, t = ch >> 5, c8 = ch & 31; \
        pv[i] = t < Tv ? *(const u32x4*)(Z + (size_t)(rowp_ + t) * NZ + cv + c8 * 8) : (u32x4){0u, 0u, 0u, 0u}; } } while (0)
    P2B_PREFETCH(0);
    for (int c = 0; c < nch; ++c) {
        const int rowc = row_base + c * 64;
        { int tid = tid0; LAUNDER(tid);
          if (!compact) {
#pragma unroll
              for (int i = 0; i < 7; ++i) { const int ch = tid + 512 * i; if (ch < REC_CHUNKS) *(LAS u32x4*)(lds + ch * 16) = pr[i]; }
          } else if (tid < SREC_CHUNKS) {
              int dst;
              if (tid < 136) dst = L_QT + tid * 16; else if (tid < 272) dst = L_KT + (tid - 136) * 16; else if (tid < 400) dst = L_KHT + (tid - 272) * KHT_STR; else dst = L_EBL + (tid - 400) * 16;
              *(LAS u32x4*)(lds + dst) = pr[0];
          }
#pragma unroll
          for (int i = 0; i < 4; ++i) { const int ch = tid + 512 * i, t = ch >> 5, c8 = ch & 31; *(LAS u32x4*)(lds + LB_V + t * V_STR + c8 * 16) = pv[i]; } }
        if (c + 1 < nch) P2B_PREFETCH(c + 1);
        __syncthreads();
        int lane = tid0 & 63; LAUNDER(lane); const int r32 = lane & 31, hh = lane >> 5;
        {
            const int fr = lane & 15, fq = lane >> 4, tb = w >> 1;
#pragma unroll
            for (int j = 0; j < 2; ++j) { const int sb = 2 * (w & 1) + j;
                pg8::f32x4 acc = (pg8::f32x4){0.f, 0.f, 0.f, 0.f};
                if (sb <= tb) {
#pragma unroll
                    for (int ks = 0; ks < 4; ++ks) {
                        const bf16x8 kf = *(const LAS bf16x8*)(lds + L_KT + (16 * sb + fr) * QT_STR + (32 * ks + 8 * fq) * 2);
                        const bf16x8 qf = *(const LAS bf16x8*)(lds + L_QT + (16 * tb + fr) * QT_STR + (32 * ks + 8 * fq) * 2);
                        acc = __builtin_amdgcn_mfma_f32_16x16x32_bf16(kf, qf, acc, 0, 0, 0);
                    }
                }
                const int tg = 16 * tb + fr;
                float v[4];
#pragma unroll
                for (int e = 0; e < 4; ++e) { const int sg = 16 * sb + 4 * fq + e; v[e] = sg <= tg ? acc[e] : 0.f; }
                u32x2 o; o.x = pk2(v[0], v[1]); o.y = pk2(v[2], v[3]);
                *(LAS u32x2*)(lds + LB_P + tg * P_STR + (16 * sb + 4 * fq) * 2) = o;
            }
        }
        bf16x8 vf[4];
        { const int g16 = (lane >> 4) & 1, i16 = lane & 15, q_ = i16 >> 2, p_ = i16 & 3;
          const LAS unsigned char* vb = lds + LB_V + (8 * hh + q_) * V_STR + (32 * w + 16 * g16 + 4 * p_) * 2;
#pragma unroll
          for (int ks = 0; ks < 4; ++ks) vf[ks] = cat8(vtr(vb + (16 * ks) * V_STR), vtr(vb + (16 * ks + 4) * V_STR)); }
        f32x16 OT[2];
#pragma unroll
        for (int mi = 0; mi < 2; ++mi) {
#pragma unroll
            for (int rg = 0; rg < 16; ++rg) OT[mi][rg] = 0.f; }
#pragma unroll
        for (int T = 0; T < 4; ++T)
#pragma unroll
            for (int s = 0; s < 2; ++s) { const bf16x8 sa = pack8(S[T], s);
#pragma unroll
                for (int mi = 0; mi < 2; ++mi) { const bf16x8 qf = *(const LAS bf16x8*)(lds + L_QT + (32 * mi + r32) * QT_STR + (32 * T + 16 * s + 8 * hh) * 2); OT[mi] = MFMA32(sa, qf, OT[mi]); } }
#pragma unroll
        for (int T = 0; T < 4; ++T) {
#pragma unroll
            for (int rg = 0; rg < 16; ++rg) S[T][rg] *= ((const LAS float*)(lds + L_EBL))[32 * T + crow(rg, hh)];
#pragma unroll
            for (int ks = 0; ks < 4; ++ks) { const bf16x8 kf = *(const LAS bf16x8*)(lds + L_KHT + (32 * T + r32) * KHT_STR + (16 * ks + 8 * hh) * 2); S[T] = MFMA32(kf, vf[ks], S[T]); } }
        __syncthreads();
#pragma unroll
        for (int mi = 0; mi < 2; ++mi)
#pragma unroll
            for (int ks = 0; ks < 4; ++ks) { if (mi == 0 && ks >= 2) continue;
                const bf16x8 pf = *(const LAS bf16x8*)(lds + LB_P + (32 * mi + r32) * P_STR + (16 * ks + 8 * hh) * 2); OT[mi] = MFMA32(vf[ks], pf, OT[mi]); }
#pragma unroll
        for (int mi = 0; mi < 2; ++mi) { const int t = 32 * mi + r32;
            if (t < Tv) { bf16* orow = MG + (size_t)(rowc + t) * 2048 + br * 1024 + h * 256 + 32 * w + 4 * hh;
#pragma unroll
                for (int g = 0; g < 4; ++g) { u32x2 o; o.x = pk2(OT[mi][4 * g], OT[mi][4 * g + 1]); o.y = pk2(OT[mi][4 * g + 2], OT[mi][4 * g + 3]); *(u32x2*)(orow + 8 * g) = o; } } }
        __syncthreads();
    }
#undef P2B_PREFETCH
    { int t0 = tid0; LAUNDER(t0); const int r32 = t0 & 31, hh = (t0 >> 5) & 1;
#pragma unroll
      for (int T = 0; T < 4; ++T)
#pragma unroll
          for (int rg = 0; rg < 16; ++rg) s_out[((size_t)(b * 4 + h) * 128 + 32 * T + crow(rg, hh)) * 256 + 32 * w + r32] = S[T][rg]; }
}
__device__ __forceinline__ void phase2b(const Params& P, LAS unsigned char* lds, int vcu, int G) {
    const bool prompt = vcu < 64; const int nw = G - 64;
    if (!prompt) {
        for (int i = threadIdx.x; i < L_IMG / 16; i += NTHR) *(LAS u32x4*)(lds + i * 16) = (u32x4){0u, 0u, 0u, 0u};
        __syncthreads();
    }
    for (int u = prompt ? vcu : vcu - 64; u < (prompt ? 64 : 1024); u += (prompt ? 64 : nw)) {
        const int br = u & 1, h = (u >> 1) & 3, b = u >> 3;
        const int row_base = prompt ? b * 2048 : NP + b * 8, nch = prompt ? 32 : 1, Tv = prompt ? 64 : 8;
        const unsigned char* rec0 = prompt ? P.ws + WS_REC + (size_t)(((b * 4 + h) * 2 + br) * 32) * REC_BYTES : P.ws + WS_SREC + (size_t)u * SREC_BYTES;
        const float* s0 = prompt ? nullptr : (br == 0 ? P.in[I_SG] : P.in[I_SR]);
        float* s_out = P.out + (prompt ? (br == 0 ? O_SGP : O_SRP) : (br == 0 ? O_SGS : O_SRS));
        chain_unit(P, lds, br, b, h, row_base, nch, Tv, rec0, !prompt, s0, s_out);
    }
}

__device__ __forceinline__ void phase2c(const Params& P, int vcu, int G) {
    int tid = threadIdx.x; LAUNDER(tid);
    const int lane = tid & 63, wave = __builtin_amdgcn_readfirstlane(tid >> 6);
    const int gw = vcu * NWAVES + wave, NGW = G * NWAVES;
    const bf16* Z = (const bf16*)(P.ws + WS_Z); bf16* MG = (bf16*)(P.ws + WS_MG);
    for (int it = gw; it < 2 * NT; it += NGW) {
        const int row = it >> 1, br = it & 1;
        const int cg1 = (br == 0 ? ZC_GR : ZC_RG), cg2 = (br == 0 ? ZC_GA : ZC_GB);
        const float* ghead = P.in[br == 0 ? I_GGLA : I_GRET];
        bf16* mrow = MG + (size_t)row * 2048 + br * 1024 + 4 * lane;
        const bf16* zr = Z + (size_t)row * NZ + 4 * lane;
        u32x2 ov[4], g1[4], g2[4]; f32x4 gh[4];
#pragma unroll
        for (int h = 0; h < 4; ++h) { ov[h] = *(const u32x2*)(mrow + h * 256); g1[h] = *(const u32x2*)(zr + cg1 + h * 256); g2[h] = *(const u32x2*)(zr + cg2 + h * 256); gh[h] = *(const f32x4*)(ghead + h * 256 + 4 * lane); }
#pragma unroll
        for (int h = 0; h < 4; ++h) {
            float o[4] = {bflo(ov[h].x), bfhi(ov[h].x), bflo(ov[h].y), bfhi(ov[h].y)};
            float mu = 0.f;
            if (br == 1) mu = wave_sum((o[0] + o[1]) + (o[2] + o[3])) * (1.0f / 256.0f);
#pragma unroll
            for (int e = 0; e < 4; ++e) o[e] -= mu;
            const float q = wave_sum((o[0] * o[0] + o[1] * o[1]) + (o[2] * o[2] + o[3] * o[3]));
            const float rstd = __builtin_amdgcn_rsqf(q * (1.0f / 256.0f) + EPS);
            const float a[4] = {bflo(g1[h].x), bfhi(g1[h].x), bflo(g1[h].y), bfhi(g1[h].y)}, gt[4] = {bflo(g2[h].x), bfhi(g2[h].x), bflo(g2[h].y), bfhi(g2[h].y)};
            const float gg[4] = {gh[h].x, gh[h].y, gh[h].z, gh[h].w};
            float res[4];
#pragma unroll
            for (int e = 0; e < 4; ++e) res[e] = o[e] * rstd * gg[e] * a[e] * __builtin_amdgcn_rcpf((1.0f + __expf(-a[e])) * (1.0f + __expf(-gt[e])));
            u32x2 w; w.x = pk2(res[0], res[1]); w.y = pk2(res[2], res[3]);
            *(u32x2*)(mrow + h * 256) = w;
        }
    }
}

constexpr int A_K = 0, AK_STR = 272, A_V = 34816, AV_STR = 320, A_END = 34816 + 40960;
#define P6_STAGE(src_, mt_, ch_, lbase_, lstr_) do { \
    _Pragma("unroll") for (int i = 0; i < 4; ++i) { const int ch = tid + 512 * i, m = ch >> 4, c8 = ch & 15; \
        const size_t off = (((size_t)b * 256 + 128 * (mt_) + m) * 4 + h) * 256 + 128 * (ch_) + c8 * 8; \
        u32x4 v; \
        if (F32SRC) { const f32x4 a = *(const f32x4*)((const float*)(src_) + off), c = *(const f32x4*)((const float*)(src_) + off + 4); v.x = pk2(a.x, a.y); v.y = pk2(a.z, a.w); v.z = pk2(c.x, c.y); v.w = pk2(c.z, c.w); } \
        else v = *(const u32x4*)((const bf16*)(src_) + off); \
        *(LAS u32x4*)(lds + (lbase_) + m * (lstr_) + c8 * 16) = v; } } while (0)

template <bool F32SRC>
__device__ __forceinline__ void attn_unit(const Params& P, LAS unsigned char* lds, int b, int h, int row0, int nq, const void* Kp, const void* Vp) {
    int tid = threadIdx.x; asm volatile("" : "+v"(tid));
    const int lane = tid & 63, w = __builtin_amdgcn_readfirstlane(tid >> 6), r32 = lane & 31, hh = lane >> 5;
    const bf16* Q = (const bf16*)(P.ws + WS_Q); bf16* Oo = (bf16*)(P.ws + WS_O);
    const bool active = (32 * w) < nq;
    const int t = 32 * w + r32; const bool tok = t < nq;
    f32x16 sT[8];
#pragma unroll
    for (int i = 0; i < 8; ++i)
#pragma unroll
        for (int rg = 0; rg < 16; ++rg) sT[i][rg] = 0.f;
#pragma unroll
    for (int dh = 0; dh < 2; ++dh) {
        bf16x8 qf[8];
#pragma unroll
        for (int ks = 0; ks < 8; ++ks) qf[ks] = tok ? *(const bf16x8*)(Q + (size_t)(row0 + t) * D + h * 256 + 128 * dh + 16 * ks + 8 * hh) : (bf16x8){0, 0, 0, 0, 0, 0, 0, 0};
#pragma unroll
        for (int mt = 0; mt < 2; ++mt) {
            P6_STAGE(Kp, mt, dh, A_K, AK_STR);
            __syncthreads();
            if (active) {
#pragma unroll
                for (int mi = 0; mi < 4; ++mi)
#pragma unroll
                    for (int ks = 0; ks < 8; ++ks) { const bf16x8 kf = *(const LAS bf16x8*)(lds + A_K + (32 * mi + r32) * AK_STR + (16 * ks + 8 * hh) * 2);
                        sT[4 * mt + mi] = MFMA32(kf, qf[ks], sT[4 * mt + mi]); }
            }
            __syncthreads();
        }
    }
    float mx = -3.0e38f;
#pragma unroll
    for (int i = 0; i < 8; ++i)
#pragma unroll
        for (int rg = 0; rg < 16; ++rg) mx = fmaxf(mx, sT[i][rg]);
    mx = fmaxf(mx, __shfl_xor(mx, 32));
    const float c2 = 0.0625f * 1.4426950408889634f;
    float sum = 0.f;
    bf16x8 pf[8][2];
#pragma unroll
    for (int i = 0; i < 8; ++i) {
#pragma unroll
        for (int rg = 0; rg < 16; ++rg) { const float p = __builtin_amdgcn_exp2f((sT[i][rg] - mx) * c2); sT[i][rg] = p; sum += p; }
        pf[i][0] = pack8(sT[i], 0); pf[i][1] = pack8(sT[i], 1); }
    sum += __shfl_xor(sum, 32);
    const float rinv = 1.0f / sum;
    const int g16 = (lane >> 4) & 1, i16 = lane & 15, q_ = i16 >> 2, p_ = i16 & 3;
#pragma unroll
    for (int nh = 0; nh < 2; ++nh) {
        f32x16 oT[4];
#pragma unroll
        for (int i = 0; i < 4; ++i)
#pragma unroll
            for (int rg = 0; rg < 16; ++rg) oT[i][rg] = 0.f;
#pragma unroll
        for (int mt = 0; mt < 2; ++mt) {
            P6_STAGE(Vp, mt, nh, A_V, AV_STR);
            __syncthreads();
            if (active) {
#pragma unroll
                for (int mi = 0; mi < 4; ++mi)
#pragma unroll
                    for (int s = 0; s < 2; ++s) {
                        const bf16x8 pb = pf[4 * mt + mi][s];
#pragma unroll
                        for (int nt = 0; nt < 4; ++nt) {
                            const LAS unsigned char* vb = lds + A_V + (32 * mi + 16 * s + 4 * hh + q_) * AV_STR + (32 * nt + 16 * g16 + 4 * p_) * 2;
                            const bf16x8 va = cat8(vtr(vb), vtr(vb + 8 * AV_STR));
                            oT[nt] = MFMA32(va, pb, oT[nt]);
                        }
                    }
            }
            __syncthreads();
        }
        if (tok) {
            bf16* orow = Oo + (size_t)(row0 + t) * D + h * 256 + 128 * nh;
#pragma unroll
            for (int nt = 0; nt < 4; ++nt)
#pragma unroll
                for (int g = 0; g < 4; ++g) { u32x2 o; o.x = pk2(oT[nt][4 * g] * rinv, oT[nt][4 * g + 1] * rinv); o.y = pk2(oT[nt][4 * g + 2] * rinv, oT[nt][4 * g + 3] * rinv);
                    *(u32x2*)(orow + 32 * nt + 8 * g + 4 * hh) = o; }
        }
    }
}
__device__ __forceinline__ void phase6(const Params& P, LAS unsigned char* lds, int vcu, int G) {
    for (int u = vcu; u < 256 + 512; u += G) {
        if (u < 256) { const int qb = u & 7, h = (u >> 3) & 3, b = u >> 5; attn_unit<false>(P, lds, b, h, b * 2048 + qb * 256, 256, P.ws + WS_MKB, P.ws + WS_MVB); }
        else { const int v = u - 256, h = v & 3, b = v >> 2; attn_unit<true>(P, lds, b, h, NP + b * 8, 8, P.in[I_CK], P.in[I_CV]); }
    }
}

__global__ void __launch_bounds__(NTHR, 2) mega_fwd(Params P) {
    extern __shared__ __attribute__((aligned(16))) unsigned char lds_raw[];
    LAS unsigned char* lds = (LAS unsigned char*)lds_raw;
    cg::grid_group grid = cg::this_grid();
    if (threadIdx.x < 16) ((LAS unsigned*)(lds + MISC_OFF))[threadIdx.x] = 0u;
    __syncthreads();
    const XcdBarrier xbar = xcd_barrier_post((unsigned*)(P.ws + WS_CTL) + 1024, (volatile LAS unsigned*)(lds + MISC_OFF));
    const int G = gridDim.x; const int bx = blockIdx.x; const int vcu = (G % 8 == 0) ? (bx % 8) * (G / 8) + bx / 8 : bx;
    unsigned char* ws = P.ws;
    const int stop = P.stop_after;
#define SEAM(k) do { if (stop <= (k)) return; if ((k) == 0) grid.sync(); else xcd_barrier(xbar); } while (0)
#ifndef NO_P0
    phase0(P, lds, vcu, G);
#endif
    SEAM(0);
    { pg8::Gemm g{(const bf16*)(ws + WS_H), (const bf16*)(ws + WS_WIN), NT, NZ, D}; pg8::StaticOrder S; S.init(NT, NZ, G, bx);
      pg8::EpiBf16<0> E{(bf16*)(ws + WS_Z), NZ};
      pg8::gemm_phase<pg8::EpiBf16<0>, pg8::StaticOrder, true, true>(lds, g, S, E); }
    { pg8::Gemm g{(const bf16*)(ws + WS_MB), (const bf16*)(ws + WS_WXKV), NMEM, 2 * D, D}; pg8::StaticOrder S; S.init(NMEM, 2 * D, G, (bx >= G / 2) ? bx - G / 2 : -1);
      pg8::EpiKV E{P.out + O_MK, P.out + O_MV, (bf16*)(ws + WS_MKB), (bf16*)(ws + WS_MVB)};
      pg8::gemm_phase<pg8::EpiKV, pg8::StaticOrder, true, true>(lds, g, S, E); }
    SEAM(1);
#ifndef NO_P2
    phase2a(P, lds, vcu, G);
    xcd_barrier(xbar);
    phase2b(P, lds, vcu, G);
    xcd_barrier(xbar);
    phase2c(P, vcu, G);
#endif
    SEAM(2);
    { pg8::Gemm g{(const bf16*)(ws + WS_MG), (const bf16*)(ws + WS_WMO), NP, D, 2 * D}; pg8::StaticOrder S; S.init(NP, D, G, bx);
      pg8::EpiF32 E{(float*)(ws + WS_T), D};
      pg8::gemm_phase<pg8::EpiF32, pg8::StaticOrder, true, true>(lds, g, S, E); }
    small_gemm(lds, (const bf16*)(ws + WS_MG) + (size_t)NP * 2 * D, (const bf16*)(ws + WS_WMO), 2 * D, D, vcu, G, SEpiF32{(float*)(ws + WS_T) + (size_t)NP * D, D});
    SEAM(3);
    row_phase(P.in[I_XP], P.in[I_XS], (const float*)(ws + WS_T), P.in[I_GQM], P.yout, P.in[I_GPX], (bf16*)(ws + WS_H), vcu, G);
    SEAM(4);
    { pg8::Gemm g{(const bf16*)(ws + WS_H), (const bf16*)(ws + WS_WXQ), NP, D, D}; pg8::StaticOrder S; S.init(NP, D, G, bx);
      pg8::EpiBf16<0> E{(bf16*)(ws + WS_Q), D};
      pg8::gemm_phase<pg8::EpiBf16<0>, pg8::StaticOrder, true, true>(lds, g, S, E); }
    small_gemm(lds, (const bf16*)(ws + WS_H) + (size_t)NP * D, (const bf16*)(ws + WS_WXQ), D, D, vcu, G, SEpiBf16{(bf16*)(ws + WS_Q) + (size_t)NP * D, D});
    SEAM(5);
#ifndef NO_P6
    phase6(P, lds, vcu, G);
#endif
    SEAM(6);
    { pg8::Gemm g{(const bf16*)(ws + WS_O), (const bf16*)(ws + WS_WXO), NP, D, D}; pg8::StaticOrder S; S.init(NP, D, G, bx);
      pg8::EpiF32 E{(float*)(ws + WS_T), D};
      pg8::gemm_phase<pg8::EpiF32, pg8::StaticOrder, true, true>(lds, g, S, E); }
    small_gemm(lds, (const bf16*)(ws + WS_O) + (size_t)NP * D, (const bf16*)(ws + WS_WXO), D, D, vcu, G, SEpiF32{(float*)(ws + WS_T) + (size_t)NP * D, D});
    SEAM(7);
    row_phase(P.yout, nullptr, (const float*)(ws + WS_T), P.in[I_GQX], P.yout, P.in[I_GPF], (bf16*)(ws + WS_H), vcu, G);
    SEAM(8);
    { pg8::Gemm g{(const bf16*)(ws + WS_H), (const bf16*)(ws + WS_WUP), NT, FF, D}; pg8::StaticOrder S; S.init(NT, FF, G, bx);
      pg8::EpiBf16<2> E{(bf16*)(ws + WS_U), FF};
      pg8::gemm_phase<pg8::EpiBf16<2>, pg8::StaticOrder, true, true>(lds, g, S, E); }
    SEAM(9);
    { pg8::Gemm g{(const bf16*)(ws + WS_U), (const bf16*)(ws + WS_WDN), NP, D, FF}; pg8::StaticOrder S; S.init(NP, D, G, bx);
      pg8::EpiF32 E{(float*)(ws + WS_T), D};
      pg8::gemm_phase<pg8::EpiF32, pg8::StaticOrder, true, true>(lds, g, S, E); }
    small_gemm(lds, (const bf16*)(ws + WS_U) + (size_t)NP * FF, (const bf16*)(ws + WS_WDN), FF, D, vcu, G, SEpiF32{(float*)(ws + WS_T) + (size_t)NP * D, D});
    SEAM(10);
    row_phase(P.yout, nullptr, (const float*)(ws + WS_T), P.in[I_GQF], P.yout, nullptr, nullptr, vcu, G);
#undef SEAM
}
}


#ifndef HYBRID
#define HYBRID 0
#endif
extern "C" void kernel_launch(void* const* d_in, const int* in_sizes, int n_in, void* d_out, int out_size, void* d_ws, size_t ws_size, hipStream_t stream) {
    static int grid = 0;
    if (grid == 0) {
        if (n_in != 26 || out_size != (int)mk::O_END || ws_size < mk::WS_END) { fprintf(stderr, "kernel_launch: unexpected sizes n_in %d out %d ws %zu\n", n_in, out_size, ws_size); grid = -1; return; }
        int dev = 0, cus = 0, per_cu = 0;
        if (hipGetDevice(&dev) != hipSuccess || hipDeviceGetAttribute(&cus, hipDeviceAttributeMultiprocessorCount, dev) != hipSuccess) { grid = -1; return; }
        if (hipFuncSetAttribute((const void*)mk::mega_fwd, hipFuncAttributeMaxDynamicSharedMemorySize, mk::LDS_BYTES) != hipSuccess) { fprintf(stderr, "kernel_launch: hipFuncSetAttribute failed\n"); grid = -1; return; }
        if (hipOccupancyMaxActiveBlocksPerMultiprocessor(&per_cu, (const void*)mk::mega_fwd, mk::NTHR, mk::LDS_BYTES) != hipSuccess || per_cu < 1) { fprintf(stderr, "kernel_launch: occupancy query says %d\n", per_cu); grid = -1; (void)hipGetLastError(); return; }
        grid = cus;
    }
    if (grid < 0) return;
    if (hipMemsetAsync((char*)d_ws + mk::WS_CTL, 0, 65536, stream) != hipSuccess) { fprintf(stderr, "kernel_launch: memset failed\n"); return; }
    mk::Params p{};
    for (int i = 0; i < 26; ++i) p.in[i] = (const float*)d_in[i];
    p.out = (float*)d_out; p.ws = (unsigned char*)d_ws; p.yout = (float*)d_out + mk::O_YP; p.stop_after = 100; p.pad = 0;
    void* args[] = {&p};
    hipError_t e = hipLaunchCooperativeKernel((const void*)mk::mega_fwd, dim3(grid), dim3(mk::NTHR), args, mk::LDS_BYTES, stream);
    if (e != hipSuccess) fprintf(stderr, "cooperative launch failed: %s (grid %d)\n", hipGetErrorString(e), grid);
#ifdef PROBE_STOP
    if (hipMemsetAsync((char*)d_ws + mk::WS_CTL, 0, 65536, stream) != hipSuccess) return;
    mk::Params p2 = p; p2.stop_after = PROBE_STOP; p2.yout = (float*)((unsigned char*)d_ws + mk::WS_MG);
    void* args2[] = {&p2};
    e = hipLaunchCooperativeKernel((const void*)mk::mega_fwd, dim3(grid), dim3(mk::NTHR), args2, mk::LDS_BYTES, stream);
    if (e != hipSuccess) fprintf(stderr, "cooperative launch 2 failed: %s\n", hipGetErrorString(e));
#endif
}
```

```cpp
#include <hip/hip_runtime.h>
#include <cstdio>
#include <cstdint>

namespace pg8 {
#define PG8_LAS __attribute__((address_space(3)))
typedef unsigned short bf16_t;
typedef short bf16x8 __attribute__((ext_vector_type(8)));
typedef float f32x4 __attribute__((ext_vector_type(4)));
typedef unsigned u32x4 __attribute__((ext_vector_type(4)));
typedef unsigned u32x2 __attribute__((ext_vector_type(2)));
constexpr int BM = 256, BK = 64, HALF = 128, HTB = HALF * BK * 2  , STAGE_BYTES = 8 * HTB, NXCD = 8, WGM = 8;

__host__ __device__ __forceinline__ int lds_byte(int r, int c) { const int st = (r >> 4) * 2 + (c >> 5), rr = r & 15, cc = c & 31, ob = rr * 64 + cc * 2; return st * 1024 + (ob ^ (((ob >> 9) & 1) << 5)); }
__host__ __device__ __forceinline__ void stage_rc(int b, int& R, int& C) { const int st = b / 1024, sb = b % 1024, swz = sb ^ (((sb >> 9) & 1) << 5); R = (st >> 1) * 16 + swz / 64; C = (st & 1) * 32 + (swz % 64) / 2; }
__host__ __device__ __forceinline__ int perm32(int rho) { const int n = rho >> 4, i = rho & 15; return 8 * (i >> 2) + 4 * n + (i & 3); }

struct Unit { int pm, pn; };
struct Gemm { const bf16_t* A; const bf16_t* Bt; int M, N, K; };

struct StaticOrder {
    int nM, nN, nwg, G, c;
    __host__ __device__ void init(int M, int N, int G_, int c_) { nM = M / BM; nN = N / BM; nwg = nM * nN; G = G_; c = c_; }
    __host__ __device__ bool next(int i, Unit& u) const {
        if (c < 0) return false;
        const long L = (long)i * G + c; if (L >= nwg) return false;
        int wgid = (int)L; { const int q = nwg / NXCD, r = nwg % NXCD, xcd = wgid % NXCD, off = wgid / NXCD; wgid = (xcd < r ? xcd * (q + 1) : r * (q + 1) + (xcd - r) * q) + off; }
        const int nig = WGM * nN, gid = wgid / nig, fm = gid * WGM, gsz = (nM - fm) < WGM ? (nM - fm) : WGM;
        u.pm = fm + ((wgid % nig) % gsz); u.pn = (wgid % nig) / gsz; return true;
    }
    __device__ __forceinline__ void a_ready(const Unit&) const {}
    __device__ __forceinline__ void done(const Unit&) const {}
};

typedef float f32x2_t __attribute__((ext_vector_type(2))); typedef __bf16 bf16x2_t __attribute__((ext_vector_type(2)));
__device__ __forceinline__ unsigned cvt_pk_bf16(float lo, float hi) { f32x2_t v = {lo, hi}; bf16x2_t b = __builtin_convertvector(v, bf16x2_t); return __builtin_bit_cast(unsigned, b); }

template <int ACT  > struct EpiBf16 {
    static constexpr bool PERM = true, AFTER_DRAIN = false;
    bf16_t* O; int ldc;
    __device__ __forceinline__ void operator()(const f32x4 (&acc)[2][2][4][2], const Unit& u, int wr, int wc, int fr, int fq) const {
        const int row0 = u.pm * BM + wr * 64 + fr; const int col0 = u.pn * BM + wc * 32 + 8 * fq;
#pragma unroll
        for (int ai = 0; ai < 2; ++ai)
#pragma unroll
            for (int m = 0; m < 4; ++m) { bf16_t* rowp = O + (size_t)(row0 + ai * HALF + m * 16) * ldc + col0;
#pragma unroll
                for (int bj = 0; bj < 2; ++bj) { f32x4 v0 = acc[ai][bj][m][0], v1 = acc[ai][bj][m][1];
                    if (ACT == 2) {
#pragma unroll
                        for (int e = 0; e < 4; ++e) { const float a = v0[e] > 0.f ? v0[e] : 0.f, b = v1[e] > 0.f ? v1[e] : 0.f; v0[e] = a * a; v1[e] = b * b; } }
                    u32x4 w; w.x = cvt_pk_bf16(v0[0], v0[1]); w.y = cvt_pk_bf16(v0[2], v0[3]); w.z = cvt_pk_bf16(v1[0], v1[1]); w.w = cvt_pk_bf16(v1[2], v1[3]);
                    *(u32x4*)(rowp + bj * HALF) = w; } }
    }
};
struct EpiF32 {
    static constexpr bool PERM = false, AFTER_DRAIN = false;
    float* O; int ldc;
    __device__ __forceinline__ void operator()(const f32x4 (&acc)[2][2][4][2], const Unit& u, int wr, int wc, int fr, int fq) const {
        const int row0 = u.pm * BM + wr * 64 + fr; const int col0 = u.pn * BM + wc * 32 + 4 * fq;
#pragma unroll
        for (int ai = 0; ai < 2; ++ai)
#pragma unroll
            for (int m = 0; m < 4; ++m) { float* rowp = O + (size_t)(row0 + ai * HALF + m * 16) * ldc + col0;
#pragma unroll
                for (int bj = 0; bj < 2; ++bj)
#pragma unroll
                    for (int n = 0; n < 2; ++n) *(f32x4*)(rowp + bj * HALF + n * 16) = acc[ai][bj][m][n]; }
    }
};
struct EpiKV {
    static constexpr bool PERM = false, AFTER_DRAIN = false;
    float* OK; float* OV; bf16_t* BK_; bf16_t* BV_;
    __device__ __forceinline__ void operator()(const f32x4 (&acc)[2][2][4][2], const Unit& u, int wr, int wc, int fr, int fq) const {
        const int row0 = u.pm * BM + wr * 64 + fr; const bool isv = u.pn >= 4; const int col0 = (u.pn & 3) * BM + wc * 32 + 4 * fq;
        float* Of = isv ? OV : OK; bf16_t* Ob = isv ? BV_ : BK_;
#pragma unroll
        for (int ai = 0; ai < 2; ++ai)
#pragma unroll
            for (int m = 0; m < 4; ++m) { const size_t ro = (size_t)(row0 + ai * HALF + m * 16) * 1024 + col0;
#pragma unroll
                for (int bj = 0; bj < 2; ++bj)
#pragma unroll
                    for (int n = 0; n < 2; ++n) { const f32x4 v = acc[ai][bj][m][n]; *(f32x4*)(Of + ro + bj * HALF + n * 16) = v;
                        u32x2 w; w.x = cvt_pk_bf16(v[0], v[1]); w.y = cvt_pk_bf16(v[2], v[3]); *(u32x2*)(Ob + ro + bj * HALF + n * 16) = w; } }
    }
};

template <class Epi, class Sched, bool ALIGN_EPI = false, bool SP2 = false>
__device__ __forceinline__ void gemm_phase(PG8_LAS unsigned char* lds, const Gemm g, const Sched& S, const Epi& E) {
    int tid = threadIdx.x; asm volatile("" : "+v"(tid));
    const int wid = __builtin_amdgcn_readfirstlane(tid >> 6), lane = tid & 63, wr = wid >> 2, wc = wid & 3, fr = lane & 15, fq = lane >> 4;
    const int K = g.K, nt = K / BK;
    unsigned voffA[2], voffB[2];
#pragma unroll
    for (int i = 0; i < 2; ++i) { int R, C; stage_rc(tid * 16 + i * 8192, R, C); const int Rb = Epi::PERM ? ((R & ~31) + perm32(R & 31)) : R;
        voffA[i] = (unsigned)(R * K + C) * 2u; voffB[i] = (unsigned)(Rb * K + C) * 2u; }
    const size_t kstep = (size_t)(BK * 2);
    const size_t hstep = (size_t)HALF * K * 2;
    const size_t tstep = 2 * hstep;
    const unsigned ldsw = (unsigned)wid * 1024u;
    const int aoff = lds_byte(wr * 64 + fr, fq * 8), boff = lds_byte(wc * 32 + fr, fq * 8);
#define PG8_SA(b, h) (((b) * 2 + (h)) * HTB)
#define PG8_SB(b, h) ((4 + (b) * 2 + (h)) * HTB)
#define PG8_STAGE(bufoff, gbase, voff) do { _Pragma("unroll") for (int _i = 0; _i < 2; ++_i) \
        __builtin_amdgcn_global_load_lds((const unsigned*)((const char*)(gbase) + (voff)[_i]), (PG8_LAS unsigned*)(lds + (bufoff) + ldsw + _i * 8192), 16, 0, 0); } while (0)
#define PG8_LDA(dst, b, h) do { _Pragma("unroll") for (int m = 0; m < 4; ++m) _Pragma("unroll") for (int k = 0; k < 2; ++k) dst[m][k] = *(const PG8_LAS bf16x8*)(lds + PG8_SA(b, h) + aoff + m * 2048 + k * 1024); } while (0)
#define PG8_LDB(dst, b, h) do { _Pragma("unroll") for (int n = 0; n < 2; ++n) _Pragma("unroll") for (int k = 0; k < 2; ++k) dst[n][k] = *(const PG8_LAS bf16x8*)(lds + PG8_SB(b, h) + boff + n * 2048 + k * 1024); } while (0)
#define PG8_MMA(ai, bj, At, Bt) do { __builtin_amdgcn_s_setprio(1); _Pragma("unroll") for (int m = 0; m < 4; ++m) _Pragma("unroll") for (int n = 0; n < 2; ++n) _Pragma("unroll") for (int k = 0; k < 2; ++k) \
        acc[ai][bj][m][n] = __builtin_amdgcn_mfma_f32_16x16x32_bf16(Bt[n][k], At[m][k], acc[ai][bj][m][n], 0, 0, 0); __builtin_amdgcn_s_setprio(0); } while (0)
#define PG8_WAIT_V(n) asm volatile("s_waitcnt vmcnt(" #n ")" ::: "memory")
#define PG8_WAIT_L(n) asm volatile("s_waitcnt lgkmcnt(" #n ")" ::: "memory")
#define PG8_BAR __builtin_amdgcn_s_barrier()
#define PG8_SCHED __builtin_amdgcn_sched_barrier(0)
    Unit cur, nxt; int ui = 0;
    if (!S.next(0, cur)) return;
    f32x4 acc[2][2][4][2];
#pragma unroll
    for (int a = 0; a < 2; ++a)
#pragma unroll
        for (int b = 0; b < 2; ++b)
#pragma unroll
            for (int m = 0; m < 4; ++m)
#pragma unroll
                for (int n = 0; n < 2; ++n) acc[a][b][m][n] = (f32x4){0.f, 0.f, 0.f, 0.f};
    bf16x8 At[4][2], B0[2][2], B1[2][2];
    const char* cA = (const char*)g.A + (size_t)cur.pm * tstep; const char* cB = (const char*)g.Bt + (size_t)cur.pn * tstep;
    S.a_ready(cur);
    if constexpr (SP2) {
        PG8_STAGE(PG8_SB(0, 0), cB, voffB); PG8_STAGE(PG8_SB(0, 1), cB + hstep, voffB); PG8_STAGE(PG8_SA(0, 0), cA, voffA); PG8_STAGE(PG8_SA(0, 1), cA + hstep, voffA);
        if (wr == 1) PG8_BAR;
        PG8_WAIT_V(2); PG8_BAR;
        PG8_STAGE(PG8_SB(1, 0), cB + kstep, voffB); PG8_STAGE(PG8_SA(1, 0), cA + kstep, voffA); PG8_STAGE(PG8_SB(1, 1), cB + hstep + kstep, voffB);
        PG8_WAIT_V(6); PG8_BAR;
    } else {
        PG8_STAGE(PG8_SB(0, 0), cB, voffB); PG8_STAGE(PG8_SA(0, 0), cA, voffA); PG8_STAGE(PG8_SB(0, 1), cB + hstep, voffB); PG8_STAGE(PG8_SA(0, 1), cA + hstep, voffA);
        if (wr == 1) PG8_BAR;
        PG8_WAIT_V(4); PG8_BAR;
        PG8_STAGE(PG8_SB(1, 0), cB + kstep, voffB); PG8_STAGE(PG8_SA(1, 0), cA + kstep, voffA); PG8_STAGE(PG8_SB(1, 1), cB + hstep + kstep, voffB);
        PG8_WAIT_V(6); PG8_BAR;
    }
    for (;;) {
        const bool has_next = S.next(ui + 1, nxt);
        const char* nA = has_next ? (const char*)g.A + (size_t)nxt.pm * tstep : cA; const char* nB = has_next ? (const char*)g.Bt + (size_t)nxt.pn * tstep : cB;
        for (int t = 0; t < nt; t += 2) {
            const bool last = (t == nt - 2);
            const char* a1 = cA + (size_t)(t + 1) * kstep;
            const char* a2 = last ? nA : cA + (size_t)(t + 2) * kstep; const char* b2 = last ? nB : cB + (size_t)(t + 2) * kstep;
            const char* a3 = a2 + kstep; const char* b3 = b2 + kstep;
            if (last && has_next) S.a_ready(nxt);
            if constexpr (SP2) {
            PG8_LDB(B0, 0, 0); PG8_LDB(B1, 0, 1); PG8_SCHED; PG8_LDA(At, 0, 0); PG8_STAGE(PG8_SA(1, 1), a1 + hstep, voffA);
            PG8_WAIT_V(8); PG8_WAIT_L(0); PG8_BAR; PG8_MMA(0, 0, At, B0); PG8_MMA(0, 1, At, B1); PG8_BAR; PG8_SCHED;
            PG8_LDA(At, 0, 1); PG8_STAGE(PG8_SB(0, 0), b2, voffB); PG8_STAGE(PG8_SB(0, 1), b2 + hstep, voffB); PG8_STAGE(PG8_SA(0, 0), a2, voffA);
            PG8_WAIT_V(8); PG8_WAIT_L(0); PG8_BAR; PG8_MMA(1, 0, At, B0); PG8_MMA(1, 1, At, B1); PG8_BAR; PG8_SCHED;
            PG8_LDB(B0, 1, 0); PG8_LDB(B1, 1, 1); PG8_SCHED; PG8_LDA(At, 1, 0); PG8_STAGE(PG8_SA(0, 1), a2 + hstep, voffA);
            PG8_WAIT_V(8); PG8_WAIT_L(0); PG8_BAR; PG8_MMA(0, 0, At, B0); PG8_MMA(0, 1, At, B1); PG8_BAR; PG8_SCHED;
            PG8_LDA(At, 1, 1); PG8_STAGE(PG8_SB(1, 0), b3, voffB); PG8_STAGE(PG8_SB(1, 1), b3 + hstep, voffB); PG8_STAGE(PG8_SA(1, 0), a3, voffA);
            PG8_WAIT_V(8); PG8_WAIT_L(0); PG8_BAR; PG8_MMA(1, 0, At, B0); PG8_MMA(1, 1, At, B1); PG8_BAR; PG8_SCHED;
            } else {
            PG8_LDB(B0, 0, 0); PG8_SCHED; PG8_LDA(At, 0, 0); PG8_STAGE(PG8_SA(1, 1), a1 + hstep, voffA);
            PG8_WAIT_L(8); PG8_BAR; PG8_WAIT_L(0); PG8_MMA(0, 0, At, B0); PG8_BAR; PG8_SCHED;
            PG8_LDB(B1, 0, 1); PG8_STAGE(PG8_SB(0, 0), b2, voffB);
            PG8_BAR; PG8_WAIT_L(0); PG8_MMA(0, 1, At, B1); PG8_BAR;
            PG8_LDA(At, 0, 1); PG8_STAGE(PG8_SA(0, 0), a2, voffA);
            PG8_BAR; PG8_WAIT_L(0); PG8_MMA(1, 0, At, B0); PG8_BAR; PG8_SCHED;
            PG8_STAGE(PG8_SB(0, 1), b2 + hstep, voffB);
            PG8_WAIT_V(6); PG8_BAR; PG8_MMA(1, 1, At, B1); PG8_BAR;
            PG8_LDB(B0, 1, 0); PG8_SCHED; PG8_LDA(At, 1, 0); PG8_STAGE(PG8_SA(0, 1), a2 + hstep, voffA);
            PG8_WAIT_L(8); PG8_BAR; PG8_WAIT_L(0); PG8_MMA(0, 0, At, B0); PG8_BAR; PG8_SCHED;
            PG8_LDB(B1, 1, 1); PG8_STAGE(PG8_SB(1, 0), b3, voffB);
            PG8_BAR; PG8_WAIT_L(0); PG8_MMA(0, 1, At, B1); PG8_BAR;
            PG8_LDA(At, 1, 1); PG8_STAGE(PG8_SA(1, 0), a3, voffA);
            PG8_BAR; PG8_WAIT_L(0); PG8_MMA(1, 0, At, B0); PG8_BAR; PG8_SCHED;
            PG8_STAGE(PG8_SB(1, 1), b3 + hstep, voffB);
            PG8_WAIT_V(6); PG8_BAR; PG8_MMA(1, 1, At, B1); PG8_BAR;
            }
        }
        if constexpr (ALIGN_EPI) { if (wr == 0) PG8_BAR; }
        if constexpr (!Epi::AFTER_DRAIN) { E(acc, cur, wr, wc, fr, fq); S.done(cur); }
        if (!has_next) break;
#pragma unroll
        for (int a = 0; a < 2; ++a)
#pragma unroll
            for (int b = 0; b < 2; ++b)
#pragma unroll
                for (int m = 0; m < 4; ++m)
#pragma unroll
                    for (int n = 0; n < 2; ++n) acc[a][b][m][n] = (f32x4){0.f, 0.f, 0.f, 0.f};
        cur = nxt; cA = nA; cB = nB; ++ui;
        if constexpr (ALIGN_EPI) { if (wr == 1) PG8_BAR; }
    }
    PG8_WAIT_V(0);
    if constexpr (!ALIGN_EPI) { if (wr == 0) PG8_BAR; }
    PG8_BAR;
#undef PG8_SA
#undef PG8_SB
#undef PG8_STAGE
#undef PG8_LDA
#undef PG8_LDB
#undef PG8_MMA
#undef PG8_WAIT_V
#undef PG8_WAIT_L
#undef PG8_BAR
#undef PG8_SCHED
}
}

#include <hip/hip_cooperative_groups.h>
namespace mk {
namespace cg = cooperative_groups;
#define LAS __attribute__((address_space(3)))
#define GAS __attribute__((address_space(1)))
typedef unsigned short bf16;
typedef float f32x4 __attribute__((ext_vector_type(4)));
typedef float f32x16 __attribute__((ext_vector_type(16)));
typedef unsigned u32x4 __attribute__((ext_vector_type(4)));
typedef unsigned u32x2 __attribute__((ext_vector_type(2)));
typedef short bf16x8 __attribute__((ext_vector_type(8)));
typedef short s16x4 __attribute__((ext_vector_type(4)));
typedef short v4i16_t __attribute__((ext_vector_type(4)));

constexpr int NWAVES = 8, NTHR = 512;
constexpr int D = 1024, NP = 16384, NS = 1024, NT = NP + NS, NIN = 8208, NZ = 8192, FF = 4096, NMEM = 2048;
constexpr size_t O_YP = 0, O_YS = 16777216, O_SGP = 17825792, O_SRP = 18874368, O_MK = 19922944, O_MV = 22020096, O_SGS = 24117248, O_SRS = 40894464, O_END = 57671680;
constexpr int ZC_GQ = 0, ZC_GK = 512, ZC_GV = 1024, ZC_GR = 2048, ZC_RQ = 3072, ZC_RK = 3584, ZC_RV = 4096, ZC_RG = 5120, ZC_GA = 6144, ZC_GB = 7168;
constexpr size_t MiB = 1u << 20;
constexpr size_t WS_CTL = 0, WS_WIN = 1 * MiB, WS_WMO = 17 * MiB, WS_WXQ = 21 * MiB, WS_WXKV = 23 * MiB, WS_WXO = 27 * MiB, WS_WUP = 29 * MiB, WS_WDN = 37 * MiB, WS_ROPE = 45 * MiB, WS_GAL = 47 * MiB,
                 WS_MB = 49 * MiB, WS_MKB = 53 * MiB, WS_MVB = 57 * MiB, WS_H = 61 * MiB, WS_Z = 95 * MiB, WS_Q = WS_Z, WS_O = WS_Z + 34 * MiB, WS_U = WS_Z + 68 * MiB, WS_MG = 367 * MiB, WS_T = 435 * MiB, WS_END = 540 * MiB;
constexpr int LDS_BYTES = 147456, MISC_OFF = LDS_BYTES - 64;
constexpr float EPS = 1e-6f;

__device__ __forceinline__ unsigned pk2(float lo, float hi) { return pg8::cvt_pk_bf16(lo, hi); }
__device__ __forceinline__ float bf2f(unsigned short u) { return __uint_as_float((unsigned)u << 16); }
__device__ __forceinline__ float bflo(unsigned w) { return __uint_as_float(w << 16); }
__device__ __forceinline__ float bfhi(unsigned w) { return __uint_as_float(w & 0xffff0000u); }
__device__ __forceinline__ unsigned short f2bf(float f) { return (unsigned short)(pk2(f, 0.f) & 0xffffu); }
__device__ __forceinline__ float wave_sum(float v) {
#pragma unroll
    for (int o = 1; o < 64; o <<= 1) v += __shfl_xor(v, o);
    return v;
}
#define MFMA32(a, b, c) __builtin_amdgcn_mfma_f32_32x32x16_bf16((a), (b), (c), 0, 0, 0)
__device__ __forceinline__ int crow(int reg, int h) { return (reg & 3) + 8 * (reg >> 2) + 4 * h; }
__device__ __forceinline__ bf16x8 pack8(const f32x16& x, int s) {
    u32x4 p; p.x = pk2(x[8 * s + 0], x[8 * s + 1]); p.y = pk2(x[8 * s + 2], x[8 * s + 3]); p.z = pk2(x[8 * s + 4], x[8 * s + 5]); p.w = pk2(x[8 * s + 6], x[8 * s + 7]);
    return __builtin_bit_cast(bf16x8, p);
}
__device__ __forceinline__ s16x4 vtr(const LAS unsigned char* p) { return __builtin_bit_cast(s16x4, __builtin_amdgcn_ds_read_tr16_b64_v4i16((LAS v4i16_t*)p)); }
__device__ __forceinline__ bf16x8 cat8(s16x4 lo, s16x4 hi) { return __builtin_shufflevector(lo, hi, 0, 1, 2, 3, 4, 5, 6, 7); }

struct Params {
    const float* in[26];
    float* out; unsigned char* ws; float* yout;
    int stop_after;
    int pad;
};
enum { I_XP = 0, I_XS, I_SG, I_SR, I_CK, I_CV, I_MEM, I_WIN, I_WA2, I_BA, I_GGLA, I_GRET, I_WMO, I_WXQ, I_WXK, I_WXV, I_WXO, I_GMEM, I_WUP, I_WDN, I_GPM, I_GQM, I_GPX, I_GQX, I_GPF, I_GQF };

__device__ __forceinline__ void transpose_item(const float* W, int ldw, int col_off, int N, bf16* WT, int ldt, int row_off, int kcol_off, LAS float* scr, int item, int lane) {
    const int nblk = N / 32, kb = item / nblk, nb = item % nblk, k0 = 64 * kb, n0 = 32 * nb;
#pragma unroll 8
    for (int i = 0; i < 32; ++i) { const int kk = 2 * i + (lane >> 5); scr[kk * 33 + (lane & 31)] = W[(size_t)(k0 + kk) * ldw + col_off + n0 + (lane & 31)]; }
    asm volatile("s_waitcnt lgkmcnt(0)" ::: "memory");
    const int c = lane & 7;
#pragma unroll
    for (int j = 0; j < 4; ++j) { const int n = (lane >> 3) + 8 * j; const LAS float* s = scr + (8 * c) * 33 + n;
        u32x4 o; o.x = pk2(s[0 * 33], s[1 * 33]); o.y = pk2(s[2 * 33], s[3 * 33]); o.z = pk2(s[4 * 33], s[5 * 33]); o.w = pk2(s[6 * 33], s[7 * 33]);
        *(u32x4*)(WT + (size_t)(row_off + n0 + n) * ldt + kcol_off + k0 + 8 * c) = o; }
    asm volatile("s_waitcnt lgkmcnt(0)" ::: "memory");
}

template <bool GA>
__device__ __forceinline__ void rms_row_bf16(const float* xrow, const float* g, bf16* orow, const LAS float* wga, float* garow, int lane) {
    f32x4 v[4]; float s = 0.f;
#pragma unroll
    for (int j = 0; j < 4; ++j) { v[j] = ((const f32x4*)xrow)[lane + 64 * j]; s += (v[j].x * v[j].x + v[j].y * v[j].y) + (v[j].z * v[j].z + v[j].w * v[j].w); }
    const float rs = 1.0f / sqrtf(wave_sum(s) * (1.f / D) + EPS);
#pragma unroll
    for (int j = 0; j < 4; ++j) { const f32x4 gg = ((const f32x4*)g)[lane + 64 * j]; v[j] = v[j] * rs * gg; }
#pragma unroll
    for (int j = 0; j < 4; ++j) { u32x2 w; w.x = pk2(v[j].x, v[j].y); w.y = pk2(v[j].z, v[j].w); ((u32x2*)orow)[lane + 64 * j] = w; }
    if (GA) {
        float mine = 0.f;
#pragma unroll
        for (int r = 0; r < 16; ++r) {
            float a = 0.f;
#pragma unroll
            for (int j = 0; j < 4; ++j) { const f32x4 w = ((const LAS f32x4*)(wga + r * 1024))[lane + 64 * j]; a += (v[j].x * w.x + v[j].y * w.y) + (v[j].z * w.z + v[j].w * w.w); }
            a = wave_sum(a);
            if (lane == r) mine = a;
        }
        if (lane < 16) garow[lane] = mine;
    }
}

__device__ __forceinline__ void phase0(const Params& P, LAS unsigned char* lds, int vcu, int G) {
    int tid = threadIdx.x; asm volatile("" : "+v"(tid));
    const int lane = tid & 63, wave = __builtin_amdgcn_readfirstlane(tid >> 6);
    unsigned char* ws = P.ws;
    LAS float* wga = (LAS float*)lds;
    LAS float* scr = (LAS float*)(lds + 65536 + wave * 8704);
    { const float* W = P.in[I_WIN];
      for (int k = tid; k < 1024; k += NTHR) {
#pragma unroll
          for (int q = 0; q < 4; ++q) { const f32x4 w = *(const f32x4*)(W + (size_t)k * NIN + 3072 + 4 * q); wga[(4 * q + 0) * 1024 + k] = w.x; wga[(4 * q + 1) * 1024 + k] = w.y; wga[(4 * q + 2) * 1024 + k] = w.z; wga[(4 * q + 3) * 1024 + k] = w.w; } } }
    const int gw = vcu * NWAVES + wave, NGW = G * NWAVES;
    constexpr int I_IN = (D / 64) * (NZ / 32), I_SQ = (D / 64) * (D / 32), I_UP = (D / 64) * (FF / 32), I_DN = (FF / 64) * (D / 32);
    constexpr int NITEMS = I_IN + 5 * I_SQ + I_UP + I_DN;
    for (int it = gw; it < NITEMS; it += NGW) {
        int r = it;
        if (r < I_IN) { const int nb = r % (NZ / 32); const int coff = (nb * 32 >= 3072) ? 16 : 0;
            transpose_item(P.in[I_WIN], NIN, coff, NZ, (bf16*)(ws + WS_WIN), D, 0, 0, scr, r, lane); continue; } r -= I_IN;
        if (r < I_SQ) { transpose_item(P.in[I_WMO], D, 0, D, (bf16*)(ws + WS_WMO), 2 * D, 0, 0, scr, r, lane); transpose_item(P.in[I_WMO], D, 0, D, (bf16*)(ws + WS_WMO), 2 * D, 0, D, scr, r, lane); continue; } r -= I_SQ;
        if (r < I_SQ) { transpose_item(P.in[I_WXQ], D, 0, D, (bf16*)(ws + WS_WXQ), D, 0, 0, scr, r, lane); continue; } r -= I_SQ;
        if (r < I_SQ) { transpose_item(P.in[I_WXK], D, 0, D, (bf16*)(ws + WS_WXKV), D, 0, 0, scr, r, lane); continue; } r -= I_SQ;
        if (r < I_SQ) { transpose_item(P.in[I_WXV], D, 0, D, (bf16*)(ws + WS_WXKV), D, D, 0, scr, r, lane); continue; } r -= I_SQ;
        if (r < I_SQ) { transpose_item(P.in[I_WXO], D, 0, D, (bf16*)(ws + WS_WXO), D, 0, 0, scr, r, lane); continue; } r -= I_SQ;
        if (r < I_UP) { transpose_item(P.in[I_WUP], FF, 0, FF, (bf16*)(ws + WS_WUP), D, 0, 0, scr, r, lane); continue; } r -= I_UP;
        transpose_item(P.in[I_WDN], D, 0, D, (bf16*)(ws + WS_WDN), FF, 0, 0, scr, r, lane);
    }
    { float* tab = (float*)(ws + WS_ROPE);
      for (int e = (vcu * NTHR + tid); e < 2056 * 64; e += G * NTHR) { const int p = e >> 6, i = e & 63; const int pos = p < 2048 ? p : 16384 + (p - 2048);
          const float inv = (float)pow(10000.0, -(double)i / 64.0); const float ang = (float)pos * inv;
          tab[2 * e] = (float)cos((double)ang); tab[2 * e + 1] = (float)sin((double)ang); } }
    __syncthreads();
    for (int m = gw; m < NT + NMEM; m += NGW) {
        if (m < NT) { const float* xr = m < NP ? P.in[I_XP] + (size_t)m * D : P.in[I_XS] + (size_t)(m - NP) * D;
            rms_row_bf16<true>(xr, P.in[I_GPM], (bf16*)(ws + WS_H) + (size_t)m * D, wga, (float*)(ws + WS_GAL) + (size_t)m * 16, lane); }
        else { const int r = m - NT; rms_row_bf16<false>(P.in[I_MEM] + (size_t)r * D, P.in[I_GMEM], (bf16*)(ws + WS_MB) + (size_t)r * D, wga, nullptr, lane); }
    }
}

__device__ __forceinline__ void row_phase(const float* xop, const float* xos, const float* t, const float* g1, float* xnew, const float* g2, bf16* hn, int vcu, int G) {
    int tid = threadIdx.x; asm volatile("" : "+v"(tid));
    const int lane = tid & 63, wave = __builtin_amdgcn_readfirstlane(tid >> 6);
    const int gw = vcu * NWAVES + wave, NGW = G * NWAVES;
    for (int m = gw; m < NT; m += NGW) {
        const float* xo = (xos && m >= NP) ? xos + (size_t)(m - NP) * D : xop + (size_t)m * D;
        f32x4 tv[4], xv[4]; float s = 0.f;
#pragma unroll
        for (int j = 0; j < 4; ++j) { tv[j] = ((const f32x4*)(t + (size_t)m * D))[lane + 64 * j]; xv[j] = ((const f32x4*)xo)[lane + 64 * j]; s += (tv[j].x * tv[j].x + tv[j].y * tv[j].y) + (tv[j].z * tv[j].z + tv[j].w * tv[j].w); }
        const float rs = 1.0f / sqrtf(wave_sum(s) * (1.f / D) + EPS);
        float s2 = 0.f;
#pragma unroll
        for (int j = 0; j < 4; ++j) { const f32x4 gg = ((const f32x4*)g1)[lane + 64 * j]; xv[j] = xv[j] + tv[j] * rs * gg; ((f32x4*)(xnew + (size_t)m * D))[lane + 64 * j] = xv[j];
            s2 += (xv[j].x * xv[j].x + xv[j].y * xv[j].y) + (xv[j].z * xv[j].z + xv[j].w * xv[j].w); }
        if (hn) {
            const float rs2 = 1.0f / sqrtf(wave_sum(s2) * (1.f / D) + EPS);
#pragma unroll
            for (int j = 0; j < 4; ++j) { const f32x4 gg = ((const f32x4*)g2)[lane + 64 * j]; const f32x4 o = xv[j] * rs2 * gg; u32x2 w; w.x = pk2(o.x, o.y); w.y = pk2(o.z, o.w); ((u32x2*)(hn + (size_t)m * D))[lane + 64 * j] = w; }
        }
    }
}


#define XB_TMO      128
#define XB_XCNT(j)  (256  + 64 * (j))
#define XB_XSUB(j)  (1280 + 64 * (j))
#define XB_XGEN(j)  (2304 + 64 * (j))
#define XB_TOP      3328
#define XB_TOPGEN   3392
#define XCD_BAR_WORDS 3456
#define XB_SPIN_CAP (1u << 22)
__device__ __forceinline__ unsigned xb_ld(unsigned* p)              { return __hip_atomic_load(p, __ATOMIC_RELAXED, __HIP_MEMORY_SCOPE_AGENT); }
__device__ __forceinline__ unsigned xb_add(unsigned* p, unsigned v) { return __hip_atomic_fetch_add(p, v, __ATOMIC_RELAXED, __HIP_MEMORY_SCOPE_AGENT); }
__device__ __forceinline__ unsigned xb_xcc_id() { return (unsigned)__builtin_amdgcn_s_getreg((3 << 11) | 20) & 0xFu; }
#define XB_SPIN(cond, bar) do { unsigned _sp = 0; while (cond) { __builtin_amdgcn_s_sleep(1); \
    if ((++_sp & 255u) == 0u) { if (xb_ld(&(bar)[XB_TMO])) break; if (_sp > XB_SPIN_CAP) { atomicAdd(&(bar)[XB_TMO], 1u); break; } } } } while (0)
struct XcdBarrier { unsigned* bar; unsigned x; volatile LAS unsigned* st; };
__device__ __forceinline__ XcdBarrier xcd_barrier_post(unsigned* bar, volatile LAS unsigned* st) {
    XcdBarrier b; b.bar = bar; b.x = xb_xcc_id(); b.st = st;
    if (threadIdx.x == 0) (void)xb_add(&bar[XB_XCNT(b.x)], 1u);
    return b;
}
__device__ __forceinline__ void xcd_barrier_complete(unsigned* bar, unsigned x, unsigned& nloc, unsigned& nx) {
    const unsigned G = gridDim.x * gridDim.y * gridDim.z;
    unsigned sum, cnt, mine, sp = 0u;
    for (;;) {
        sum = 0u; cnt = 0u; mine = 0u;
#pragma unroll
        for (unsigned j = 0; j < 16; ++j) { const unsigned c = xb_ld(&bar[XB_XCNT(j)]); sum += c; cnt += (c > 0u) ? 1u : 0u; mine = (j == x) ? c : mine; }
        if (sum == G) break;
        __builtin_amdgcn_s_sleep(1);
        if ((++sp & 255u) == 0u) { if (xb_ld(&bar[XB_TMO])) break; if (sp > XB_SPIN_CAP) { atomicAdd(&bar[XB_TMO], 1u); break; } }
    }
    nloc = mine > 0u ? mine : 1u; nx = cnt > 0u ? cnt : 1u;
}
__device__ __forceinline__ void xcd_barrier(const XcdBarrier& b) {
    asm volatile("s_waitcnt vmcnt(0)" ::: "memory");
    __syncthreads();
    if (threadIdx.x == 0) {
        unsigned* bar = b.bar;
        __builtin_amdgcn_s_waitcnt(0);
        unsigned nloc = b.st[0], nx = b.st[1];
        if (nloc == 0u) { xcd_barrier_complete(bar, b.x, nloc, nx); b.st[0] = nloc; b.st[1] = nx; }
        const unsigned old = xb_add(&bar[XB_XSUB(b.x)], 1u);
        const unsigned gen = old / nloc;
        if (old + 1u == (gen + 1u) * nloc) {
            __builtin_amdgcn_fence(__ATOMIC_RELEASE, "agent");
            asm volatile("s_waitcnt vmcnt(0)" ::: "memory");
            const unsigned og = xb_add(&bar[XB_TOP], 1u);
            const unsigned tg = og / nx;
            if (og + 1u == (tg + 1u) * nx) xb_add(&bar[XB_TOPGEN], 1u);
            else XB_SPIN(xb_ld(&bar[XB_TOPGEN]) == tg, bar);
            __builtin_amdgcn_fence(__ATOMIC_ACQUIRE, "agent");
            xb_add(&bar[XB_XGEN(b.x)], 1u);
            asm volatile("s_waitcnt vmcnt(0)" ::: "memory");
        } else {
            XB_SPIN(xb_ld(&bar[XB_XGEN(b.x)]) == gen, bar);
            __builtin_amdgcn_fence(__ATOMIC_ACQUIRE, "agent");
            asm volatile("s_waitcnt vmcnt(0)" ::: "memory");
        }
    }
    __syncthreads();
}

constexpr int SG_STR = 68, SG_SLAB = 64 * SG_STR * 4;
static_assert(8 * SG_SLAB <= LDS_BYTES - 64, "small-gemm LDS");
struct SEpiF32 { float* O; int ldc;
    __device__ __forceinline__ void operator()(int row, int col, const float (&v)[8]) const { float* p = O + (size_t)row * ldc + col; *(f32x4*)p = (f32x4){v[0], v[1], v[2], v[3]}; *(f32x4*)(p + 4) = (f32x4){v[4], v[5], v[6], v[7]}; } };
struct SEpiBf16 { bf16* O; int ldc;
    __device__ __forceinline__ void operator()(int row, int col, const float (&v)[8]) const { u32x4 o; o.x = pk2(v[0], v[1]); o.y = pk2(v[2], v[3]); o.z = pk2(v[4], v[5]); o.w = pk2(v[6], v[7]); *(u32x4*)(O + (size_t)row * ldc + col) = o; } };
template <class SEpi>
__device__ __forceinline__ void small_gemm(LAS unsigned char* lds, const bf16* A, const bf16* Bt, int K, int N, int vcu, int G, const SEpi& E) {
    int tid = threadIdx.x; asm volatile("" : "+v"(tid));
    const int lane = tid & 63, w = __builtin_amdgcn_readfirstlane(tid >> 6), r32 = lane & 31, hh = lane >> 5;
    const int nun = 16 * (N / 64), kw = K / 8;
    for (int u = vcu; u < nun; u += G) {
        const int tm = u & 15, tn = u >> 4;
        f32x16 acc[2][2];
#pragma unroll
        for (int i = 0; i < 2; ++i)
#pragma unroll
            for (int j = 0; j < 2; ++j)
#pragma unroll
                for (int rg = 0; rg < 16; ++rg) acc[i][j][rg] = 0.f;
        const bf16* Ap = A + (size_t)(tm * 64 + r32) * K + w * kw + 8 * hh;
        const bf16* Bp = Bt + (size_t)(tn * 64 + r32) * K + w * kw + 8 * hh;
        const size_t r32k = (size_t)32 * K;
#pragma unroll 4
        for (int ks = 0; ks < kw / 16; ++ks) {
            const bf16x8 a0 = *(const bf16x8*)(Ap + ks * 16), a1 = *(const bf16x8*)(Ap + r32k + ks * 16);
            const bf16x8 b0 = *(const bf16x8*)(Bp + ks * 16), b1 = *(const bf16x8*)(Bp + r32k + ks * 16);
            acc[0][0] = MFMA32(a0, b0, acc[0][0]); acc[0][1] = MFMA32(a0, b1, acc[0][1]); acc[1][0] = MFMA32(a1, b0, acc[1][0]); acc[1][1] = MFMA32(a1, b1, acc[1][1]);
        }
        LAS float* slab = (LAS float*)(lds + w * SG_SLAB);
#pragma unroll
        for (int i = 0; i < 2; ++i)
#pragma unroll
            for (int j = 0; j < 2; ++j)
#pragma unroll
                for (int rg = 0; rg < 16; ++rg) slab[(32 * i + crow(rg, hh)) * SG_STR + 32 * j + r32] = acc[i][j][rg];
        __syncthreads();
        { const int row = tid >> 3, c8 = (tid & 7) * 8;
          f32x4 s0 = (f32x4){0.f, 0.f, 0.f, 0.f}, s1 = s0;
#pragma unroll
          for (int q = 0; q < 8; ++q) { const LAS float* p = (const LAS float*)(lds + q * SG_SLAB) + row * SG_STR + c8; s0 += *(const LAS f32x4*)p; s1 += *(const LAS f32x4*)(p + 4); }
          const float v[8] = {s0.x, s0.y, s0.z, s0.w, s1.x, s1.y, s1.z, s1.w};
          E(tm * 64 + row, tn * 64 + c8, v); }
        __syncthreads();
    }
}

constexpr int L_QT = 0, L_KT = 17408, L_KHT = 34816, L_EBL = 53248, L_IMG = 53760;
constexpr int QT_STR = 272, KHT_STR = 144, P_STR = 144, V_STR = 576;
constexpr int LA_RQ = 53760, LA_RK = 70144, LA_GAL = 86528, LA_PRE = 90624, LA_END = 92672;
constexpr int LB_P = 53760, LB_V = 62976, LB_END = 99840;
constexpr int REC_BYTES = L_IMG, REC_CHUNKS = REC_BYTES / 16  , SREC_BYTES = 6912, SREC_CHUNKS = 432;
constexpr size_t WS_REC = WS_T, WS_SREC = WS_H;
static_assert(WS_REC + (size_t)2048 * REC_BYTES <= WS_END && (size_t)1024 * SREC_BYTES <= 34 * MiB, "record space");
__device__ __forceinline__ int dperm(int d) { return (d & ~12) | ((d & 4) << 1) | ((d & 8) >> 1); }
#define LAUNDER(x) asm volatile("" : "+v"(x))
__device__ __forceinline__ u32x4 mask4(u32x4 v, int t, int Tv) { const unsigned m = (unsigned)((t - Tv) >> 31); return (u32x4){v.x & m, v.y & m, v.z & m, v.w & m}; }

template <int BR>
__device__ __forceinline__ void prep_unit(const Params& P, LAS unsigned char* lds, int h, int rowc, int Tv, int pidx, unsigned char* rec, bool compact) {
    const int tid0 = threadIdx.x;
    const bf16* Z = (const bf16*)(P.ws + WS_Z);
    const float* GAL = (const float*)(P.ws + WS_GAL);
    const float* ROPE = (const float*)(P.ws + WS_ROPE);
    const int cq = (BR == 0 ? ZC_GQ : ZC_RQ) + h * 128, ck = (BR == 0 ? ZC_GK : ZC_RK) + h * 128;
    const float scale = 0.08838834764831845f;
    const float lg = BR == 1 ? log1pf(-exp2f(-5.0f - (float)h)) : 0.f;
    { int tid = tid0; LAUNDER(tid);
#pragma unroll
      for (int i = 0; i < 2; ++i) { const int ch = tid + 512 * i, t = ch >> 4, c8 = ch & 15; const int tt = t < Tv ? t : 0;
          const u32x4 q = mask4(*(const u32x4*)(Z + (size_t)(rowc + tt) * NZ + cq + c8 * 8), t, Tv);
          const u32x4 k = mask4(*(const u32x4*)(Z + (size_t)(rowc + tt) * NZ + ck + c8 * 8), t, Tv);
          *(LAS u32x4*)(lds + LA_RQ + t * 256 + c8 * 16) = q; *(LAS u32x4*)(lds + LA_RK + t * 256 + c8 * 16) = k; }
      if (BR == 0) { const int t = (tid >> 2) & 63, c4 = tid & 3; const int tt = t < Tv ? t : 0;
          const u32x4 g = mask4(*(const u32x4*)(GAL + (size_t)(rowc + tt) * 16 + c4 * 4), t, Tv);
          if (tid < 256) *(LAS u32x4*)(lds + LA_GAL + tid * 16) = g; } }
    __syncthreads();
    {
        int tid = tid0; LAUNDER(tid); const int pd = tid & 127, ptq = tid >> 7;
        const int pp = dperm(pd);
        const bool work = (16 * ptq) < Tv;
        unsigned kh[8];
#pragma unroll
        for (int i = 0; i < 8; ++i) kh[i] = 0u;
        if (BR == 0) {
            float la[16];
#pragma unroll
            for (int i = 0; i < 16; ++i) la[i] = 0.f;
            if (work) {
                float w2r[16];
#pragma unroll
                for (int r = 0; r < 16; ++r) w2r[r] = P.in[I_WA2][r * 512 + h * 128 + pd];
                const float bias = P.in[I_BA][h * 128 + pd];
#pragma unroll
                for (int i = 0; i < 16; ++i) { const int t = 16 * ptq + i;
                    float x = bias;
#pragma unroll
                    for (int q4 = 0; q4 < 4; ++q4) { const f32x4 g = *(const LAS f32x4*)(lds + LA_GAL + t * 64 + q4 * 16); x += g.x * w2r[4 * q4] + g.y * w2r[4 * q4 + 1] + g.z * w2r[4 * q4 + 2] + g.w * w2r[4 * q4 + 3]; }
                    const float ls = fminf(x, 0.f) - __logf(1.0f + __expf(-fabsf(x)));
                    la[i] = t < Tv ? ls * (1.0f / 16.0f) : 0.f; }
#pragma unroll
                for (int i = 1; i < 16; ++i) la[i] += la[i - 1];
            }
            ((LAS float*)(lds + LA_PRE))[ptq * 128 + pd] = la[15];
            __syncthreads();
            float base = 0.f, btot = 0.f;
#pragma unroll
            for (int q = 0; q < 4; ++q) { const float v = ((const LAS float*)(lds + LA_PRE))[q * 128 + pd]; btot += v; if (q < ptq) base += v; }
            if (ptq == 0) ((LAS float*)(lds + L_EBL))[pd] = __expf(btot);
            if (work) {
#pragma unroll
                for (int i = 0; i < 16; ++i) { const int t = 16 * ptq + i; const float bt = base + la[i];
                    const float qv = bf2f(*(const LAS unsigned short*)(lds + LA_RQ + t * 256 + pd * 2)), kv = bf2f(*(const LAS unsigned short*)(lds + LA_RK + t * 256 + pd * 2));
                    *(LAS unsigned short*)(lds + L_QT + t * QT_STR + pp * 2) = f2bf(qv * (__expf(bt) * scale));
                    *(LAS unsigned short*)(lds + L_KT + t * QT_STR + pp * 2) = f2bf(kv * __expf(-bt));
                    const float k3 = kv * __expf(btot - bt);
                    if (i & 1) kh[i >> 1] = (kh[i >> 1] & 0xffffu) | ((unsigned)f2bf(k3) << 16); else kh[i >> 1] = (unsigned)f2bf(k3); }
            }
        } else {
            const float btot = (float)Tv * lg;
            if (ptq == 0) ((LAS float*)(lds + L_EBL))[pd] = __expf(btot);
            if (work) {
                const int fi = pd & 63; const float sgn = pd < 64 ? -1.f : 1.f;
#pragma unroll
                for (int i = 0; i < 16; ++i) { const int t = 16 * ptq + i;
                    const float bt = (float)(t < Tv ? t + 1 : Tv) * lg;
                    const int pi = pidx + (t < Tv ? t : 0);
                    const float cs = ROPE[(size_t)(pi * 64 + fi) * 2], sn = ROPE[(size_t)(pi * 64 + fi) * 2 + 1];
                    const float q1 = bf2f(*(const LAS unsigned short*)(lds + LA_RQ + t * 256 + pd * 2)), q2 = bf2f(*(const LAS unsigned short*)(lds + LA_RQ + t * 256 + (pd ^ 64) * 2));
                    const float k1 = bf2f(*(const LAS unsigned short*)(lds + LA_RK + t * 256 + pd * 2)), k2 = bf2f(*(const LAS unsigned short*)(lds + LA_RK + t * 256 + (pd ^ 64) * 2));
                    const float qv = q1 * cs + sgn * q2 * sn, kv = k1 * cs + sgn * k2 * sn;
                    *(LAS unsigned short*)(lds + L_QT + t * QT_STR + pp * 2) = f2bf(qv * __expf(bt));
                    *(LAS unsigned short*)(lds + L_KT + t * QT_STR + pp * 2) = f2bf(kv * (__expf(-bt) * scale));
                    const float k3 = kv * (__expf(btot - bt) * scale);
                    if (i & 1) kh[i >> 1] = (kh[i >> 1] & 0xffffu) | ((unsigned)f2bf(k3) << 16); else kh[i >> 1] = (unsigned)f2bf(k3); }
            }
        }
        if (work) {
            *(LAS u32x4*)(lds + L_KHT + pd * KHT_STR + ptq * 32) = (u32x4){kh[0], kh[1], kh[2], kh[3]};
            *(LAS u32x4*)(lds + L_KHT + pd * KHT_STR + ptq * 32 + 16) = (u32x4){kh[4], kh[5], kh[6], kh[7]};
        }
    }
    __syncthreads();
    { int tid = tid0; LAUNDER(tid);
      if (!compact) {
#pragma unroll
          for (int i = 0; i < 7; ++i) { const int ch = tid + 512 * i; if (ch < REC_CHUNKS) *(u32x4*)(rec + (size_t)ch * 16) = *(const LAS u32x4*)(lds + ch * 16); }
      } else if (tid < SREC_CHUNKS) {
          int src;
          if (tid < 136) src = L_QT + tid * 16; else if (tid < 272) src = L_KT + (tid - 136) * 16; else if (tid < 400) src = L_KHT + (tid - 272) * KHT_STR; else src = L_EBL + (tid - 400) * 16;
          *(u32x4*)(rec + (size_t)tid * 16) = *(const LAS u32x4*)(lds + src);
      } }
}
__device__ __forceinline__ void phase2a(const Params& P, LAS unsigned char* lds, int vcu, int G) {
    for (int u = vcu; u < 2048 + 1024; u += G) {
        const bool prompt = u < 2048;
        const int v = prompt ? u : u - 2048;
        const int c = prompt ? (v & 31) : 0, br = prompt ? ((v >> 5) & 1) : (v & 1), h = prompt ? ((v >> 6) & 3) : ((v >> 1) & 3), b = prompt ? (v >> 8) : (v >> 3);
        const int rowc = prompt ? b * 2048 + c * 64 : NP + b * 8, Tv = prompt ? 64 : 8, pidx = prompt ? c * 64 : 2048;
        unsigned char* rec = prompt ? P.ws + WS_REC + (size_t)v * REC_BYTES : P.ws + WS_SREC + (size_t)v * SREC_BYTES;
        if (br == 0) prep_unit<0>(P, lds, h, rowc, Tv, pidx, rec, !prompt); else prep_unit<1>(P, lds, h, rowc, Tv, pidx, rec, !prompt);
        __syncthreads();
    }
}

constexpr int LC_P = 53760, LC_V = 62976, VQ_STR = 192, LC_RED = 75264, LC_END = LC_RED + 65536;
static_assert(LC_END <= MISC_OFF, "P2b LDS map");
__device__ __forceinline__ void chain_run(const Params& P, LAS unsigned char* lds, int vcu, int G, bool sample) {
    const int tid0 = threadIdx.x, w = __builtin_amdgcn_readfirstlane(tid0 >> 6), nt = w & 1, T = w >> 1;
    const bf16* Z = (const bf16*)(P.ws + WS_Z);
    bf16* MG = (bf16*)(P.ws + WS_MG);
    const int Tv = sample ? 8 : 64;
    const int nsteps = sample ? (4096 - vcu + G - 1) / G : (vcu < 256 ? 32 : 0);
    const int nchunks = sample ? SREC_CHUNKS : REC_CHUNKS;
    const bool probe = (P.pad & 0x700) != 0;
#define STEP_UNIT(stp_, br_, b_, h_, qd_, rowc_, rec_) \
    const int uu_##stp_ = sample ? vcu + (stp_) * G : vcu; \
    const int qd_ = uu_##stp_ & 3, ch_##stp_ = uu_##stp_ >> 2, br_ = ch_##stp_ & 1, h_ = (ch_##stp_ >> 1) & 3, b_ = ch_##stp_ >> 3; \
    const int rowc_ = sample ? NP + b_ * 8 : b_ * 2048 + (stp_) * 64; \
    const unsigned char* rec_ = sample ? P.ws + WS_SREC + (size_t)ch_##stp_ * SREC_BYTES : P.ws + WS_REC + (size_t)(ch_##stp_ * 32 + ((P.pad & 0x100) ? 0 : (stp_))) * REC_BYTES;
    f32x16 S, Sn;
#pragma unroll
    for (int rg = 0; rg < 16; ++rg) { S[rg] = 0.f; Sn[rg] = 0.f; }
    u32x4 pr[7], pv;
    u32x2 ost[2];
    ost[0] = (u32x2){0u, 0u}; ost[1] = (u32x2){0u, 0u};
#define P2B_PREFETCH(stp_) do { STEP_UNIT(stp_, brp_, bp_, hp_, qdp_, rowp_, recp_) \
    int tid = tid0; LAUNDER(tid); \
    _Pragma("unroll") for (int i = 0; i < 7; ++i) { const int ch = tid + 512 * i; const int cl = ch < nchunks ? ch : nchunks - 1; pr[i] = *(const u32x4*)(recp_ + (size_t)cl * 16); } \
    { const int t = tid >> 3, c8 = tid & 7; const int tt = t < Tv ? t : 0; \
      pv = *(const u32x4*)(Z + (size_t)(rowp_ + tt) * NZ + (brp_ == 0 ? ZC_GV : ZC_RV) + hp_ * 256 + 64 * qdp_ + c8 * 8); } \
    if (sample) { const float* s0_ = (brp_ == 0 ? P.in[I_SG] : P.in[I_SR]); const int r32_ = tid & 31, hh_ = (tid >> 5) & 1; \
        _Pragma("unroll") for (int rg = 0; rg < 16; ++rg) Sn[rg] = s0_[((size_t)(bp_ * 4 + hp_) * 128 + 32 * T + crow(rg, hh_)) * 256 + 64 * qdp_ + 32 * nt + r32_]; } } while (0)
#define P2B_STORE_O(stp_) do { STEP_UNIT(stp_, brs_, bs_, hs_, qds_, rows_, recs_) (void)recs_; \
    int ln_ = tid0 & 63; LAUNDER(ln_); const int r32_ = ln_ & 31, hh_ = ln_ >> 5; const int t = 32 * (T >> 1) + r32_; \
    if (t < Tv) { bf16* orow = MG + (size_t)(rows_ + t) * 2048 + brs_ * 1024 + hs_ * 256 + 64 * qds_ + 32 * nt + 16 * (T & 1) + 4 * hh_; \
        *(u32x2*)(orow) = ost[0]; *(u32x2*)(orow + 8) = ost[1]; } } while (0)
    if (nsteps > 0) P2B_PREFETCH(0);
    for (int c = 0; c < nsteps; ++c) {
        STEP_UNIT(c, br, b, h, qd, rowc, rec) (void)rec; (void)rowc;
        if (sample) {
#pragma unroll
            for (int rg = 0; rg < 16; ++rg) S[rg] = Sn[rg]; }
        { int tid = tid0; LAUNDER(tid);
          if (!sample) {
#pragma unroll
              for (int i = 0; i < 7; ++i) { const int ch = tid + 512 * i; *(LAS u32x4*)(lds + ch * 16) = pr[i]; }
          } else if (tid < SREC_CHUNKS) {
              int dst;
              if (tid < 136) dst = L_QT + tid * 16; else if (tid < 272) dst = L_KT + (tid - 136) * 16; else if (tid < 400) dst = L_KHT + (tid - 272) * KHT_STR; else dst = L_EBL + (tid - 400) * 16;
              *(LAS u32x4*)(lds + dst) = pr[0];
          }
          { const int t = tid >> 3, c8 = tid & 7; *(LAS u32x4*)(lds + LC_V + t * VQ_STR + c8 * 16) = mask4(pv, t, Tv); } }
        asm volatile("" ::: "memory");
        { const int cn = c + 1 < nsteps ? c + 1 : c; P2B_PREFETCH(cn); }
        if (c > 0) { const int cp = c - 1; P2B_STORE_O(cp); }
        __syncthreads();
        int lane = tid0 & 63; LAUNDER(lane); const int r32 = lane & 31, hh = lane >> 5;
        {
            const int fr = lane & 15, fq = lane >> 4, tb = w >> 1;
#pragma unroll
            for (int j = 0; j < 2; ++j) { const int sb = 2 * (w & 1) + j;
                pg8::f32x4 acc = (pg8::f32x4){0.f, 0.f, 0.f, 0.f};
                if (sb <= tb) {
#pragma unroll
                    for (int ks = 0; ks < 4; ++ks) {
                        const bf16x8 kf = *(const LAS bf16x8*)(lds + L_KT + (16 * sb + fr) * QT_STR + (32 * ks + 8 * fq) * 2);
                        const bf16x8 qf = *(const LAS bf16x8*)(lds + L_QT + (16 * tb + fr) * QT_STR + (32 * ks + 8 * fq) * 2);
                        acc = __builtin_amdgcn_mfma_f32_16x16x32_bf16(kf, qf, acc, 0, 0, 0);
                    }
                }
                const int tg = 16 * tb + fr;
                float v[4];
#pragma unroll
                for (int e = 0; e < 4; ++e) { const int sg = 16 * sb + 4 * fq + e; v[e] = sg <= tg ? acc[e] : 0.f; }
                u32x2 o; o.x = pk2(v[0], v[1]); o.y = pk2(v[2], v[3]);
                *(LAS u32x2*)(lds + LC_P + tg * P_STR + (16 * sb + 4 * fq) * 2) = o;
            }
        }
        bf16x8 vf[4], qf[2][2], kf[4]; f32x4 eb[4];
        { const int g16 = (lane >> 4) & 1, i16 = lane & 15, q_ = i16 >> 2, p_ = i16 & 3;
          const LAS unsigned char* vb = lds + LC_V + (8 * hh + q_) * VQ_STR + (32 * nt + 16 * g16 + 4 * p_) * 2;
#pragma unroll
          for (int ks = 0; ks < 4; ++ks) vf[ks] = cat8(vtr(vb + (16 * ks) * VQ_STR), vtr(vb + (16 * ks + 4) * VQ_STR)); }
#pragma unroll
        for (int s = 0; s < 2; ++s)
#pragma unroll
            for (int mi = 0; mi < 2; ++mi) qf[s][mi] = *(const LAS bf16x8*)(lds + L_QT + (32 * mi + r32) * QT_STR + (32 * T + 16 * s + 8 * hh) * 2);
#pragma unroll
        for (int ks = 0; ks < 4; ++ks) kf[ks] = *(const LAS bf16x8*)(lds + L_KHT + (32 * T + r32) * KHT_STR + (16 * ks + 8 * hh) * 2);
#pragma unroll
        for (int g = 0; g < 4; ++g) eb[g] = *(const LAS f32x4*)(lds + L_EBL + (32 * T + 8 * g + 4 * hh) * 4);
        f32x16 OT[2];
#pragma unroll
        for (int mi = 0; mi < 2; ++mi) {
#pragma unroll
            for (int rg = 0; rg < 16; ++rg) OT[mi][rg] = 0.f; }
#pragma unroll
        for (int s = 0; s < 2; ++s) { const bf16x8 sa = pack8(S, s);
#pragma unroll
            for (int mi = 0; mi < 2; ++mi) OT[mi] = MFMA32(sa, qf[s][mi], OT[mi]); }
#pragma unroll
        for (int g = 0; g < 4; ++g) { S[4 * g] *= eb[g].x; S[4 * g + 1] *= eb[g].y; S[4 * g + 2] *= eb[g].z; S[4 * g + 3] *= eb[g].w; }
#pragma unroll
        for (int ks = 0; ks < 4; ++ks) S = MFMA32(kf[ks], vf[ks], S);
        __syncthreads();
        { const bf16x8 vT = T == 0 ? vf[0] : T == 1 ? vf[1] : T == 2 ? vf[2] : vf[3];
          const bf16x8 pf1 = *(const LAS bf16x8*)(lds + LC_P + (32 + r32) * P_STR + (16 * T + 8 * hh) * 2);
          OT[1] = MFMA32(vT, pf1, OT[1]);
          if (T < 2) { const bf16x8 pf0 = *(const LAS bf16x8*)(lds + LC_P + r32 * P_STR + (16 * T + 8 * hh) * 2); OT[0] = MFMA32(vT, pf0, OT[0]); } }
#pragma unroll
        for (int mi = 0; mi < 2; ++mi)
#pragma unroll
            for (int g = 0; g < 4; ++g) *(LAS f32x4*)(lds + LC_RED + ((((nt * 4 + T) * 2 + mi) * 4 + g) * 64 + lane) * 16) = (f32x4){OT[mi][4 * g], OT[mi][4 * g + 1], OT[mi][4 * g + 2], OT[mi][4 * g + 3]};
        __syncthreads();
        { const int mir = T >> 1, g0 = 2 * (T & 1);
#pragma unroll
          for (int gg = 0; gg < 2; ++gg) { f32x4 a = (f32x4){0.f, 0.f, 0.f, 0.f};
#pragma unroll
              for (int Tp = 0; Tp < 4; ++Tp) a += *(const LAS f32x4*)(lds + LC_RED + ((((nt * 4 + Tp) * 2 + mir) * 4 + g0 + gg) * 64 + lane) * 16);
              ost[gg].x = pk2(a.x, a.y); ost[gg].y = pk2(a.z, a.w); } }
        if (sample) {
            float* so = (probe ? (float*)(P.ws + WS_Z) : P.out) + (br == 0 ? O_SGS : O_SRS);
#pragma unroll
            for (int rg = 0; rg < 16; ++rg) so[((size_t)(b * 4 + h) * 128 + 32 * T + crow(rg, hh)) * 256 + 64 * qd + 32 * nt + r32] = S[rg];
        }
    }
    if (nsteps > 0) {
        { const int cl = nsteps - 1; P2B_STORE_O(cl); }
        if (!sample) { STEP_UNIT(0, br, b, h, qd, rowc, rec) (void)rec; (void)rowc;
            int t0 = tid0; LAUNDER(t0); const int r32 = t0 & 31, hh = (t0 >> 5) & 1;
            float* so = (probe ? (float*)(P.ws + WS_Z) : P.out) + (br == 0 ? O_SGP : O_SRP);
#pragma unroll
            for (int rg = 0; rg < 16; ++rg) so[((size_t)(b * 4 + h) * 128 + 32 * T + crow(rg, hh)) * 256 + 64 * qd + 32 * nt + r32] = S[rg]; }
    }
#undef P2B_PREFETCH
#undef P2B_STORE_O
#undef STEP_UNIT
}
__device__ __forceinline__ void phase2b(const Params& P, LAS unsigned char* lds, int vcu, int G) {
    if (!(P.pad & 0x400)) chain_run(P, lds, vcu, G, false);
    __syncthreads();
    for (int i = threadIdx.x; i < L_IMG / 16; i += NTHR) *(LAS u32x4*)(lds + i * 16) = (u32x4){0u, 0u, 0u, 0u};
    __syncthreads();
    if (!(P.pad & 0x200)) chain_run(P, lds, vcu, G, true);
}

__device__ __forceinline__ void phase2c(const Params& P, int vcu, int G) {
    int tid = threadIdx.x; LAUNDER(tid);
    const int lane = tid & 63, wave = __builtin_amdgcn_readfirstlane(tid >> 6);
    const int gw = vcu * NWAVES + wave, NGW = G * NWAVES;
    const bf16* Z = (const bf16*)(P.ws + WS_Z); bf16* MG = (bf16*)(P.ws + WS_MG);
    for (int it = gw; it < 2 * NT; it += NGW) {
        const int row = it >> 1, br = it & 1;
        const int cg1 = (br == 0 ? ZC_GR : ZC_RG), cg2 = (br == 0 ? ZC_GA : ZC_GB);
        const float* ghead = P.in[br == 0 ? I_GGLA : I_GRET];
        bf16* mrow = MG + (size_t)row * 2048 + br * 1024 + 4 * lane;
        const bf16* zr = Z + (size_t)row * NZ + 4 * lane;
        u32x2 ov[4], g1[4], g2[4]; f32x4 gh[4];
#pragma unroll
        for (int h = 0; h < 4; ++h) { ov[h] = *(const u32x2*)(mrow + h * 256); g1[h] = *(const u32x2*)(zr + cg1 + h * 256); g2[h] = *(const u32x2*)(zr + cg2 + h * 256); gh[h] = *(const f32x4*)(ghead + h * 256 + 4 * lane); }
#pragma unroll
        for (int h = 0; h < 4; ++h) {
            float o[4] = {bflo(ov[h].x), bfhi(ov[h].x), bflo(ov[h].y), bfhi(ov[h].y)};
            float mu = 0.f;
            if (br == 1) mu = wave_sum((o[0] + o[1]) + (o[2] + o[3])) * (1.0f / 256.0f);
#pragma unroll
            for (int e = 0; e < 4; ++e) o[e] -= mu;
            const float q = wave_sum((o[0] * o[0] + o[1] * o[1]) + (o[2] * o[2] + o[3] * o[3]));
            const float rstd = __builtin_amdgcn_rsqf(q * (1.0f / 256.0f) + EPS);
            const float a[4] = {bflo(g1[h].x), bfhi(g1[h].x), bflo(g1[h].y), bfhi(g1[h].y)}, gt[4] = {bflo(g2[h].x), bfhi(g2[h].x), bflo(g2[h].y), bfhi(g2[h].y)};
            const float gg[4] = {gh[h].x, gh[h].y, gh[h].z, gh[h].w};
            float res[4];
#pragma unroll
            for (int e = 0; e < 4; ++e) res[e] = o[e] * rstd * gg[e] * a[e] * __builtin_amdgcn_rcpf((1.0f + __expf(-a[e])) * (1.0f + __expf(-gt[e])));
            u32x2 w; w.x = pk2(res[0], res[1]); w.y = pk2(res[2], res[3]);
            *(u32x2*)(mrow + h * 256) = w;
        }
    }
}

constexpr int A_K = 0, AK_STR = 272, A_V = 34816, AV_STR = 320, A_END = 34816 + 40960;
#define P6_STAGE(src_, mt_, ch_, lbase_, lstr_) do { \
    _Pragma("unroll") for (int i = 0; i < 4; ++i) { const int ch = tid + 512 * i, m = ch >> 4, c8 = ch & 15; \
        const size_t off = (((size_t)b * 256 + 128 * (mt_) + m) * 4 + h) * 256 + 128 * (ch_) + c8 * 8; \
        u32x4 v; \
        if (F32SRC) { const f32x4 a = *(const f32x4*)((const float*)(src_) + off), c = *(const f32x4*)((const float*)(src_) + off + 4); v.x = pk2(a.x, a.y); v.y = pk2(a.z, a.w); v.z = pk2(c.x, c.y); v.w = pk2(c.z, c.w); } \
        else v = *(const u32x4*)((const bf16*)(src_) + off); \
        *(LAS u32x4*)(lds + (lbase_) + m * (lstr_) + c8 * 16) = v; } } while (0)

template <bool F32SRC>
__device__ __forceinline__ void attn_unit(const Params& P, LAS unsigned char* lds, int b, int h, int row0, int nq, const void* Kp, const void* Vp) {
    int tid = threadIdx.x; asm volatile("" : "+v"(tid));
    const int lane = tid & 63, w = __builtin_amdgcn_readfirstlane(tid >> 6), r32 = lane & 31, hh = lane >> 5;
    const bf16* Q = (const bf16*)(P.ws + WS_Q); bf16* Oo = (bf16*)(P.ws + WS_O);
    const bool active = (32 * w) < nq;
    const int t = 32 * w + r32; const bool tok = t < nq;
    f32x16 sT[8];
#pragma unroll
    for (int i = 0; i < 8; ++i)
#pragma unroll
        for (int rg = 0; rg < 16; ++rg) sT[i][rg] = 0.f;
#pragma unroll
    for (int dh = 0; dh < 2; ++dh) {
        bf16x8 qf[8];
#pragma unroll
        for (int ks = 0; ks < 8; ++ks) qf[ks] = *(const bf16x8*)(Q + (size_t)(row0 + (tok ? t : 0)) * D + h * 256 + 128 * dh + 16 * ks + 8 * hh);
#pragma unroll
        for (int mt = 0; mt < 2; ++mt) {
            P6_STAGE(Kp, mt, dh, A_K, AK_STR);
            __syncthreads();
            if (active) {
#pragma unroll
                for (int mi = 0; mi < 4; ++mi)
#pragma unroll
                    for (int ks = 0; ks < 8; ++ks) { const bf16x8 kf = *(const LAS bf16x8*)(lds + A_K + (32 * mi + r32) * AK_STR + (16 * ks + 8 * hh) * 2);
                        sT[4 * mt + mi] = MFMA32(kf, qf[ks], sT[4 * mt + mi]); }
            }
            __syncthreads();
        }
    }
    float mx = -3.0e38f;
#pragma unroll
    for (int i = 0; i < 8; ++i)
#pragma unroll
        for (int rg = 0; rg < 16; ++rg) mx = fmaxf(mx, sT[i][rg]);
    mx = fmaxf(mx, __shfl_xor(mx, 32));
    const float c2 = 0.0625f * 1.4426950408889634f;
    float sum = 0.f;
    bf16x8 pf[8][2];
#pragma unroll
    for (int i = 0; i < 8; ++i) {
#pragma unroll
        for (int rg = 0; rg < 16; ++rg) { const float p = __builtin_amdgcn_exp2f((sT[i][rg] - mx) * c2); sT[i][rg] = p; sum += p; }
        pf[i][0] = pack8(sT[i], 0); pf[i][1] = pack8(sT[i], 1); }
    sum += __shfl_xor(sum, 32);
    const float rinv = 1.0f / sum;
    const int g16 = (lane >> 4) & 1, i16 = lane & 15, q_ = i16 >> 2, p_ = i16 & 3;
#pragma unroll
    for (int nh = 0; nh < 2; ++nh) {
        f32x16 oT[4];
#pragma unroll
        for (int i = 0; i < 4; ++i)
#pragma unroll
            for (int rg = 0; rg < 16; ++rg) oT[i][rg] = 0.f;
#pragma unroll
        for (int mt = 0; mt < 2; ++mt) {
            P6_STAGE(Vp, mt, nh, A_V, AV_STR);
            __syncthreads();
            if (active) {
#pragma unroll
                for (int mi = 0; mi < 4; ++mi)
#pragma unroll
                    for (int s = 0; s < 2; ++s) {
                        const bf16x8 pb = pf[4 * mt + mi][s];
#pragma unroll
                        for (int nt = 0; nt < 4; ++nt) {
                            const LAS unsigned char* vb = lds + A_V + (32 * mi + 16 * s + 4 * hh + q_) * AV_STR + (32 * nt + 16 * g16 + 4 * p_) * 2;
                            const bf16x8 va = cat8(vtr(vb), vtr(vb + 8 * AV_STR));
                            oT[nt] = MFMA32(va, pb, oT[nt]);
                        }
                    }
            }
            __syncthreads();
        }
        if (tok) {
            bf16* orow = Oo + (size_t)(row0 + t) * D + h * 256 + 128 * nh;
#pragma unroll
            for (int nt = 0; nt < 4; ++nt)
#pragma unroll
                for (int g = 0; g < 4; ++g) { u32x2 o; o.x = pk2(oT[nt][4 * g] * rinv, oT[nt][4 * g + 1] * rinv); o.y = pk2(oT[nt][4 * g + 2] * rinv, oT[nt][4 * g + 3] * rinv);
                    *(u32x2*)(orow + 32 * nt + 8 * g + 4 * hh) = o; }
        }
    }
}
__device__ __forceinline__ void phase6(const Params& P, LAS unsigned char* lds, int vcu, int G) {
    for (int u = vcu; u < 256 + 512; u += G) {
        if (u < 256) { const int qb = u & 7, h = (u >> 3) & 3, b = u >> 5; attn_unit<false>(P, lds, b, h, b * 2048 + qb * 256, 256, P.ws + WS_MKB, P.ws + WS_MVB); }
        else { const int v = u - 256, h = v & 3, b = v >> 2; attn_unit<true>(P, lds, b, h, NP + b * 8, 8, P.in[I_CK], P.in[I_CV]); }
    }
}

__global__ void __launch_bounds__(NTHR, 2) mega_fwd(Params P) {
    extern __shared__ __attribute__((aligned(16))) unsigned char lds_raw[];
    LAS unsigned char* lds = (LAS unsigned char*)lds_raw;
    cg::grid_group grid = cg::this_grid();
    if (threadIdx.x < 16) ((LAS unsigned*)(lds + MISC_OFF))[threadIdx.x] = 0u;
    __syncthreads();
    const XcdBarrier xbar = xcd_barrier_post((unsigned*)(P.ws + WS_CTL) + 1024, (volatile LAS unsigned*)(lds + MISC_OFF));
    const int G = gridDim.x; const int bx = blockIdx.x; const int vcu = (G % 8 == 0) ? (bx % 8) * (G / 8) + bx / 8 : bx;
    unsigned char* ws = P.ws;
    const int stop = P.stop_after;
#define SEAM(k) do { if (stop <= (k)) return; if ((k) == 0) grid.sync(); else xcd_barrier(xbar); } while (0)
#ifndef NO_P0
    phase0(P, lds, vcu, G);
#endif
    SEAM(0);
    { pg8::Gemm g{(const bf16*)(ws + WS_H), (const bf16*)(ws + WS_WIN), NT, NZ, D}; pg8::StaticOrder S; S.init(NT, NZ, G, bx);
      pg8::EpiBf16<0> E{(bf16*)(ws + WS_Z), NZ};
      pg8::gemm_phase<pg8::EpiBf16<0>, pg8::StaticOrder, true, true>(lds, g, S, E); }
    { pg8::Gemm g{(const bf16*)(ws + WS_MB), (const bf16*)(ws + WS_WXKV), NMEM, 2 * D, D}; pg8::StaticOrder S; S.init(NMEM, 2 * D, G, (bx >= G / 2) ? bx - G / 2 : -1);
      pg8::EpiKV E{P.out + O_MK, P.out + O_MV, (bf16*)(ws + WS_MKB), (bf16*)(ws + WS_MVB)};
      pg8::gemm_phase<pg8::EpiKV, pg8::StaticOrder, true, true>(lds, g, S, E); }
    SEAM(1);
#ifndef NO_P2
    phase2a(P, lds, vcu, G);
    if (stop == 2 && (P.pad & 0xff) == 1) return;
    xcd_barrier(xbar);
    phase2b(P, lds, vcu, G);
    if (stop == 2 && (P.pad & 0xff) == 2) return;
    xcd_barrier(xbar);
    phase2c(P, vcu, G);
#endif
    SEAM(2);
    { pg8::Gemm g{(const bf16*)(ws + WS_MG), (const bf16*)(ws + WS_WMO), NP, D, 2 * D}; pg8::StaticOrder S; S.init(NP, D, G, bx);
      pg8::EpiF32 E{(float*)(ws + WS_T), D};
      pg8::gemm_phase<pg8::EpiF32, pg8::StaticOrder, true, true>(lds, g, S, E); }
    small_gemm(lds, (const bf16*)(ws + WS_MG) + (size_t)NP * 2 * D, (const bf16*)(ws + WS_WMO), 2 * D, D, vcu, G, SEpiF32{(float*)(ws + WS_T) + (size_t)NP * D, D});
    SEAM(3);
    row_phase(P.in[I_XP], P.in[I_XS], (const float*)(ws + WS_T), P.in[I_GQM], P.yout, P.in[I_GPX], (bf16*)(ws + WS_H), vcu, G);
    SEAM(4);
    { pg8::Gemm g{(const bf16*)(ws + WS_H), (const bf16*)(ws + WS_WXQ), NP, D, D}; pg8::StaticOrder S; S.init(NP, D, G, bx);
      pg8::EpiBf16<0> E{(bf16*)(ws + WS_Q), D};
      pg8::gemm_phase<pg8::EpiBf16<0>, pg8::StaticOrder, true, true>(lds, g, S, E); }
    small_gemm(lds, (const bf16*)(ws + WS_H) + (size_t)NP * D, (const bf16*)(ws + WS_WXQ), D, D, vcu, G, SEpiBf16{(bf16*)(ws + WS_Q) + (size_t)NP * D, D});
    SEAM(5);
#ifndef NO_P6
    phase6(P, lds, vcu, G);
#endif
    SEAM(6);
    { pg8::Gemm g{(const bf16*)(ws + WS_O), (const bf16*)(ws + WS_WXO), NP, D, D}; pg8::StaticOrder S; S.init(NP, D, G, bx);
      pg8::EpiF32 E{(float*)(ws + WS_T), D};
      pg8::gemm_phase<pg8::EpiF32, pg8::StaticOrder, true, true>(lds, g, S, E); }
    small_gemm(lds, (const bf16*)(ws + WS_O) + (size_t)NP * D, (const bf16*)(ws + WS_WXO), D, D, vcu, G, SEpiF32{(float*)(ws + WS_T) + (size_t)NP * D, D});
    SEAM(7);
    row_phase(P.yout, nullptr, (const float*)(ws + WS_T), P.in[I_GQX], P.yout, P.in[I_GPF], (bf16*)(ws + WS_H), vcu, G);
    SEAM(8);
    { pg8::Gemm g{(const bf16*)(ws + WS_H), (const bf16*)(ws + WS_WUP), NT, FF, D}; pg8::StaticOrder S; S.init(NT, FF, G, bx);
      pg8::EpiBf16<2> E{(bf16*)(ws + WS_U), FF};
      pg8::gemm_phase<pg8::EpiBf16<2>, pg8::StaticOrder, true, true>(lds, g, S, E); }
    SEAM(9);
    { pg8::Gemm g{(const bf16*)(ws + WS_U), (const bf16*)(ws + WS_WDN), NP, D, FF}; pg8::StaticOrder S; S.init(NP, D, G, bx);
      pg8::EpiF32 E{(float*)(ws + WS_T), D};
      pg8::gemm_phase<pg8::EpiF32, pg8::StaticOrder, true, true>(lds, g, S, E); }
    small_gemm(lds, (const bf16*)(ws + WS_U) + (size_t)NP * FF, (const bf16*)(ws + WS_WDN), FF, D, vcu, G, SEpiF32{(float*)(ws + WS_T) + (size_t)NP * D, D});
    SEAM(10);
    row_phase(P.yout, nullptr, (const float*)(ws + WS_T), P.in[I_GQF], P.yout, nullptr, nullptr, vcu, G);
#undef SEAM
}
}


#ifndef HYBRID
#define HYBRID 0
#endif
extern "C" void kernel_launch(void* const* d_in, const int* in_sizes, int n_in, void* d_out, int out_size, void* d_ws, size_t ws_size, hipStream_t stream) {
    static int grid = 0;
    if (grid == 0) {
        if (n_in != 26 || out_size != (int)mk::O_END || ws_size < mk::WS_END) { fprintf(stderr, "kernel_launch: unexpected sizes n_in %d out %d ws %zu\n", n_in, out_size, ws_size); grid = -1; return; }
        int dev = 0, cus = 0, per_cu = 0;
        if (hipGetDevice(&dev) != hipSuccess || hipDeviceGetAttribute(&cus, hipDeviceAttributeMultiprocessorCount, dev) != hipSuccess) { grid = -1; return; }
        if (hipFuncSetAttribute((const void*)mk::mega_fwd, hipFuncAttributeMaxDynamicSharedMemorySize, mk::LDS_BYTES) != hipSuccess) { fprintf(stderr, "kernel_launch: hipFuncSetAttribute failed\n"); grid = -1; return; }
        if (hipOccupancyMaxActiveBlocksPerMultiprocessor(&per_cu, (const void*)mk::mega_fwd, mk::NTHR, mk::LDS_BYTES) != hipSuccess || per_cu < 1) { fprintf(stderr, "kernel_launch: occupancy query says %d\n", per_cu); grid = -1; (void)hipGetLastError(); return; }
        grid = cus;
    }
    if (grid < 0) return;
    if (hipMemsetAsync((char*)d_ws + mk::WS_CTL, 0, 65536, stream) != hipSuccess) { fprintf(stderr, "kernel_launch: memset failed\n"); return; }
    mk::Params p{};
    for (int i = 0; i < 26; ++i) p.in[i] = (const float*)d_in[i];
    p.out = (float*)d_out; p.ws = (unsigned char*)d_ws; p.yout = (float*)d_out + mk::O_YP; p.stop_after = 100; p.pad = 0;
    void* args[] = {&p};
    hipError_t e = hipLaunchCooperativeKernel((const void*)mk::mega_fwd, dim3(grid), dim3(mk::NTHR), args, mk::LDS_BYTES, stream);
    if (e != hipSuccess) fprintf(stderr, "cooperative launch failed: %s (grid %d)\n", hipGetErrorString(e), grid);
#ifdef PROBE_STOP
    if (hipMemsetAsync((char*)d_ws + mk::WS_CTL, 0, 65536, stream) != hipSuccess) return;
    mk::Params p2 = p; p2.stop_after = PROBE_STOP;
#ifdef PROBE_SUB
    p2.pad = PROBE_SUB;
#endif
#ifdef PROBE_FLAGS
    p2.pad |= PROBE_FLAGS;
#endif p2.yout = (float*)((unsigned char*)d_ws + mk::WS_MG);
    void* args2[] = {&p2};
    e = hipLaunchCooperativeKernel((const void*)mk::mega_fwd, dim3(grid), dim3(mk::NTHR), args2, mk::LDS_BYTES, stream);
    if (e != hipSuccess) fprintf(stderr, "cooperative launch 2 failed: %s\n", hipGetErrorString(e));
#endif
}
```

```cpp
#include <hip/hip_runtime.h>
#include <cstdio>
#include <cstdint>

namespace pg8 {
#define PG8_LAS __attribute__((address_space(3)))
typedef unsigned short bf16_t;
typedef short bf16x8 __attribute__((ext_vector_type(8)));
typedef float f32x4 __attribute__((ext_vector_type(4)));
typedef unsigned u32x4 __attribute__((ext_vector_type(4)));
typedef unsigned u32x2 __attribute__((ext_vector_type(2)));
constexpr int BM = 256, BK = 64, HALF = 128, HTB = HALF * BK * 2  , STAGE_BYTES = 8 * HTB, NXCD = 8, WGM = 8;

__host__ __device__ __forceinline__ int lds_byte(int r, int c) { const int st = (r >> 4) * 2 + (c >> 5), rr = r & 15, cc = c & 31, ob = rr * 64 + cc * 2; return st * 1024 + (ob ^ (((ob >> 9) & 1) << 5)); }
__host__ __device__ __forceinline__ void stage_rc(int b, int& R, int& C) { const int st = b / 1024, sb = b % 1024, swz = sb ^ (((sb >> 9) & 1) << 5); R = (st >> 1) * 16 + swz / 64; C = (st & 1) * 32 + (swz % 64) / 2; }
__host__ __device__ __forceinline__ int perm32(int rho) { const int n = rho >> 4, i = rho & 15; return 8 * (i >> 2) + 4 * n + (i & 3); }

struct Unit { int pm, pn; };
struct Gemm { const bf16_t* A; const bf16_t* Bt; int M, N, K; };

struct StaticOrder {
    int nM, nN, nwg, G, c;
    __host__ __device__ void init(int M, int N, int G_, int c_) { nM = M / BM; nN = N / BM; nwg = nM * nN; G = G_; c = c_; }
    __host__ __device__ bool next(int i, Unit& u) const {
        if (c < 0) return false;
        const long L = (long)i * G + c; if (L >= nwg) return false;
        int wgid = (int)L; { const int q = nwg / NXCD, r = nwg % NXCD, xcd = wgid % NXCD, off = wgid / NXCD; wgid = (xcd < r ? xcd * (q + 1) : r * (q + 1) + (xcd - r) * q) + off; }
        const int nig = WGM * nN, gid = wgid / nig, fm = gid * WGM, gsz = (nM - fm) < WGM ? (nM - fm) : WGM;
        u.pm = fm + ((wgid % nig) % gsz); u.pn = (wgid % nig) / gsz; return true;
    }
    __device__ __forceinline__ void a_ready(const Unit&) const {}
    __device__ __forceinline__ void done(const Unit&) const {}
};

typedef float f32x2_t __attribute__((ext_vector_type(2))); typedef __bf16 bf16x2_t __attribute__((ext_vector_type(2)));
__device__ __forceinline__ unsigned cvt_pk_bf16(float lo, float hi) { f32x2_t v = {lo, hi}; bf16x2_t b = __builtin_convertvector(v, bf16x2_t); return __builtin_bit_cast(unsigned, b); }

template <int ACT  > struct EpiBf16 {
    static constexpr bool PERM = true, AFTER_DRAIN = false;
    bf16_t* O; int ldc;
    __device__ __forceinline__ void operator()(const f32x4 (&acc)[2][2][4][2], const Unit& u, int wr, int wc, int fr, int fq) const {
        const int row0 = u.pm * BM + wr * 64 + fr; const int col0 = u.pn * BM + wc * 32 + 8 * fq;
#pragma unroll
        for (int ai = 0; ai < 2; ++ai)
#pragma unroll
            for (int m = 0; m < 4; ++m) { bf16_t* rowp = O + (size_t)(row0 + ai * HALF + m * 16) * ldc + col0;
#pragma unroll
                for (int bj = 0; bj < 2; ++bj) { f32x4 v0 = acc[ai][bj][m][0], v1 = acc[ai][bj][m][1];
                    if (ACT == 2) {
#pragma unroll
                        for (int e = 0; e < 4; ++e) { const float a = v0[e] > 0.f ? v0[e] : 0.f, b = v1[e] > 0.f ? v1[e] : 0.f; v0[e] = a * a; v1[e] = b * b; } }
                    u32x4 w; w.x = cvt_pk_bf16(v0[0], v0[1]); w.y = cvt_pk_bf16(v0[2], v0[3]); w.z = cvt_pk_bf16(v1[0], v1[1]); w.w = cvt_pk_bf16(v1[2], v1[3]);
                    *(u32x4*)(rowp + bj * HALF) = w; } }
    }
};
struct EpiF32 {
    static constexpr bool PERM = false, AFTER_DRAIN = false;
    float* O; int ldc;
    __device__ __forceinline__ void operator()(const f32x4 (&acc)[2][2][4][2], const Unit& u, int wr, int wc, int fr, int fq) const {
        const int row0 = u.pm * BM + wr * 64 + fr; const int col0 = u.pn * BM + wc * 32 + 4 * fq;
#pragma unroll
        for (int ai = 0; ai < 2; ++ai)
#pragma unroll
            for (int m = 0; m < 4; ++m) { float* rowp = O + (size_t)(row0 + ai * HALF + m * 16) * ldc + col0;
#pragma unroll
                for (int bj = 0; bj < 2; ++bj)
#pragma unroll
                    for (int n = 0; n < 2; ++n) *(f32x4*)(rowp + bj * HALF + n * 16) = acc[ai][bj][m][n]; }
    }
};
struct EpiKV {
    static constexpr bool PERM = false, AFTER_DRAIN = false;
    float* OK; float* OV; bf16_t* BK_; bf16_t* BV_;
    __device__ __forceinline__ void operator()(const f32x4 (&acc)[2][2][4][2], const Unit& u, int wr, int wc, int fr, int fq) const {
        const int row0 = u.pm * BM + wr * 64 + fr; const bool isv = u.pn >= 4; const int col0 = (u.pn & 3) * BM + wc * 32 + 4 * fq;
        float* Of = isv ? OV : OK; bf16_t* Ob = isv ? BV_ : BK_;
#pragma unroll
        for (int ai = 0; ai < 2; ++ai)
#pragma unroll
            for (int m = 0; m < 4; ++m) { const size_t ro = (size_t)(row0 + ai * HALF + m * 16) * 1024 + col0;
#pragma unroll
                for (int bj = 0; bj < 2; ++bj)
#pragma unroll
                    for (int n = 0; n < 2; ++n) { const f32x4 v = acc[ai][bj][m][n]; *(f32x4*)(Of + ro + bj * HALF + n * 16) = v;
                        u32x2 w; w.x = cvt_pk_bf16(v[0], v[1]); w.y = cvt_pk_bf16(v[2], v[3]); *(u32x2*)(Ob + ro + bj * HALF + n * 16) = w; } }
    }
};

template <class Epi, class Sched, bool ALIGN_EPI = false, bool SP2 = false>
__device__ __forceinline__ void gemm_phase(PG8_LAS unsigned char* lds, const Gemm g, const Sched& S, const Epi& E) {
    int tid = threadIdx.x; asm volatile("" : "+v"(tid));
    const int wid = __builtin_amdgcn_readfirstlane(tid >> 6), lane = tid & 63, wr = wid >> 2, wc = wid & 3, fr = lane & 15, fq = lane >> 4;
    const int K = g.K, nt = K / BK;
    unsigned voffA[2], voffB[2];
#pragma unroll
    for (int i = 0; i < 2; ++i) { int R, C; stage_rc(tid * 16 + i * 8192, R, C); const int Rb = Epi::PERM ? ((R & ~31) + perm32(R & 31)) : R;
        voffA[i] = (unsigned)(R * K + C) * 2u; voffB[i] = (unsigned)(Rb * K + C) * 2u; }
    const size_t kstep = (size_t)(BK * 2);
    const size_t hstep = (size_t)HALF * K * 2;
    const size_t tstep = 2 * hstep;
    const unsigned ldsw = (unsigned)wid * 1024u;
    const int aoff = lds_byte(wr * 64 + fr, fq * 8), boff = lds_byte(wc * 32 + fr, fq * 8);
#define PG8_SA(b, h) (((b) * 2 + (h)) * HTB)
#define PG8_SB(b, h) ((4 + (b) * 2 + (h)) * HTB)
#define PG8_STAGE(bufoff, gbase, voff) do { _Pragma("unroll") for (int _i = 0; _i < 2; ++_i) \
        __builtin_amdgcn_global_load_lds((const unsigned*)((const char*)(gbase) + (voff)[_i]), (PG8_LAS unsigned*)(lds + (bufoff) + ldsw + _i * 8192), 16, 0, 0); } while (0)
#define PG8_LDA(dst, b, h) do { _Pragma("unroll") for (int m = 0; m < 4; ++m) _Pragma("unroll") for (int k = 0; k < 2; ++k) dst[m][k] = *(const PG8_LAS bf16x8*)(lds + PG8_SA(b, h) + aoff + m * 2048 + k * 1024); } while (0)
#define PG8_LDB(dst, b, h) do { _Pragma("unroll") for (int n = 0; n < 2; ++n) _Pragma("unroll") for (int k = 0; k < 2; ++k) dst[n][k] = *(const PG8_LAS bf16x8*)(lds + PG8_SB(b, h) + boff + n * 2048 + k * 1024); } while (0)
#define PG8_MMA(ai, bj, At, Bt) do { __builtin_amdgcn_s_setprio(1); _Pragma("unroll") for (int m = 0; m < 4; ++m) _Pragma("unroll") for (int n = 0; n < 2; ++n) _Pragma("unroll") for (int k = 0; k < 2; ++k) \
        acc[ai][bj][m][n] = __builtin_amdgcn_mfma_f32_16x16x32_bf16(Bt[n][k], At[m][k], acc[ai][bj][m][n], 0, 0, 0); __builtin_amdgcn_s_setprio(0); } while (0)
#define PG8_WAIT_V(n) asm volatile("s_waitcnt vmcnt(" #n ")" ::: "memory")
#define PG8_WAIT_L(n) asm volatile("s_waitcnt lgkmcnt(" #n ")" ::: "memory")
#define PG8_BAR __builtin_amdgcn_s_barrier()
#define PG8_SCHED __builtin_amdgcn_sched_barrier(0)
    Unit cur, nxt; int ui = 0;
    if (!S.next(0, cur)) return;
    f32x4 acc[2][2][4][2];
#pragma unroll
    for (int a = 0; a < 2; ++a)
#pragma unroll
        for (int b = 0; b < 2; ++b)
#pragma unroll
            for (int m = 0; m < 4; ++m)
#pragma unroll
                for (int n = 0; n < 2; ++n) acc[a][b][m][n] = (f32x4){0.f, 0.f, 0.f, 0.f};
    bf16x8 At[4][2], B0[2][2], B1[2][2];
    const char* cA = (const char*)g.A + (size_t)cur.pm * tstep; const char* cB = (const char*)g.Bt + (size_t)cur.pn * tstep;
    S.a_ready(cur);
    if constexpr (SP2) {
        PG8_STAGE(PG8_SB(0, 0), cB, voffB); PG8_STAGE(PG8_SB(0, 1), cB + hstep, voffB); PG8_STAGE(PG8_SA(0, 0), cA, voffA); PG8_STAGE(PG8_SA(0, 1), cA + hstep, voffA);
        if (wr == 1) PG8_BAR;
        PG8_WAIT_V(2); PG8_BAR;
        PG8_STAGE(PG8_SB(1, 0), cB + kstep, voffB); PG8_STAGE(PG8_SA(1, 0), cA + kstep, voffA); PG8_STAGE(PG8_SB(1, 1), cB + hstep + kstep, voffB);
        PG8_WAIT_V(6); PG8_BAR;
    } else {
        PG8_STAGE(PG8_SB(0, 0), cB, voffB); PG8_STAGE(PG8_SA(0, 0), cA, voffA); PG8_STAGE(PG8_SB(0, 1), cB + hstep, voffB); PG8_STAGE(PG8_SA(0, 1), cA + hstep, voffA);
        if (wr == 1) PG8_BAR;
        PG8_WAIT_V(4); PG8_BAR;
        PG8_STAGE(PG8_SB(1, 0), cB + kstep, voffB); PG8_STAGE(PG8_SA(1, 0), cA + kstep, voffA); PG8_STAGE(PG8_SB(1, 1), cB + hstep + kstep, voffB);
        PG8_WAIT_V(6); PG8_BAR;
    }
    for (;;) {
        const bool has_next = S.next(ui + 1, nxt);
        const char* nA = has_next ? (const char*)g.A + (size_t)nxt.pm * tstep : cA; const char* nB = has_next ? (const char*)g.Bt + (size_t)nxt.pn * tstep : cB;
        for (int t = 0; t < nt; t += 2) {
            const bool last = (t == nt - 2);
            const char* a1 = cA + (size_t)(t + 1) * kstep;
            const char* a2 = last ? nA : cA + (size_t)(t + 2) * kstep; const char* b2 = last ? nB : cB + (size_t)(t + 2) * kstep;
            const char* a3 = a2 + kstep; const char* b3 = b2 + kstep;
            if (last && has_next) S.a_ready(nxt);
            if constexpr (SP2) {
            PG8_LDB(B0, 0, 0); PG8_LDB(B1, 0, 1); PG8_SCHED; PG8_LDA(At, 0, 0); PG8_STAGE(PG8_SA(1, 1), a1 + hstep, voffA);
            PG8_WAIT_V(8); PG8_WAIT_L(0); PG8_BAR; PG8_MMA(0, 0, At, B0); PG8_MMA(0, 1, At, B1); PG8_BAR; PG8_SCHED;
            PG8_LDA(At, 0, 1); PG8_STAGE(PG8_SB(0, 0), b2, voffB); PG8_STAGE(PG8_SB(0, 1), b2 + hstep, voffB); PG8_STAGE(PG8_SA(0, 0), a2, voffA);
            PG8_WAIT_V(8); PG8_WAIT_L(0); PG8_BAR; PG8_MMA(1, 0, At, B0); PG8_MMA(1, 1, At, B1); PG8_BAR; PG8_SCHED;
            PG8_LDB(B0, 1, 0); PG8_LDB(B1, 1, 1); PG8_SCHED; PG8_LDA(At, 1, 0); PG8_STAGE(PG8_SA(0, 1), a2 + hstep, voffA);
            PG8_WAIT_V(8); PG8_WAIT_L(0); PG8_BAR; PG8_MMA(0, 0, At, B0); PG8_MMA(0, 1, At, B1); PG8_BAR; PG8_SCHED;
            PG8_LDA(At, 1, 1); PG8_STAGE(PG8_SB(1, 0), b3, voffB); PG8_STAGE(PG8_SB(1, 1), b3 + hstep, voffB); PG8_STAGE(PG8_SA(1, 0), a3, voffA);
            PG8_WAIT_V(8); PG8_WAIT_L(0); PG8_BAR; PG8_MMA(1, 0, At, B0); PG8_MMA(1, 1, At, B1); PG8_BAR; PG8_SCHED;
            } else {
            PG8_LDB(B0, 0, 0); PG8_SCHED; PG8_LDA(At, 0, 0); PG8_STAGE(PG8_SA(1, 1), a1 + hstep, voffA);
            PG8_WAIT_L(8); PG8_BAR; PG8_WAIT_L(0); PG8_MMA(0, 0, At, B0); PG8_BAR; PG8_SCHED;
            PG8_LDB(B1, 0, 1); PG8_STAGE(PG8_SB(0, 0), b2, voffB);
            PG8_BAR; PG8_WAIT_L(0); PG8_MMA(0, 1, At, B1); PG8_BAR;
            PG8_LDA(At, 0, 1); PG8_STAGE(PG8_SA(0, 0), a2, voffA);
            PG8_BAR; PG8_WAIT_L(0); PG8_MMA(1, 0, At, B0); PG8_BAR; PG8_SCHED;
            PG8_STAGE(PG8_SB(0, 1), b2 + hstep, voffB);
            PG8_WAIT_V(6); PG8_BAR; PG8_MMA(1, 1, At, B1); PG8_BAR;
            PG8_LDB(B0, 1, 0); PG8_SCHED; PG8_LDA(At, 1, 0); PG8_STAGE(PG8_SA(0, 1), a2 + hstep, voffA);
            PG8_WAIT_L(8); PG8_BAR; PG8_WAIT_L(0); PG8_MMA(0, 0, At, B0); PG8_BAR; PG8_SCHED;
            PG8_LDB(B1, 1, 1); PG8_STAGE(PG8_SB(1, 0), b3, voffB);
            PG8_BAR; PG8_WAIT_L(0); PG8_MMA(0, 1, At, B1); PG8_BAR;
            PG8_LDA(At, 1, 1); PG8_STAGE(PG8_SA(1, 0), a3, voffA);
            PG8_BAR; PG8_WAIT_L(0); PG8_MMA(1, 0, At, B0); PG8_BAR; PG8_SCHED;
            PG8_STAGE(PG8_SB(1, 1), b3 + hstep, voffB);
            PG8_WAIT_V(6); PG8_BAR; PG8_MMA(1, 1, At, B1); PG8_BAR;
            }
        }
        if constexpr (ALIGN_EPI) { if (wr == 0) PG8_BAR; }
        if constexpr (!Epi::AFTER_DRAIN) { E(acc, cur, wr, wc, fr, fq); S.done(cur); }
        if (!has_next) break;
#pragma unroll
        for (int a = 0; a < 2; ++a)
#pragma unroll
            for (int b = 0; b < 2; ++b)
#pragma unroll
                for (int m = 0; m < 4; ++m)
#pragma unroll
                    for (int n = 0; n < 2; ++n) acc[a][b][m][n] = (f32x4){0.f, 0.f, 0.f, 0.f};
        cur = nxt; cA = nA; cB = nB; ++ui;
        if constexpr (ALIGN_EPI) { if (wr == 1) PG8_BAR; }
    }
    PG8_WAIT_V(0);
    if constexpr (!ALIGN_EPI) { if (wr == 0) PG8_BAR; }
    PG8_BAR;
#undef PG8_SA
#undef PG8_SB
#undef PG8_STAGE
#undef PG8_LDA
#undef PG8_LDB
#undef PG8_MMA
#undef PG8_WAIT_V
#undef PG8_WAIT_L
#undef PG8_BAR
#undef PG8_SCHED
}
}

#include <hip/hip_cooperative_groups.h>
namespace mk {
namespace cg = cooperative_groups;
#define LAS __attribute__((address_space(3)))
#define GAS __attribute__((address_space(1)))
typedef unsigned short bf16;
typedef float f32x4 __attribute__((ext_vector_type(4)));
typedef float f32x16 __attribute__((ext_vector_type(16)));
typedef unsigned u32x4 __attribute__((ext_vector_type(4)));
typedef unsigned u32x2 __attribute__((ext_vector_type(2)));
typedef short bf16x8 __attribute__((ext_vector_type(8)));
typedef short s16x4 __attribute__((ext_vector_type(4)));
typedef short v4i16_t __attribute__((ext_vector_type(4)));

constexpr int NWAVES = 8, NTHR = 512;
constexpr int D = 1024, NP = 16384, NS = 1024, NT = NP + NS, NIN = 8208, NZ = 8192, FF = 4096, NMEM = 2048;
constexpr size_t O_YP = 0, O_YS = 16777216, O_SGP = 17825792, O_SRP = 18874368, O_MK = 19922944, O_MV = 22020096, O_SGS = 24117248, O_SRS = 40894464, O_END = 57671680;
constexpr int ZC_GQ = 0, ZC_GK = 512, ZC_GV = 1024, ZC_GR = 2048, ZC_RQ = 3072, ZC_RK = 3584, ZC_RV = 4096, ZC_RG = 5120, ZC_GA = 6144, ZC_GB = 7168;
constexpr size_t MiB = 1u << 20;
constexpr size_t WS_CTL = 0, WS_WIN = 1 * MiB, WS_WMO = 17 * MiB, WS_WXQ = 21 * MiB, WS_WXKV = 23 * MiB, WS_WXO = 27 * MiB, WS_WUP = 29 * MiB, WS_WDN = 37 * MiB, WS_ROPE = 45 * MiB, WS_GAL = 47 * MiB,
                 WS_MB = 49 * MiB, WS_MKB = 53 * MiB, WS_MVB = 57 * MiB, WS_H = 61 * MiB, WS_Z = 95 * MiB, WS_Q = WS_Z, WS_O = WS_Z + 34 * MiB, WS_U = WS_Z + 68 * MiB, WS_MG = 367 * MiB, WS_T = 435 * MiB, WS_END = 540 * MiB;
constexpr int LDS_BYTES = 147456, MISC_OFF = LDS_BYTES - 64;
constexpr float EPS = 1e-6f;

__device__ __forceinline__ unsigned pk2(float lo, float hi) { return pg8::cvt_pk_bf16(lo, hi); }
__device__ __forceinline__ float bf2f(unsigned short u) { return __uint_as_float((unsigned)u << 16); }
__device__ __forceinline__ float bflo(unsigned w) { return __uint_as_float(w << 16); }
__device__ __forceinline__ float bfhi(unsigned w) { return __uint_as_float(w & 0xffff0000u); }
__device__ __forceinline__ unsigned short f2bf(float f) { return (unsigned short)(pk2(f, 0.f) & 0xffffu); }
__device__ __forceinline__ float wave_sum(float v) {
#pragma unroll
    for (int o = 1; o < 64; o <<= 1) v += __shfl_xor(v, o);
    return v;
}
#define MFMA32(a, b, c) __builtin_amdgcn_mfma_f32_32x32x16_bf16((a), (b), (c), 0, 0, 0)
__device__ __forceinline__ int crow(int reg, int h) { return (reg & 3) + 8 * (reg >> 2) + 4 * h; }
__device__ __forceinline__ bf16x8 pack8(const f32x16& x, int s) {
    u32x4 p; p.x = pk2(x[8 * s + 0], x[8 * s + 1]); p.y = pk2(x[8 * s + 2], x[8 * s + 3]); p.z = pk2(x[8 * s + 4], x[8 * s + 5]); p.w = pk2(x[8 * s + 6], x[8 * s + 7]);
    return __builtin_bit_cast(bf16x8, p);
}
__device__ __forceinline__ s16x4 vtr(const LAS unsigned char* p) { return __builtin_bit_cast(s16x4, __builtin_amdgcn_ds_read_tr16_b64_v4i16((LAS v4i16_t*)p)); }
__device__ __forceinline__ bf16x8 cat8(s16x4 lo, s16x4 hi) { return __builtin_shufflevector(lo, hi, 0, 1, 2, 3, 4, 5, 6, 7); }

struct Params {
    const float* in[26];
    float* out; unsigned char* ws; float* yout;
    int stop_after;
    int pad;
};
enum { I_XP = 0, I_XS, I_SG, I_SR, I_CK, I_CV, I_MEM, I_WIN, I_WA2, I_BA, I_GGLA, I_GRET, I_WMO, I_WXQ, I_WXK, I_WXV, I_WXO, I_GMEM, I_WUP, I_WDN, I_GPM, I_GQM, I_GPX, I_GQX, I_GPF, I_GQF };

__device__ __forceinline__ void transpose_item(const float* W, int ldw, int col_off, int N, bf16* WT, int ldt, int row_off, int kcol_off, LAS float* scr, int item, int lane) {
    const int nblk = N / 64, kb = item / nblk, nb = item % nblk, k0 = 32 * kb, n0 = 64 * nb;
    const int lr = lane >> 4, lc = (lane & 15) * 4;
    f32x4 v[8];
#pragma unroll
    for (int i = 0; i < 8; ++i) v[i] = *(const f32x4*)(W + (size_t)(k0 + 4 * i + lr) * ldw + col_off + n0 + lc);
#pragma unroll
    for (int i = 0; i < 8; ++i) { LAS float* d = scr + (4 * i + lr) * 65 + lc; d[0] = v[i].x; d[1] = v[i].y; d[2] = v[i].z; d[3] = v[i].w; }
    asm volatile("s_waitcnt lgkmcnt(0)" ::: "memory");
    unsigned o[16];
#pragma unroll
    for (int j = 0; j < 16; ++j) o[j] = pk2(scr[(2 * j) * 65 + lane], scr[(2 * j + 1) * 65 + lane]);
    bf16* dst = WT + (size_t)(row_off + n0 + lane) * ldt + kcol_off + k0;
#pragma unroll
    for (int j = 0; j < 4; ++j) *(u32x4*)(dst + 8 * j) = (u32x4){o[4 * j], o[4 * j + 1], o[4 * j + 2], o[4 * j + 3]};
    asm volatile("s_waitcnt lgkmcnt(0)" ::: "memory");
}

template <bool GA>
__device__ __forceinline__ void rms_row_bf16(const float* xrow, const float* g, bf16* orow, const LAS float* wga, float* garow, int lane) {
    f32x4 v[4]; float s = 0.f;
#pragma unroll
    for (int j = 0; j < 4; ++j) { v[j] = ((const f32x4*)xrow)[lane + 64 * j]; s += (v[j].x * v[j].x + v[j].y * v[j].y) + (v[j].z * v[j].z + v[j].w * v[j].w); }
    const float rs = 1.0f / sqrtf(wave_sum(s) * (1.f / D) + EPS);
#pragma unroll
    for (int j = 0; j < 4; ++j) { const f32x4 gg = ((const f32x4*)g)[lane + 64 * j]; v[j] = v[j] * rs * gg; }
#pragma unroll
    for (int j = 0; j < 4; ++j) { u32x2 w; w.x = pk2(v[j].x, v[j].y); w.y = pk2(v[j].z, v[j].w); ((u32x2*)orow)[lane + 64 * j] = w; }
    if (GA) {
        float mine = 0.f;
#pragma unroll
        for (int r = 0; r < 16; ++r) {
            float a = 0.f;
#pragma unroll
            for (int j = 0; j < 4; ++j) { const f32x4 w = ((const LAS f32x4*)(wga + r * 1024))[lane + 64 * j]; a += (v[j].x * w.x + v[j].y * w.y) + (v[j].z * w.z + v[j].w * w.w); }
            a = wave_sum(a);
            if (lane == r) mine = a;
        }
        if (lane < 16) garow[lane] = mine;
    }
}

__device__ __forceinline__ void phase0(const Params& P, LAS unsigned char* lds, int vcu, int G) {
    int tid = threadIdx.x; asm volatile("" : "+v"(tid));
    const int lane = tid & 63, wave = __builtin_amdgcn_readfirstlane(tid >> 6);
    unsigned char* ws = P.ws;
    LAS float* wga = (LAS float*)lds;
    LAS float* scr = (LAS float*)(lds + 65536 + wave * 8704);
    { const float* W = P.in[I_WIN];
      for (int k = tid; k < 1024; k += NTHR) {
#pragma unroll
          for (int q = 0; q < 4; ++q) { const f32x4 w = *(const f32x4*)(W + (size_t)k * NIN + 3072 + 4 * q); wga[(4 * q + 0) * 1024 + k] = w.x; wga[(4 * q + 1) * 1024 + k] = w.y; wga[(4 * q + 2) * 1024 + k] = w.z; wga[(4 * q + 3) * 1024 + k] = w.w; } } }
    const int gw = vcu * NWAVES + wave, NGW = G * NWAVES;
    constexpr int I_IN = (D / 32) * (NZ / 64), I_SQ = (D / 32) * (D / 64), I_UP = (D / 32) * (FF / 64), I_DN = (FF / 32) * (D / 64);
    constexpr int NITEMS = I_IN + 5 * I_SQ + I_UP + I_DN;
    for (int it = gw; it < NITEMS; it += NGW) {
        int r = it;
        if (r < I_IN) { const int nb = r % (NZ / 64); const int coff = (nb * 64 >= 3072) ? 16 : 0;
            transpose_item(P.in[I_WIN], NIN, coff, NZ, (bf16*)(ws + WS_WIN), D, 0, 0, scr, r, lane); continue; } r -= I_IN;
        if (r < I_SQ) { transpose_item(P.in[I_WMO], D, 0, D, (bf16*)(ws + WS_WMO), 2 * D, 0, 0, scr, r, lane); transpose_item(P.in[I_WMO], D, 0, D, (bf16*)(ws + WS_WMO), 2 * D, 0, D, scr, r, lane); continue; } r -= I_SQ;
        if (r < I_SQ) { transpose_item(P.in[I_WXQ], D, 0, D, (bf16*)(ws + WS_WXQ), D, 0, 0, scr, r, lane); continue; } r -= I_SQ;
        if (r < I_SQ) { transpose_item(P.in[I_WXK], D, 0, D, (bf16*)(ws + WS_WXKV), D, 0, 0, scr, r, lane); continue; } r -= I_SQ;
        if (r < I_SQ) { transpose_item(P.in[I_WXV], D, 0, D, (bf16*)(ws + WS_WXKV), D, D, 0, scr, r, lane); continue; } r -= I_SQ;
        if (r < I_SQ) { transpose_item(P.in[I_WXO], D, 0, D, (bf16*)(ws + WS_WXO), D, 0, 0, scr, r, lane); continue; } r -= I_SQ;
        if (r < I_UP) { transpose_item(P.in[I_WUP], FF, 0, FF, (bf16*)(ws + WS_WUP), D, 0, 0, scr, r, lane); continue; } r -= I_UP;
        transpose_item(P.in[I_WDN], D, 0, D, (bf16*)(ws + WS_WDN), FF, 0, 0, scr, r, lane);
    }
    { float* tab = (float*)(ws + WS_ROPE);
      for (int e = (vcu * NTHR + tid); e < 2056 * 64; e += G * NTHR) { const int p = e >> 6, i = e & 63; const int pos = p < 2048 ? p : 16384 + (p - 2048);
          const float inv = (float)pow(10000.0, -(double)i / 64.0); const float ang = (float)pos * inv;
          tab[2 * e] = (float)cos((double)ang); tab[2 * e + 1] = (float)sin((double)ang); } }
    __syncthreads();
    for (int m = gw; m < NT + NMEM; m += NGW) {
        if (m < NT) { const float* xr = m < NP ? P.in[I_XP] + (size_t)m * D : P.in[I_XS] + (size_t)(m - NP) * D;
            rms_row_bf16<true>(xr, P.in[I_GPM], (bf16*)(ws + WS_H) + (size_t)m * D, wga, (float*)(ws + WS_GAL) + (size_t)m * 16, lane); }
        else { const int r = m - NT; rms_row_bf16<false>(P.in[I_MEM] + (size_t)r * D, P.in[I_GMEM], (bf16*)(ws + WS_MB) + (size_t)r * D, wga, nullptr, lane); }
    }
}

__device__ __forceinline__ void row_phase(const float* xop, const float* xos, const float* t, const float* g1, float* xnew, const float* g2, bf16* hn, int vcu, int G) {
    int tid = threadIdx.x; asm volatile("" : "+v"(tid));
    const int lane = tid & 63, wave = __builtin_amdgcn_readfirstlane(tid >> 6);
    const int gw = vcu * NWAVES + wave, NGW = G * NWAVES;
    for (int m = gw; m < NT; m += NGW) {
        const float* xo = (xos && m >= NP) ? xos + (size_t)(m - NP) * D : xop + (size_t)m * D;
        f32x4 tv[4], xv[4]; float s = 0.f;
#pragma unroll
        for (int j = 0; j < 4; ++j) { tv[j] = ((const f32x4*)(t + (size_t)m * D))[lane + 64 * j]; xv[j] = ((const f32x4*)xo)[lane + 64 * j]; s += (tv[j].x * tv[j].x + tv[j].y * tv[j].y) + (tv[j].z * tv[j].z + tv[j].w * tv[j].w); }
        const float rs = 1.0f / sqrtf(wave_sum(s) * (1.f / D) + EPS);
        float s2 = 0.f;
#pragma unroll
        for (int j = 0; j < 4; ++j) { const f32x4 gg = ((const f32x4*)g1)[lane + 64 * j]; xv[j] = xv[j] + tv[j] * rs * gg; ((f32x4*)(xnew + (size_t)m * D))[lane + 64 * j] = xv[j];
            s2 += (xv[j].x * xv[j].x + xv[j].y * xv[j].y) + (xv[j].z * xv[j].z + xv[j].w * xv[j].w); }
        if (hn) {
            const float rs2 = 1.0f / sqrtf(wave_sum(s2) * (1.f / D) + EPS);
#pragma unroll
            for (int j = 0; j < 4; ++j) { const f32x4 gg = ((const f32x4*)g2)[lane + 64 * j]; const f32x4 o = xv[j] * rs2 * gg; u32x2 w; w.x = pk2(o.x, o.y); w.y = pk2(o.z, o.w); ((u32x2*)(hn + (size_t)m * D))[lane + 64 * j] = w; }
        }
    }
}


#define XB_TMO      128
#define XB_XCNT(j)  (256  + 64 * (j))
#define XB_XSUB(j)  (1280 + 64 * (j))
#define XB_XGEN(j)  (2304 + 64 * (j))
#define XB_TOP      3328
#define XB_TOPGEN   3392
#define XCD_BAR_WORDS 3456
#define XB_SPIN_CAP (1u << 22)
__device__ __forceinline__ unsigned xb_ld(unsigned* p)              { return __hip_atomic_load(p, __ATOMIC_RELAXED, __HIP_MEMORY_SCOPE_AGENT); }
__device__ __forceinline__ unsigned xb_add(unsigned* p, unsigned v) { return __hip_atomic_fetch_add(p, v, __ATOMIC_RELAXED, __HIP_MEMORY_SCOPE_AGENT); }
__device__ __forceinline__ unsigned xb_xcc_id() { return (unsigned)__builtin_amdgcn_s_getreg((3 << 11) | 20) & 0xFu; }
#define XB_SPIN(cond, bar) do { unsigned _sp = 0; while (cond) { __builtin_amdgcn_s_sleep(1); \
    if ((++_sp & 255u) == 0u) { if (xb_ld(&(bar)[XB_TMO])) break; if (_sp > XB_SPIN_CAP) { atomicAdd(&(bar)[XB_TMO], 1u); break; } } } } while (0)
struct XcdBarrier { unsigned* bar; unsigned x; volatile LAS unsigned* st; };
__device__ __forceinline__ XcdBarrier xcd_barrier_post(unsigned* bar, volatile LAS unsigned* st) {
    XcdBarrier b; b.bar = bar; b.x = xb_xcc_id(); b.st = st;
    if (threadIdx.x == 0) (void)xb_add(&bar[XB_XCNT(b.x)], 1u);
    return b;
}
__device__ __forceinline__ void xcd_barrier_complete(unsigned* bar, unsigned x, unsigned& nloc, unsigned& nx) {
    const unsigned G = gridDim.x * gridDim.y * gridDim.z;
    unsigned sum, cnt, mine, sp = 0u;
    for (;;) {
        sum = 0u; cnt = 0u; mine = 0u;
#pragma unroll
        for (unsigned j = 0; j < 16; ++j) { const unsigned c = xb_ld(&bar[XB_XCNT(j)]); sum += c; cnt += (c > 0u) ? 1u : 0u; mine = (j == x) ? c : mine; }
        if (sum == G) break;
        __builtin_amdgcn_s_sleep(1);
        if ((++sp & 255u) == 0u) { if (xb_ld(&bar[XB_TMO])) break; if (sp > XB_SPIN_CAP) { atomicAdd(&bar[XB_TMO], 1u); break; } }
    }
    nloc = mine > 0u ? mine : 1u; nx = cnt > 0u ? cnt : 1u;
}
__device__ __forceinline__ void xcd_barrier(const XcdBarrier& b) {
    asm volatile("s_waitcnt vmcnt(0)" ::: "memory");
    __syncthreads();
    if (threadIdx.x == 0) {
        unsigned* bar = b.bar;
        __builtin_amdgcn_s_waitcnt(0);
        unsigned nloc = b.st[0], nx = b.st[1];
        if (nloc == 0u) { xcd_barrier_complete(bar, b.x, nloc, nx); b.st[0] = nloc; b.st[1] = nx; }
        const unsigned old = xb_add(&bar[XB_XSUB(b.x)], 1u);
        const unsigned gen = old / nloc;
        if (old + 1u == (gen + 1u) * nloc) {
            __builtin_amdgcn_fence(__ATOMIC_RELEASE, "agent");
            asm volatile("s_waitcnt vmcnt(0)" ::: "memory");
            const unsigned og = xb_add(&bar[XB_TOP], 1u);
            const unsigned tg = og / nx;
            if (og + 1u == (tg + 1u) * nx) xb_add(&bar[XB_TOPGEN], 1u);
            else XB_SPIN(xb_ld(&bar[XB_TOPGEN]) == tg, bar);
            __builtin_amdgcn_fence(__ATOMIC_ACQUIRE, "agent");
            xb_add(&bar[XB_XGEN(b.x)], 1u);
            asm volatile("s_waitcnt vmcnt(0)" ::: "memory");
        } else {
            XB_SPIN(xb_ld(&bar[XB_XGEN(b.x)]) == gen, bar);
            __builtin_amdgcn_fence(__ATOMIC_ACQUIRE, "agent");
            asm volatile("s_waitcnt vmcnt(0)" ::: "memory");
        }
    }
    __syncthreads();
}

constexpr int SG_STR = 68, SG_SLAB = 64 * SG_STR * 4;
static_assert(8 * SG_SLAB <= LDS_BYTES - 64, "small-gemm LDS");
struct SEpiF32 { float* O; int ldc;
    __device__ __forceinline__ void operator()(int row, int col, const float (&v)[8]) const { float* p = O + (size_t)row * ldc + col; *(f32x4*)p = (f32x4){v[0], v[1], v[2], v[3]}; *(f32x4*)(p + 4) = (f32x4){v[4], v[5], v[6], v[7]}; } };
struct SEpiBf16 { bf16* O; int ldc;
    __device__ __forceinline__ void operator()(int row, int col, const float (&v)[8]) const { u32x4 o; o.x = pk2(v[0], v[1]); o.y = pk2(v[2], v[3]); o.z = pk2(v[4], v[5]); o.w = pk2(v[6], v[7]); *(u32x4*)(O + (size_t)row * ldc + col) = o; } };
template <class SEpi>
__device__ __forceinline__ void small_gemm(LAS unsigned char* lds, const bf16* A, const bf16* Bt, int K, int N, int vcu, int G, const SEpi& E) {
    int tid = threadIdx.x; asm volatile("" : "+v"(tid));
    const int lane = tid & 63, w = __builtin_amdgcn_readfirstlane(tid >> 6), r32 = lane & 31, hh = lane >> 5;
    const int nun = 16 * (N / 64), kw = K / 8;
    for (int u = vcu; u < nun; u += G) {
        const int tm = u & 15, tn = u >> 4;
        f32x16 acc[2][2];
#pragma unroll
        for (int i = 0; i < 2; ++i)
#pragma unroll
            for (int j = 0; j < 2; ++j)
#pragma unroll
                for (int rg = 0; rg < 16; ++rg) acc[i][j][rg] = 0.f;
        const bf16* Ap = A + (size_t)(tm * 64 + r32) * K + w * kw + 8 * hh;
        const bf16* Bp = Bt + (size_t)(tn * 64 + r32) * K + w * kw + 8 * hh;
        const size_t r32k = (size_t)32 * K;
#pragma unroll 4
        for (int ks = 0; ks < kw / 16; ++ks) {
            const bf16x8 a0 = *(const bf16x8*)(Ap + ks * 16), a1 = *(const bf16x8*)(Ap + r32k + ks * 16);
            const bf16x8 b0 = *(const bf16x8*)(Bp + ks * 16), b1 = *(const bf16x8*)(Bp + r32k + ks * 16);
            acc[0][0] = MFMA32(a0, b0, acc[0][0]); acc[0][1] = MFMA32(a0, b1, acc[0][1]); acc[1][0] = MFMA32(a1, b0, acc[1][0]); acc[1][1] = MFMA32(a1, b1, acc[1][1]);
        }
        LAS float* slab = (LAS float*)(lds + w * SG_SLAB);
#pragma unroll
        for (int i = 0; i < 2; ++i)
#pragma unroll
            for (int j = 0; j < 2; ++j)
#pragma unroll
                for (int rg = 0; rg < 16; ++rg) slab[(32 * i + crow(rg, hh)) * SG_STR + 32 * j + r32] = acc[i][j][rg];
        __syncthreads();
        { const int row = tid >> 3, c8 = (tid & 7) * 8;
          f32x4 s0 = (f32x4){0.f, 0.f, 0.f, 0.f}, s1 = s0;
#pragma unroll
          for (int q = 0; q < 8; ++q) { const LAS float* p = (const LAS float*)(lds + q * SG_SLAB) + row * SG_STR + c8; s0 += *(const LAS f32x4*)p; s1 += *(const LAS f32x4*)(p + 4); }
          const float v[8] = {s0.x, s0.y, s0.z, s0.w, s1.x, s1.y, s1.z, s1.w};
          E(tm * 64 + row, tn * 64 + c8, v); }
        __syncthreads();
    }
}

constexpr int L_QT = 0, L_KT = 17408, L_KHT = 34816, L_EBL = 53248, L_IMG = 53760;
constexpr int QT_STR = 272, KHT_STR = 144, P_STR = 144, V_STR = 576;
constexpr int LA_RQ = 53760, LA_RK = 70144, LA_GAL = 86528, LA_PRE = 90624, LA_END = 92672;
constexpr int LB_P = 53760, LB_V = 62976, LB_END = 99840;
constexpr int REC_BYTES = L_IMG, REC_CHUNKS = REC_BYTES / 16  , SREC_BYTES = 6912, SREC_CHUNKS = 432;
constexpr size_t WS_REC = WS_T, WS_SREC = WS_H;
static_assert(WS_REC + (size_t)2048 * REC_BYTES <= WS_END && (size_t)1024 * SREC_BYTES <= 34 * MiB, "record space");
__device__ __forceinline__ int dperm(int d) { return (d & ~12) | ((d & 4) << 1) | ((d & 8) >> 1); }
#define LAUNDER(x) asm volatile("" : "+v"(x))
__device__ __forceinline__ u32x4 mask4(u32x4 v, int t, int Tv) { const unsigned m = (unsigned)((t - Tv) >> 31); return (u32x4){v.x & m, v.y & m, v.z & m, v.w & m}; }

template <int BR>
__device__ __forceinline__ void prep_unit(const Params& P, LAS unsigned char* lds, int h, int rowc, int Tv, int pidx, unsigned char* rec, bool compact) {
    const int tid0 = threadIdx.x;
    const bf16* Z = (const bf16*)(P.ws + WS_Z);
    const float* GAL = (const float*)(P.ws + WS_GAL);
    const float* ROPE = (const float*)(P.ws + WS_ROPE);
    const int cq = (BR == 0 ? ZC_GQ : ZC_RQ) + h * 128, ck = (BR == 0 ? ZC_GK : ZC_RK) + h * 128;
    const float scale = 0.08838834764831845f;
    const float lg = BR == 1 ? log1pf(-exp2f(-5.0f - (float)h)) : 0.f;
    __syncthreads();
    {
        int tid = tid0; LAUNDER(tid); const int pd = tid & 127, ptq = tid >> 7;
        const int pp = dperm(pd);
        const bool work = (16 * ptq) < Tv;
        unsigned kh[8];
#pragma unroll
        for (int i = 0; i < 8; ++i) kh[i] = 0u;
        if (BR == 0) {
            float la[16];
#pragma unroll
            for (int i = 0; i < 16; ++i) la[i] = 0.f;
            if (work) {
                float w2r[16];
#pragma unroll
                for (int r = 0; r < 16; ++r) w2r[r] = P.in[I_WA2][r * 512 + h * 128 + pd];
                const float bias = P.in[I_BA][h * 128 + pd];
#pragma unroll
                for (int i = 0; i < 16; ++i) { const int t = 16 * ptq + i;
                    float x = bias;
#pragma unroll
                    for (int q4 = 0; q4 < 4; ++q4) { const f32x4 g = *(const LAS f32x4*)(lds + LA_GAL + t * 64 + q4 * 16); x += g.x * w2r[4 * q4] + g.y * w2r[4 * q4 + 1] + g.z * w2r[4 * q4 + 2] + g.w * w2r[4 * q4 + 3]; }
                    const float ls = fminf(x, 0.f) - __logf(1.0f + __expf(-fabsf(x)));
                    la[i] = t < Tv ? ls * (1.0f / 16.0f) : 0.f; }
#pragma unroll
                for (int i = 1; i < 16; ++i) la[i] += la[i - 1];
            }
            ((LAS float*)(lds + LA_PRE))[ptq * 128 + pd] = la[15];
            __syncthreads();
            float base = 0.f, btot = 0.f;
#pragma unroll
            for (int q = 0; q < 4; ++q) { const float v = ((const LAS float*)(lds + LA_PRE))[q * 128 + pd]; btot += v; if (q < ptq) base += v; }
            if (ptq == 0) ((LAS float*)(lds + L_EBL))[pd] = __expf(btot);
            if (work) {
#pragma unroll
                for (int i = 0; i < 16; ++i) { const int t = 16 * ptq + i; const float bt = base + la[i];
                    const float qv = bf2f(*(const LAS unsigned short*)(lds + LA_RQ + t * 256 + pd * 2)), kv = bf2f(*(const LAS unsigned short*)(lds + LA_RK + t * 256 + pd * 2));
                    *(LAS unsigned short*)(lds + L_QT + t * QT_STR + pp * 2) = f2bf(qv * (__expf(bt) * scale));
                    *(LAS unsigned short*)(lds + L_KT + t * QT_STR + pp * 2) = f2bf(kv * __expf(-bt));
                    const float k3 = kv * __expf(btot - bt);
                    if (i & 1) kh[i >> 1] = (kh[i >> 1] & 0xffffu) | ((unsigned)f2bf(k3) << 16); else kh[i >> 1] = (unsigned)f2bf(k3); }
            }
        } else {
            const float btot = (float)Tv * lg;
            if (ptq == 0) ((LAS float*)(lds + L_EBL))[pd] = __expf(btot);
            if (work) {
                const int fi = pd & 63; const float sgn = pd < 64 ? -1.f : 1.f;
#pragma unroll
                for (int i = 0; i < 16; ++i) { const int t = 16 * ptq + i;
                    const float bt = (float)(t < Tv ? t + 1 : Tv) * lg;
                    const int pi = pidx + (t < Tv ? t : 0);
                    const float cs = ROPE[(size_t)(pi * 64 + fi) * 2], sn = ROPE[(size_t)(pi * 64 + fi) * 2 + 1];
                    const float q1 = bf2f(*(const LAS unsigned short*)(lds + LA_RQ + t * 256 + pd * 2)), q2 = bf2f(*(const LAS unsigned short*)(lds + LA_RQ + t * 256 + (pd ^ 64) * 2));
                    const float k1 = bf2f(*(const LAS unsigned short*)(lds + LA_RK + t * 256 + pd * 2)), k2 = bf2f(*(const LAS unsigned short*)(lds + LA_RK + t * 256 + (pd ^ 64) * 2));
                    const float qv = q1 * cs + sgn * q2 * sn, kv = k1 * cs + sgn * k2 * sn;
                    *(LAS unsigned short*)(lds + L_QT + t * QT_STR + pp * 2) = f2bf(qv * __expf(bt));
                    *(LAS unsigned short*)(lds + L_KT + t * QT_STR + pp * 2) = f2bf(kv * (__expf(-bt) * scale));
                    const float k3 = kv * (__expf(btot - bt) * scale);
                    if (i & 1) kh[i >> 1] = (kh[i >> 1] & 0xffffu) | ((unsigned)f2bf(k3) << 16); else kh[i >> 1] = (unsigned)f2bf(k3); }
            }
        }
        if (work) {
            *(LAS u32x4*)(lds + L_KHT + pd * KHT_STR + ptq * 32) = (u32x4){kh[0], kh[1], kh[2], kh[3]};
            *(LAS u32x4*)(lds + L_KHT + pd * KHT_STR + ptq * 32 + 16) = (u32x4){kh[4], kh[5], kh[6], kh[7]};
        }
    }
    __syncthreads();
    { int tid = tid0; LAUNDER(tid);
      if (!compact) {
#pragma unroll
          for (int i = 0; i < 7; ++i) { const int ch = tid + 512 * i; if (ch < REC_CHUNKS) *(u32x4*)(rec + (size_t)ch * 16) = *(const LAS u32x4*)(lds + ch * 16); }
      } else if (tid < SREC_CHUNKS) {
          int src;
          if (tid < 136) src = L_QT + tid * 16; else if (tid < 272) src = L_KT + (tid - 136) * 16; else if (tid < 400) src = L_KHT + (tid - 272) * KHT_STR; else src = L_EBL + (tid - 400) * 16;
          *(u32x4*)(rec + (size_t)tid * 16) = *(const LAS u32x4*)(lds + src);
      } }
}
__device__ __forceinline__ void phase2a(const Params& P, LAS unsigned char* lds, int vcu, int G) {
    const int tid0 = threadIdx.x;
    const bf16* Z = (const bf16*)(P.ws + WS_Z);
    const float* GAL = (const float*)(P.ws + WS_GAL);
#define P2A_UNIT(u_, sfx) \
    const bool prompt##sfx = (u_) < 2048; const int v##sfx = prompt##sfx ? (u_) : (u_) - 2048; \
    const int c##sfx = prompt##sfx ? (v##sfx & 31) : 0, br##sfx = prompt##sfx ? ((v##sfx >> 5) & 1) : (v##sfx & 1), h##sfx = prompt##sfx ? ((v##sfx >> 6) & 3) : ((v##sfx >> 1) & 3), b##sfx = prompt##sfx ? (v##sfx >> 8) : (v##sfx >> 3); \
    const int rowc##sfx = prompt##sfx ? b##sfx * 2048 + c##sfx * 64 : NP + b##sfx * 8, Tv##sfx = prompt##sfx ? 64 : 8, pidx##sfx = prompt##sfx ? c##sfx * 64 : 2048;
    u32x4 rq[2], rk[2], rg;
#define P2A_LOAD(u_) do { P2A_UNIT(u_, L) (void)pidxL; int tid = tid0; LAUNDER(tid); \
    const int cq_ = (brL == 0 ? ZC_GQ : ZC_RQ) + hL * 128, ck_ = (brL == 0 ? ZC_GK : ZC_RK) + hL * 128; \
    _Pragma("unroll") for (int i = 0; i < 2; ++i) { const int ch = tid + 512 * i, t = ch >> 4, c8 = ch & 15; const int tt = t < TvL ? t : 0; \
        rq[i] = *(const u32x4*)(Z + (size_t)(rowcL + tt) * NZ + cq_ + c8 * 8); rk[i] = *(const u32x4*)(Z + (size_t)(rowcL + tt) * NZ + ck_ + c8 * 8); } \
    { const int t = (tid >> 2) & 63, c4 = tid & 3; const int tt = t < TvL ? t : 0; rg = *(const u32x4*)(GAL + (size_t)(rowcL + tt) * 16 + c4 * 4); } } while (0)
    if (vcu < 3072) P2A_LOAD(vcu);
    for (int u = vcu; u < 2048 + 1024; u += G) {
        P2A_UNIT(u, )
        { int tid = tid0; LAUNDER(tid);
#pragma unroll
          for (int i = 0; i < 2; ++i) { const int ch = tid + 512 * i, t = ch >> 4, c8 = ch & 15;
              *(LAS u32x4*)(lds + LA_RQ + t * 256 + c8 * 16) = mask4(rq[i], t, Tv); *(LAS u32x4*)(lds + LA_RK + t * 256 + c8 * 16) = mask4(rk[i], t, Tv); }
          if (tid < 256) *(LAS u32x4*)(lds + LA_GAL + tid * 16) = mask4(rg, tid >> 2, Tv); }
        asm volatile("" ::: "memory");
        { const int un = u + G < 3072 ? u + G : u; P2A_LOAD(un); }
        unsigned char* rec = prompt ? P.ws + WS_REC + (size_t)v * REC_BYTES : P.ws + WS_SREC + (size_t)v * SREC_BYTES;
        if (br == 0) prep_unit<0>(P, lds, h, rowc, Tv, pidx, rec, !prompt); else prep_unit<1>(P, lds, h, rowc, Tv, pidx, rec, !prompt);
        __syncthreads();
    }
#undef P2A_LOAD
#undef P2A_UNIT
}

constexpr int LC_P = 53760, LC_V = 62976, VQ_STR = 192, LC_RED = 75264, LC_END = LC_RED + 65536;
static_assert(LC_END <= MISC_OFF, "P2b LDS map");
__device__ __forceinline__ void chain_run(const Params& P, LAS unsigned char* lds, int vcu, int G, bool sample) {
    const int tid0 = threadIdx.x, w = __builtin_amdgcn_readfirstlane(tid0 >> 6), nt = w & 1, T = w >> 1;
    const bf16* Z = (const bf16*)(P.ws + WS_Z);
    bf16* MG = (bf16*)(P.ws + WS_MG);
    const int Tv = sample ? 8 : 64;
    const int nsteps = sample ? (4096 - vcu + G - 1) / G : (vcu < 256 ? 32 : 0);
    const int nchunks = sample ? SREC_CHUNKS : REC_CHUNKS;
    const bool probe = (P.pad & 0xff00) != 0;
#define STEP_UNIT(stp_, br_, b_, h_, qd_, rowc_, rec_) \
    const int uu_##stp_ = sample ? vcu + (stp_) * G : vcu; \
    const int qd_ = uu_##stp_ & 3, ch_##stp_ = uu_##stp_ >> 2, br_ = ch_##stp_ & 1, h_ = (ch_##stp_ >> 1) & 3, b_ = ch_##stp_ >> 3; \
    const int rowc_ = sample ? NP + b_ * 8 : b_ * 2048 + (stp_) * 64; \
    const unsigned char* rec_ = sample ? P.ws + WS_SREC + (size_t)ch_##stp_ * SREC_BYTES : P.ws + WS_REC + (size_t)(ch_##stp_ * 32 + ((P.pad & 0x100) ? 0 : (stp_))) * REC_BYTES;
    f32x16 S, Sn;
#pragma unroll
    for (int rg = 0; rg < 16; ++rg) { S[rg] = 0.f; Sn[rg] = 0.f; }
    u32x4 pr[7], pv;
    u32x2 ost[2];
    ost[0] = (u32x2){0u, 0u}; ost[1] = (u32x2){0u, 0u};
#define P2B_PREFETCH(stp_) do { STEP_UNIT(stp_, brp_, bp_, hp_, qdp_, rowp_, recp_) \
    int tid = tid0; LAUNDER(tid); \
    _Pragma("unroll") for (int i = 0; i < 7; ++i) { const int ch = tid + 512 * i; const int cl = ch < nchunks ? ch : nchunks - 1; pr[i] = *(const u32x4*)(recp_ + (size_t)cl * 16); } \
    { const int t = tid >> 3, c8 = tid & 7; const int tt = t < Tv ? t : 0; \
      pv = *(const u32x4*)(Z + (size_t)(rowp_ + tt) * NZ + (brp_ == 0 ? ZC_GV : ZC_RV) + hp_ * 256 + 64 * qdp_ + c8 * 8); } \
    if (sample) { const float* s0_ = (brp_ == 0 ? P.in[I_SG] : P.in[I_SR]); const int r32_ = tid & 31, hh_ = (tid >> 5) & 1; \
        _Pragma("unroll") for (int rg = 0; rg < 16; ++rg) Sn[rg] = s0_[((size_t)(bp_ * 4 + hp_) * 128 + 32 * T + crow(rg, hh_)) * 256 + 64 * qdp_ + 32 * nt + r32_]; } } while (0)
#define P2B_STORE_O(stp_) do { STEP_UNIT(stp_, brs_, bs_, hs_, qds_, rows_, recs_) (void)recs_; \
    int ln_ = tid0 & 63; LAUNDER(ln_); const int r32_ = ln_ & 31, hh_ = ln_ >> 5; const int t = 32 * (T >> 1) + r32_; \
    if (t < Tv) { bf16* orow = MG + (size_t)(rows_ + t) * 2048 + brs_ * 1024 + hs_ * 256 + 64 * qds_ + 32 * nt + 16 * (T & 1) + 4 * hh_; \
        *(u32x2*)(orow) = ost[0]; *(u32x2*)(orow + 8) = ost[1]; } } while (0)
    if (nsteps > 0) P2B_PREFETCH(0);
    for (int c = 0; c < nsteps; ++c) {
        STEP_UNIT(c, br, b, h, qd, rowc, rec) (void)rec; (void)rowc;
        if (sample) {
#pragma unroll
            for (int rg = 0; rg < 16; ++rg) S[rg] = Sn[rg]; }
        { int tid = tid0; LAUNDER(tid);
          if (!sample) {
#pragma unroll
              for (int i = 0; i < 7; ++i) { const int ch = tid + 512 * i; *(LAS u32x4*)(lds + ch * 16) = pr[i]; }
          } else if (tid < SREC_CHUNKS) {
              int dst;
              if (tid < 136) dst = L_QT + tid * 16; else if (tid < 272) dst = L_KT + (tid - 136) * 16; else if (tid < 400) dst = L_KHT + (tid - 272) * KHT_STR; else dst = L_EBL + (tid - 400) * 16;
              *(LAS u32x4*)(lds + dst) = pr[0];
          }
          { const int t = tid >> 3, c8 = tid & 7; *(LAS u32x4*)(lds + LC_V + t * VQ_STR + c8 * 16) = mask4(pv, t, Tv); } }
        asm volatile("" ::: "memory");
        { const int cn = c + 1 < nsteps ? c + 1 : c; P2B_PREFETCH(cn); }
        if (c > 0) { const int cp = c - 1; P2B_STORE_O(cp); }
        __syncthreads();
        int lane = tid0 & 63; LAUNDER(lane); const int r32 = lane & 31, hh = lane >> 5;
        if (!(P.pad & 0x1000)) {
            const int fr = lane & 15, fq = lane >> 4, tb = w >> 1;
#pragma unroll
            for (int j = 0; j < 2; ++j) { const int sb = 2 * (w & 1) + j;
                pg8::f32x4 acc = (pg8::f32x4){0.f, 0.f, 0.f, 0.f};
                if (sb <= tb) {
#pragma unroll
                    for (int ks = 0; ks < 4; ++ks) {
                        const bf16x8 kf = *(const LAS bf16x8*)(lds + L_KT + (16 * sb + fr) * QT_STR + (32 * ks + 8 * fq) * 2);
                        const bf16x8 qf = *(const LAS bf16x8*)(lds + L_QT + (16 * tb + fr) * QT_STR + (32 * ks + 8 * fq) * 2);
                        acc = __builtin_amdgcn_mfma_f32_16x16x32_bf16(kf, qf, acc, 0, 0, 0);
                    }
                }
                const int tg = 16 * tb + fr;
                float v[4];
#pragma unroll
                for (int e = 0; e < 4; ++e) { const int sg = 16 * sb + 4 * fq + e; v[e] = sg <= tg ? acc[e] : 0.f; }
                u32x2 o; o.x = pk2(v[0], v[1]); o.y = pk2(v[2], v[3]);
                *(LAS u32x2*)(lds + LC_P + tg * P_STR + (16 * sb + 4 * fq) * 2) = o;
            }
        }
        bf16x8 vf[4], qf[2][2], kf[4]; f32x4 eb[4];
        { const int g16 = (lane >> 4) & 1, i16 = lane & 15, q_ = i16 >> 2, p_ = i16 & 3;
          const LAS unsigned char* vb = lds + LC_V + (8 * hh + q_) * VQ_STR + (32 * nt + 16 * g16 + 4 * p_) * 2;
#pragma unroll
          for (int ks = 0; ks < 4; ++ks) vf[ks] = cat8(vtr(vb + (16 * ks) * VQ_STR), vtr(vb + (16 * ks + 4) * VQ_STR)); }
#pragma unroll
        for (int s = 0; s < 2; ++s)
#pragma unroll
            for (int mi = 0; mi < 2; ++mi) qf[s][mi] = *(const LAS bf16x8*)(lds + L_QT + (32 * mi + r32) * QT_STR + (32 * T + 16 * s + 8 * hh) * 2);
#pragma unroll
        for (int ks = 0; ks < 4; ++ks) kf[ks] = *(const LAS bf16x8*)(lds + L_KHT + (32 * T + r32) * KHT_STR + (16 * ks + 8 * hh) * 2);
#pragma unroll
        for (int g = 0; g < 4; ++g) eb[g] = *(const LAS f32x4*)(lds + L_EBL + (32 * T + 8 * g + 4 * hh) * 4);
        f32x16 OT[2];
#pragma unroll
        for (int mi = 0; mi < 2; ++mi) {
#pragma unroll
            for (int rg = 0; rg < 16; ++rg) OT[mi][rg] = 0.f; }
#pragma unroll
        for (int s = 0; s < 2; ++s) { const bf16x8 sa = pack8(S, s);
#pragma unroll
            for (int mi = 0; mi < 2; ++mi) OT[mi] = MFMA32(sa, qf[s][mi], OT[mi]); }
#pragma unroll
        for (int g = 0; g < 4; ++g) { S[4 * g] *= eb[g].x; S[4 * g + 1] *= eb[g].y; S[4 * g + 2] *= eb[g].z; S[4 * g + 3] *= eb[g].w; }
#pragma unroll
        for (int ks = 0; ks < 4; ++ks) S = MFMA32(kf[ks], vf[ks], S);
        __syncthreads();
        { const bf16x8 vT = T == 0 ? vf[0] : T == 1 ? vf[1] : T == 2 ? vf[2] : vf[3];
          const bf16x8 pf1 = *(const LAS bf16x8*)(lds + LC_P + (32 + r32) * P_STR + (16 * T + 8 * hh) * 2);
          OT[1] = MFMA32(vT, pf1, OT[1]);
          if (T < 2) { const bf16x8 pf0 = *(const LAS bf16x8*)(lds + LC_P + r32 * P_STR + (16 * T + 8 * hh) * 2); OT[0] = MFMA32(vT, pf0, OT[0]); } }
        if (!(P.pad & 0x800))
#pragma unroll
        for (int mi = 0; mi < 2; ++mi)
#pragma unroll
            for (int g = 0; g < 4; ++g) *(LAS f32x4*)(lds + LC_RED + ((((nt * 4 + T) * 2 + mi) * 4 + g) * 64 + lane) * 16) = (f32x4){OT[mi][4 * g], OT[mi][4 * g + 1], OT[mi][4 * g + 2], OT[mi][4 * g + 3]};
        __syncthreads();
        if (!(P.pad & 0x800)) { const int mir = T >> 1, g0 = 2 * (T & 1);
#pragma unroll
          for (int gg = 0; gg < 2; ++gg) { f32x4 a = (f32x4){0.f, 0.f, 0.f, 0.f};
#pragma unroll
              for (int Tp = 0; Tp < 4; ++Tp) a += *(const LAS f32x4*)(lds + LC_RED + ((((nt * 4 + Tp) * 2 + mir) * 4 + g0 + gg) * 64 + lane) * 16);
              ost[gg].x = pk2(a.x, a.y); ost[gg].y = pk2(a.z, a.w); } }
        if (sample) {
            float* so = (probe ? (float*)(P.ws + WS_Z) : P.out) + (br == 0 ? O_SGS : O_SRS);
#pragma unroll
            for (int rg = 0; rg < 16; ++rg) so[((size_t)(b * 4 + h) * 128 + 32 * T + crow(rg, hh)) * 256 + 64 * qd + 32 * nt + r32] = S[rg];
        }
    }
    if (nsteps > 0) {
        { const int cl = nsteps - 1; P2B_STORE_O(cl); }
        if (!sample) { STEP_UNIT(0, br, b, h, qd, rowc, rec) (void)rec; (void)rowc;
            int t0 = tid0; LAUNDER(t0); const int r32 = t0 & 31, hh = (t0 >> 5) & 1;
            float* so = (probe ? (float*)(P.ws + WS_Z) : P.out) + (br == 0 ? O_SGP : O_SRP);
#pragma unroll
            for (int rg = 0; rg < 16; ++rg) so[((size_t)(b * 4 + h) * 128 + 32 * T + crow(rg, hh)) * 256 + 64 * qd + 32 * nt + r32] = S[rg]; }
    }
#undef P2B_PREFETCH
#undef P2B_STORE_O
#undef STEP_UNIT
}
__device__ __forceinline__ void phase2b(const Params& P, LAS unsigned char* lds, int vcu, int G) {
    if (!(P.pad & 0x400)) chain_run(P, lds, vcu, G, false);
    __syncthreads();
    for (int i = threadIdx.x; i < L_IMG / 16; i += NTHR) *(LAS u32x4*)(lds + i * 16) = (u32x4){0u, 0u, 0u, 0u};
    __syncthreads();
    if (!(P.pad & 0x200)) chain_run(P, lds, vcu, G, true);
}

__device__ __forceinline__ void phase2c(const Params& P, int vcu, int G) {
    int tid = threadIdx.x; LAUNDER(tid);
    const int lane = tid & 63, wave = __builtin_amdgcn_readfirstlane(tid >> 6);
    const int gw = vcu * NWAVES + wave, NGW = G * NWAVES;
    const bf16* Z = (const bf16*)(P.ws + WS_Z); bf16* MG = (bf16*)(P.ws + WS_MG);
    for (int it = gw; it < 2 * NT; it += NGW) {
        const int row = it >> 1, br = it & 1;
        const int cg1 = (br == 0 ? ZC_GR : ZC_RG), cg2 = (br == 0 ? ZC_GA : ZC_GB);
        const float* ghead = P.in[br == 0 ? I_GGLA : I_GRET];
        bf16* mrow = MG + (size_t)row * 2048 + br * 1024 + 4 * lane;
        const bf16* zr = Z + (size_t)row * NZ + 4 * lane;
        u32x2 ov[4], g1[4], g2[4]; f32x4 gh[4];
#pragma unroll
        for (int h = 0; h < 4; ++h) { ov[h] = *(const u32x2*)(mrow + h * 256); g1[h] = *(const u32x2*)(zr + cg1 + h * 256); g2[h] = *(const u32x2*)(zr + cg2 + h * 256); gh[h] = *(const f32x4*)(ghead + h * 256 + 4 * lane); }
#pragma unroll
        for (int h = 0; h < 4; ++h) {
            float o[4] = {bflo(ov[h].x), bfhi(ov[h].x), bflo(ov[h].y), bfhi(ov[h].y)};
            float mu = 0.f;
            if (br == 1) mu = wave_sum((o[0] + o[1]) + (o[2] + o[3])) * (1.0f / 256.0f);
#pragma unroll
            for (int e = 0; e < 4; ++e) o[e] -= mu;
            const float q = wave_sum((o[0] * o[0] + o[1] * o[1]) + (o[2] * o[2] + o[3] * o[3]));
            const float rstd = __builtin_amdgcn_rsqf(q * (1.0f / 256.0f) + EPS);
            const float a[4] = {bflo(g1[h].x), bfhi(g1[h].x), bflo(g1[h].y), bfhi(g1[h].y)}, gt[4] = {bflo(g2[h].x), bfhi(g2[h].x), bflo(g2[h].y), bfhi(g2[h].y)};
            const float gg[4] = {gh[h].x, gh[h].y, gh[h].z, gh[h].w};
            float res[4];
#pragma unroll
            for (int e = 0; e < 4; ++e) res[e] = o[e] * rstd * gg[e] * a[e] * __builtin_amdgcn_rcpf((1.0f + __expf(-a[e])) * (1.0f + __expf(-gt[e])));
            u32x2 w; w.x = pk2(res[0], res[1]); w.y = pk2(res[2], res[3]);
            *(u32x2*)(mrow + h * 256) = w;
        }
    }
}

constexpr int A_K = 0, AK_STR = 272, A_V = 34816, AV_STR = 320, A_END = 34816 + 40960;
#define P6_STAGE(src_, mt_, ch_, lbase_, lstr_) do { \
    _Pragma("unroll") for (int i = 0; i < 4; ++i) { const int ch = tid + 512 * i, m = ch >> 4, c8 = ch & 15; \
        const size_t off = (((size_t)b * 256 + 128 * (mt_) + m) * 4 + h) * 256 + 128 * (ch_) + c8 * 8; \
        u32x4 v; \
        if (F32SRC) { const f32x4 a = *(const f32x4*)((const float*)(src_) + off), c = *(const f32x4*)((const float*)(src_) + off + 4); v.x = pk2(a.x, a.y); v.y = pk2(a.z, a.w); v.z = pk2(c.x, c.y); v.w = pk2(c.z, c.w); } \
        else v = *(const u32x4*)((const bf16*)(src_) + off); \
        *(LAS u32x4*)(lds + (lbase_) + m * (lstr_) + c8 * 16) = v; } } while (0)

template <bool F32SRC>
__device__ __forceinline__ void attn_unit(const Params& P, LAS unsigned char* lds, int b, int h, int row0, int nq, const void* Kp, const void* Vp) {
    int tid = threadIdx.x; asm volatile("" : "+v"(tid));
    const int lane = tid & 63, w = __builtin_amdgcn_readfirstlane(tid >> 6), r32 = lane & 31, hh = lane >> 5;
    const bf16* Q = (const bf16*)(P.ws + WS_Q); bf16* Oo = (bf16*)(P.ws + WS_O);
    const bool active = (32 * w) < nq;
    const int t = 32 * w + r32; const bool tok = t < nq;
    f32x16 sT[8];
#pragma unroll
    for (int i = 0; i < 8; ++i)
#pragma unroll
        for (int rg = 0; rg < 16; ++rg) sT[i][rg] = 0.f;
#pragma unroll
    for (int dh = 0; dh < 2; ++dh) {
        bf16x8 qf[8];
#pragma unroll
        for (int ks = 0; ks < 8; ++ks) qf[ks] = *(const bf16x8*)(Q + (size_t)(row0 + (tok ? t : 0)) * D + h * 256 + 128 * dh + 16 * ks + 8 * hh);
#pragma unroll
        for (int mt = 0; mt < 2; ++mt) {
            P6_STAGE(Kp, mt, dh, A_K, AK_STR);
            __syncthreads();
            if (active) {
#pragma unroll
                for (int mi = 0; mi < 4; ++mi)
#pragma unroll
                    for (int ks = 0; ks < 8; ++ks) { const bf16x8 kf = *(const LAS bf16x8*)(lds + A_K + (32 * mi + r32) * AK_STR + (16 * ks + 8 * hh) * 2);
                        sT[4 * mt + mi] = MFMA32(kf, qf[ks], sT[4 * mt + mi]); }
            }
            __syncthreads();
        }
    }
    float mx = -3.0e38f;
#pragma unroll
    for (int i = 0; i < 8; ++i)
#pragma unroll
        for (int rg = 0; rg < 16; ++rg) mx = fmaxf(mx, sT[i][rg]);
    mx = fmaxf(mx, __shfl_xor(mx, 32));
    const float c2 = 0.0625f * 1.4426950408889634f;
    float sum = 0.f;
    bf16x8 pf[8][2];
#pragma unroll
    for (int i = 0; i < 8; ++i) {
#pragma unroll
        for (int rg = 0; rg < 16; ++rg) { const float p = __builtin_amdgcn_exp2f((sT[i][rg] - mx) * c2); sT[i][rg] = p; sum += p; }
        pf[i][0] = pack8(sT[i], 0); pf[i][1] = pack8(sT[i], 1); }
    sum += __shfl_xor(sum, 32);
    const float rinv = 1.0f / sum;
    const int g16 = (lane >> 4) & 1, i16 = lane & 15, q_ = i16 >> 2, p_ = i16 & 3;
#pragma unroll
    for (int nh = 0; nh < 2; ++nh) {
        f32x16 oT[4];
#pragma unroll
        for (int i = 0; i < 4; ++i)
#pragma unroll
            for (int rg = 0; rg < 16; ++rg) oT[i][rg] = 0.f;
#pragma unroll
        for (int mt = 0; mt < 2; ++mt) {
            P6_STAGE(Vp, mt, nh, A_V, AV_STR);
            __syncthreads();
            if (active) {
#pragma unroll
                for (int mi = 0; mi < 4; ++mi)
#pragma unroll
                    for (int s = 0; s < 2; ++s) {
                        const bf16x8 pb = pf[4 * mt + mi][s];
#pragma unroll
                        for (int nt = 0; nt < 4; ++nt) {
                            const LAS unsigned char* vb = lds + A_V + (32 * mi + 16 * s + 4 * hh + q_) * AV_STR + (32 * nt + 16 * g16 + 4 * p_) * 2;
                            const bf16x8 va = cat8(vtr(vb), vtr(vb + 8 * AV_STR));
                            oT[nt] = MFMA32(va, pb, oT[nt]);
                        }
                    }
            }
            __syncthreads();
        }
        if (tok) {
            bf16* orow = Oo + (size_t)(row0 + t) * D + h * 256 + 128 * nh;
#pragma unroll
            for (int nt = 0; nt < 4; ++nt)
#pragma unroll
                for (int g = 0; g < 4; ++g) { u32x2 o; o.x = pk2(oT[nt][4 * g] * rinv, oT[nt][4 * g + 1] * rinv); o.y = pk2(oT[nt][4 * g + 2] * rinv, oT[nt][4 * g + 3] * rinv);
                    *(u32x2*)(orow + 32 * nt + 8 * g + 4 * hh) = o; }
        }
    }
}
__device__ __forceinline__ void phase6(const Params& P, LAS unsigned char* lds, int vcu, int G) {
    for (int u = vcu; u < 256 + 512; u += G) {
        if (u < 256) { const int qb = u & 7, h = (u >> 3) & 3, b = u >> 5; attn_unit<false>(P, lds, b, h, b * 2048 + qb * 256, 256, P.ws + WS_MKB, P.ws + WS_MVB); }
        else { const int v = u - 256, h = v & 3, b = v >> 2; attn_unit<true>(P, lds, b, h, NP + b * 8, 8, P.in[I_CK], P.in[I_CV]); }
    }
}

__global__ void __launch_bounds__(NTHR, 2) mega_fwd(Params P) {
    extern __shared__ __attribute__((aligned(16))) unsigned char lds_raw[];
    LAS unsigned char* lds = (LAS unsigned char*)lds_raw;
    cg::grid_group grid = cg::this_grid();
    if (threadIdx.x < 16) ((LAS unsigned*)(lds + MISC_OFF))[threadIdx.x] = 0u;
    __syncthreads();
    const XcdBarrier xbar = xcd_barrier_post((unsigned*)(P.ws + WS_CTL) + 1024, (volatile LAS unsigned*)(lds + MISC_OFF));
    const int G = gridDim.x; const int bx = blockIdx.x; const int vcu = (G % 8 == 0) ? (bx % 8) * (G / 8) + bx / 8 : bx;
    unsigned char* ws = P.ws;
    const int stop = P.stop_after;
    if (stop < 0) grid.sync();
#define SEAM(k) do { if (stop <= (k)) return; xcd_barrier(xbar); } while (0)
#ifndef NO_P0
    phase0(P, lds, vcu, G);
#endif
    SEAM(0);
    { pg8::Gemm g{(const bf16*)(ws + WS_H), (const bf16*)(ws + WS_WIN), NT, NZ, D}; pg8::StaticOrder S; S.init(NT, NZ, G, bx);
      pg8::EpiBf16<0> E{(bf16*)(ws + WS_Z), NZ};
      pg8::gemm_phase<pg8::EpiBf16<0>, pg8::StaticOrder, true, true>(lds, g, S, E); }
    { pg8::Gemm g{(const bf16*)(ws + WS_MB), (const bf16*)(ws + WS_WXKV), NMEM, 2 * D, D}; pg8::StaticOrder S; S.init(NMEM, 2 * D, G, (bx >= G / 2) ? bx - G / 2 : -1);
      pg8::EpiKV E{P.out + O_MK, P.out + O_MV, (bf16*)(ws + WS_MKB), (bf16*)(ws + WS_MVB)};
      pg8::gemm_phase<pg8::EpiKV, pg8::StaticOrder, true, true>(lds, g, S, E); }
    SEAM(1);
#ifndef NO_P2
    phase2a(P, lds, vcu, G);
    if (stop == 2 && (P.pad & 0xff) == 1) return;
    xcd_barrier(xbar);
    phase2b(P, lds, vcu, G);
    if (stop == 2 && (P.pad & 0xff) == 2) return;
    xcd_barrier(xbar);
    phase2c(P, vcu, G);
#endif
    SEAM(2);
    { pg8::Gemm g{(const bf16*)(ws + WS_MG), (const bf16*)(ws + WS_WMO), NP, D, 2 * D}; pg8::StaticOrder S; S.init(NP, D, G, bx);
      pg8::EpiF32 E{(float*)(ws + WS_T), D};
      pg8::gemm_phase<pg8::EpiF32, pg8::StaticOrder, true, true>(lds, g, S, E); }
    small_gemm(lds, (const bf16*)(ws + WS_MG) + (size_t)NP * 2 * D, (const bf16*)(ws + WS_WMO), 2 * D, D, vcu, G, SEpiF32{(float*)(ws + WS_T) + (size_t)NP * D, D});
    SEAM(3);
    row_phase(P.in[I_XP], P.in[I_XS], (const float*)(ws + WS_T), P.in[I_GQM], P.yout, P.in[I_GPX], (bf16*)(ws + WS_H), vcu, G);
    SEAM(4);
    { pg8::Gemm g{(const bf16*)(ws + WS_H), (const bf16*)(ws + WS_WXQ), NP, D, D}; pg8::StaticOrder S; S.init(NP, D, G, bx);
      pg8::EpiBf16<0> E{(bf16*)(ws + WS_Q), D};
      pg8::gemm_phase<pg8::EpiBf16<0>, pg8::StaticOrder, true, true>(lds, g, S, E); }
    small_gemm(lds, (const bf16*)(ws + WS_H) + (size_t)NP * D, (const bf16*)(ws + WS_WXQ), D, D, vcu, G, SEpiBf16{(bf16*)(ws + WS_Q) + (size_t)NP * D, D});
    SEAM(5);
#ifndef NO_P6
    phase6(P, lds, vcu, G);
#endif
    SEAM(6);
    { pg8::Gemm g{(const bf16*)(ws + WS_O), (const bf16*)(ws + WS_WXO), NP, D, D}; pg8::StaticOrder S; S.init(NP, D, G, bx);
      pg8::EpiF32 E{(float*)(ws + WS_T), D};
      pg8::gemm_phase<pg8::EpiF32, pg8::StaticOrder, true, true>(lds, g, S, E); }
    small_gemm(lds, (const bf16*)(ws + WS_O) + (size_t)NP * D, (const bf16*)(ws + WS_WXO), D, D, vcu, G, SEpiF32{(float*)(ws + WS_T) + (size_t)NP * D, D});
    SEAM(7);
    row_phase(P.yout, nullptr, (const float*)(ws + WS_T), P.in[I_GQX], P.yout, P.in[I_GPF], (bf16*)(ws + WS_H), vcu, G);
    SEAM(8);
    { pg8::Gemm g{(const bf16*)(ws + WS_H), (const bf16*)(ws + WS_WUP), NT, FF, D}; pg8::StaticOrder S; S.init(NT, FF, G, bx);
      pg8::EpiBf16<2> E{(bf16*)(ws + WS_U), FF};
      pg8::gemm_phase<pg8::EpiBf16<2>, pg8::StaticOrder, true, true>(lds, g, S, E); }
    SEAM(9);
    { pg8::Gemm g{(const bf16*)(ws + WS_U), (const bf16*)(ws + WS_WDN), NP, D, FF}; pg8::StaticOrder S; S.init(NP, D, G, bx);
      pg8::EpiF32 E{(float*)(ws + WS_T), D};
      pg8::gemm_phase<pg8::EpiF32, pg8::StaticOrder, true, true>(lds, g, S, E); }
    small_gemm(lds, (const bf16*)(ws + WS_U) + (size_t)NP * FF, (const bf16*)(ws + WS_WDN), FF, D, vcu, G, SEpiF32{(float*)(ws + WS_T) + (size_t)NP * D, D});
    SEAM(10);
    row_phase(P.yout, nullptr, (const float*)(ws + WS_T), P.in[I_GQF], P.yout, nullptr, nullptr, vcu, G);
#undef SEAM
}
}


#ifndef HYBRID
#define HYBRID 0
#endif
extern "C" void kernel_launch(void* const* d_in, const int* in_sizes, int n_in, void* d_out, int out_size, void* d_ws, size_t ws_size, hipStream_t stream) {
    static int grid = 0;
    if (grid == 0) {
        if (n_in != 26 || out_size != (int)mk::O_END || ws_size < mk::WS_END) { fprintf(stderr, "kernel_launch: unexpected sizes n_in %d out %d ws %zu\n", n_in, out_size, ws_size); grid = -1; return; }
        int dev = 0, cus = 0, per_cu = 0;
        if (hipGetDevice(&dev) != hipSuccess || hipDeviceGetAttribute(&cus, hipDeviceAttributeMultiprocessorCount, dev) != hipSuccess) { grid = -1; return; }
        if (hipFuncSetAttribute((const void*)mk::mega_fwd, hipFuncAttributeMaxDynamicSharedMemorySize, mk::LDS_BYTES) != hipSuccess) { fprintf(stderr, "kernel_launch: hipFuncSetAttribute failed\n"); grid = -1; return; }
        if (hipOccupancyMaxActiveBlocksPerMultiprocessor(&per_cu, (const void*)mk::mega_fwd, mk::NTHR, mk::LDS_BYTES) != hipSuccess || per_cu < 1) { fprintf(stderr, "kernel_launch: occupancy query says %d\n", per_cu); grid = -1; (void)hipGetLastError(); return; }
        grid = cus;
    }
    if (grid < 0) return;
    if (hipMemsetAsync((char*)d_ws + mk::WS_CTL, 0, 65536, stream) != hipSuccess) { fprintf(stderr, "kernel_launch: memset failed\n"); return; }
    mk::Params p{};
    for (int i = 0; i < 26; ++i) p.in[i] = (const float*)d_in[i];
    p.out = (float*)d_out; p.ws = (unsigned char*)d_ws; p.yout = (float*)d_out + mk::O_YP; p.stop_after = 100; p.pad = 0;
    void* args[] = {&p};
    hipError_t e = hipLaunchCooperativeKernel((const void*)mk::mega_fwd, dim3(grid), dim3(mk::NTHR), args, mk::LDS_BYTES, stream);
    if (e != hipSuccess) fprintf(stderr, "cooperative launch failed: %s (grid %d)\n", hipGetErrorString(e), grid);
#ifdef PROBE_STOP
    if (hipMemsetAsync((char*)d_ws + mk::WS_CTL, 0, 65536, stream) != hipSuccess) return;
    mk::Params p2 = p; p2.stop_after = PROBE_STOP;
#ifdef PROBE_SUB
    p2.pad = PROBE_SUB;
#endif
#ifdef PROBE_FLAGS
    p2.pad |= PROBE_FLAGS;
#endif p2.yout = (float*)((unsigned char*)d_ws + mk::WS_MG);
    void* args2[] = {&p2};
    e = hipLaunchCooperativeKernel((const void*)mk::mega_fwd, dim3(grid), dim3(mk::NTHR), args2, mk::LDS_BYTES, stream);
    if (e != hipSuccess) fprintf(stderr, "cooperative launch 2 failed: %s\n", hipGetErrorString(e));
#endif
}
```

```cpp
#include <hip/hip_runtime.h>
#include <cstdio>
#include <cstdint>

namespace pg8 {
#define PG8_LAS __attribute__((address_space(3)))
typedef unsigned short bf16_t;
typedef short bf16x8 __attribute__((ext_vector_type(8)));
typedef float f32x4 __attribute__((ext_vector_type(4)));
typedef unsigned u32x4 __attribute__((ext_vector_type(4)));
typedef unsigned u32x2 __attribute__((ext_vector_type(2)));
constexpr int BM = 256, BK = 64, HALF = 128, HTB = HALF * BK * 2  , STAGE_BYTES = 8 * HTB, NXCD = 8, WGM = 8;

__host__ __device__ __forceinline__ int lds_byte(int r, int c) { const int st = (r >> 4) * 2 + (c >> 5), rr = r & 15, cc = c & 31, ob = rr * 64 + cc * 2; return st * 1024 + (ob ^ (((ob >> 9) & 1) << 5)); }
__host__ __device__ __forceinline__ void stage_rc(int b, int& R, int& C) { const int st = b / 1024, sb = b % 1024, swz = sb ^ (((sb >> 9) & 1) << 5); R = (st >> 1) * 16 + swz / 64; C = (st & 1) * 32 + (swz % 64) / 2; }
__host__ __device__ __forceinline__ int perm32(int rho) { const int n = rho >> 4, i = rho & 15; return 8 * (i >> 2) + 4 * n + (i & 3); }

struct Unit { int pm, pn; };
struct Gemm { const bf16_t* A; const bf16_t* Bt; int M, N, K; };

struct StaticOrder {
    int nM, nN, nwg, G, c;
    __host__ __device__ void init(int M, int N, int G_, int c_) { nM = M / BM; nN = N / BM; nwg = nM * nN; G = G_; c = c_; }
    __host__ __device__ bool next(int i, Unit& u) const {
        if (c < 0) return false;
        const long L = (long)i * G + c; if (L >= nwg) return false;
        int wgid = (int)L; { const int q = nwg / NXCD, r = nwg % NXCD, xcd = wgid % NXCD, off = wgid / NXCD; wgid = (xcd < r ? xcd * (q + 1) : r * (q + 1) + (xcd - r) * q) + off; }
        const int nig = WGM * nN, gid = wgid / nig, fm = gid * WGM, gsz = (nM - fm) < WGM ? (nM - fm) : WGM;
        u.pm = fm + ((wgid % nig) % gsz); u.pn = (wgid % nig) / gsz; return true;
    }
    __device__ __forceinline__ void a_ready(const Unit&) const {}
    __device__ __forceinline__ void done(const Unit&) const {}
};

typedef float f32x2_t __attribute__((ext_vector_type(2))); typedef __bf16 bf16x2_t __attribute__((ext_vector_type(2)));
__device__ __forceinline__ unsigned cvt_pk_bf16(float lo, float hi) { f32x2_t v = {lo, hi}; bf16x2_t b = __builtin_convertvector(v, bf16x2_t); return __builtin_bit_cast(unsigned, b); }

template <int ACT  > struct EpiBf16 {
    static constexpr bool PERM = true, AFTER_DRAIN = false;
    bf16_t* O; int ldc;
    __device__ __forceinline__ void operator()(const f32x4 (&acc)[2][2][4][2], const Unit& u, int wr, int wc, int fr, int fq) const {
        const int row0 = u.pm * BM + wr * 64 + fr; const int col0 = u.pn * BM + wc * 32 + 8 * fq;
#pragma unroll
        for (int ai = 0; ai < 2; ++ai)
#pragma unroll
            for (int m = 0; m < 4; ++m) { bf16_t* rowp = O + (size_t)(row0 + ai * HALF + m * 16) * ldc + col0;
#pragma unroll
                for (int bj = 0; bj < 2; ++bj) { f32x4 v0 = acc[ai][bj][m][0], v1 = acc[ai][bj][m][1];
                    if (ACT == 2) {
#pragma unroll
                        for (int e = 0; e < 4; ++e) { const float a = v0[e] > 0.f ? v0[e] : 0.f, b = v1[e] > 0.f ? v1[e] : 0.f; v0[e] = a * a; v1[e] = b * b; } }
                    u32x4 w; w.x = cvt_pk_bf16(v0[0], v0[1]); w.y = cvt_pk_bf16(v0[2], v0[3]); w.z = cvt_pk_bf16(v1[0], v1[1]); w.w = cvt_pk_bf16(v1[2], v1[3]);
                    *(u32x4*)(rowp + bj * HALF) = w; } }
    }
};
struct EpiF32 {
    static constexpr bool PERM = false, AFTER_DRAIN = false;
    float* O; int ldc;
    __device__ __forceinline__ void operator()(const f32x4 (&acc)[2][2][4][2], const Unit& u, int wr, int wc, int fr, int fq) const {
        const int row0 = u.pm * BM + wr * 64 + fr; const int col0 = u.pn * BM + wc * 32 + 4 * fq;
#pragma unroll
        for (int ai = 0; ai < 2; ++ai)
#pragma unroll
            for (int m = 0; m < 4; ++m) { float* rowp = O + (size_t)(row0 + ai * HALF + m * 16) * ldc + col0;
#pragma unroll
                for (int bj = 0; bj < 2; ++bj)
#pragma unroll
                    for (int n = 0; n < 2; ++n) *(f32x4*)(rowp + bj * HALF + n * 16) = acc[ai][bj][m][n]; }
    }
};
struct EpiKV {
    static constexpr bool PERM = false, AFTER_DRAIN = false;
    float* OK; float* OV; bf16_t* BK_; bf16_t* BV_;
    __device__ __forceinline__ void operator()(const f32x4 (&acc)[2][2][4][2], const Unit& u, int wr, int wc, int fr, int fq) const {
        const int row0 = u.pm * BM + wr * 64 + fr; const bool isv = u.pn >= 4; const int col0 = (u.pn & 3) * BM + wc * 32 + 4 * fq;
        float* Of = isv ? OV : OK; bf16_t* Ob = isv ? BV_ : BK_;
#pragma unroll
        for (int ai = 0; ai < 2; ++ai)
#pragma unroll
            for (int m = 0; m < 4; ++m) { const size_t ro = (size_t)(row0 + ai * HALF + m * 16) * 1024 + col0;
#pragma unroll
                for (int bj = 0; bj < 2; ++bj)
#pragma unroll
                    for (int n = 0; n < 2; ++n) { const f32x4 v = acc[ai][bj][m][n]; *(f32x4*)(Of + ro + bj * HALF + n * 16) = v;
                        u32x2 w; w.x = cvt_pk_bf16(v[0], v[1]); w.y = cvt_pk_bf16(v[2], v[3]); *(u32x2*)(Ob + ro + bj * HALF + n * 16) = w; } }
    }
};

template <class Epi, class Sched, bool ALIGN_EPI = false, bool SP2 = false>
__device__ __forceinline__ void gemm_phase(PG8_LAS unsigned char* lds, const Gemm g, const Sched& S, const Epi& E) {
    int tid = threadIdx.x; asm volatile("" : "+v"(tid));
    const int wid = __builtin_amdgcn_readfirstlane(tid >> 6), lane = tid & 63, wr = wid >> 2, wc = wid & 3, fr = lane & 15, fq = lane >> 4;
    const int K = g.K, nt = K / BK;
    unsigned voffA[2], voffB[2];
#pragma unroll
    for (int i = 0; i < 2; ++i) { int R, C; stage_rc(tid * 16 + i * 8192, R, C); const int Rb = Epi::PERM ? ((R & ~31) + perm32(R & 31)) : R;
        voffA[i] = (unsigned)(R * K + C) * 2u; voffB[i] = (unsigned)(Rb * K + C) * 2u; }
    const size_t kstep = (size_t)(BK * 2);
    const size_t hstep = (size_t)HALF * K * 2;
    const size_t tstep = 2 * hstep;
    const unsigned ldsw = (unsigned)wid * 1024u;
    const int aoff = lds_byte(wr * 64 + fr, fq * 8), boff = lds_byte(wc * 32 + fr, fq * 8);
#define PG8_SA(b, h) (((b) * 2 + (h)) * HTB)
#define PG8_SB(b, h) ((4 + (b) * 2 + (h)) * HTB)
#define PG8_STAGE(bufoff, gbase, voff) do { _Pragma("unroll") for (int _i = 0; _i < 2; ++_i) \
        __builtin_amdgcn_global_load_lds((const unsigned*)((const char*)(gbase) + (voff)[_i]), (PG8_LAS unsigned*)(lds + (bufoff) + ldsw + _i * 8192), 16, 0, 0); } while (0)
#define PG8_LDA(dst, b, h) do { _Pragma("unroll") for (int m = 0; m < 4; ++m) _Pragma("unroll") for (int k = 0; k < 2; ++k) dst[m][k] = *(const PG8_LAS bf16x8*)(lds + PG8_SA(b, h) + aoff + m * 2048 + k * 1024); } while (0)
#define PG8_LDB(dst, b, h) do { _Pragma("unroll") for (int n = 0; n < 2; ++n) _Pragma("unroll") for (int k = 0; k < 2; ++k) dst[n][k] = *(const PG8_LAS bf16x8*)(lds + PG8_SB(b, h) + boff + n * 2048 + k * 1024); } while (0)
#define PG8_MMA(ai, bj, At, Bt) do { __builtin_amdgcn_s_setprio(1); _Pragma("unroll") for (int m = 0; m < 4; ++m) _Pragma("unroll") for (int n = 0; n < 2; ++n) _Pragma("unroll") for (int k = 0; k < 2; ++k) \
        acc[ai][bj][m][n] = __builtin_amdgcn_mfma_f32_16x16x32_bf16(Bt[n][k], At[m][k], acc[ai][bj][m][n], 0, 0, 0); __builtin_amdgcn_s_setprio(0); } while (0)
#define PG8_WAIT_V(n) asm volatile("s_waitcnt vmcnt(" #n ")" ::: "memory")
#define PG8_WAIT_L(n) asm volatile("s_waitcnt lgkmcnt(" #n ")" ::: "memory")
#define PG8_BAR __builtin_amdgcn_s_barrier()
#define PG8_SCHED __builtin_amdgcn_sched_barrier(0)
    Unit cur, nxt; int ui = 0;
    if (!S.next(0, cur)) return;
    f32x4 acc[2][2][4][2];
#pragma unroll
    for (int a = 0; a < 2; ++a)
#pragma unroll
        for (int b = 0; b < 2; ++b)
#pragma unroll
            for (int m = 0; m < 4; ++m)
#pragma unroll
                for (int n = 0; n < 2; ++n) acc[a][b][m][n] = (f32x4){0.f, 0.f, 0.f, 0.f};
    bf16x8 At[4][2], B0[2][2], B1[2][2];
    const char* cA = (const char*)g.A + (size_t)cur.pm * tstep; const char* cB = (const char*)g.Bt + (size_t)cur.pn * tstep;
    S.a_ready(cur);
    if constexpr (SP2) {
        PG8_STAGE(PG8_SB(0, 0), cB, voffB); PG8_STAGE(PG8_SB(0, 1), cB + hstep, voffB); PG8_STAGE(PG8_SA(0, 0), cA, voffA); PG8_STAGE(PG8_SA(0, 1), cA + hstep, voffA);
        if (wr == 1) PG8_BAR;
        PG8_WAIT_V(2); PG8_BAR;
        PG8_STAGE(PG8_SB(1, 0), cB + kstep, voffB); PG8_STAGE(PG8_SA(1, 0), cA + kstep, voffA); PG8_STAGE(PG8_SB(1, 1), cB + hstep + kstep, voffB);
        PG8_WAIT_V(6); PG8_BAR;
    } else {
        PG8_STAGE(PG8_SB(0, 0), cB, voffB); PG8_STAGE(PG8_SA(0, 0), cA, voffA); PG8_STAGE(PG8_SB(0, 1), cB + hstep, voffB); PG8_STAGE(PG8_SA(0, 1), cA + hstep, voffA);
        if (wr == 1) PG8_BAR;
        PG8_WAIT_V(4); PG8_BAR;
        PG8_STAGE(PG8_SB(1, 0), cB + kstep, voffB); PG8_STAGE(PG8_SA(1, 0), cA + kstep, voffA); PG8_STAGE(PG8_SB(1, 1), cB + hstep + kstep, voffB);
        PG8_WAIT_V(6); PG8_BAR;
    }
    for (;;) {
        const bool has_next = S.next(ui + 1, nxt);
        const char* nA = has_next ? (const char*)g.A + (size_t)nxt.pm * tstep : cA; const char* nB = has_next ? (const char*)g.Bt + (size_t)nxt.pn * tstep : cB;
        for (int t = 0; t < nt; t += 2) {
            const bool last = (t == nt - 2);
            const char* a1 = cA + (size_t)(t + 1) * kstep;
            const char* a2 = last ? nA : cA + (size_t)(t + 2) * kstep; const char* b2 = last ? nB : cB + (size_t)(t + 2) * kstep;
            const char* a3 = a2 + kstep; const char* b3 = b2 + kstep;
            if (last && has_next) S.a_ready(nxt);
            if constexpr (SP2) {
            PG8_LDB(B0, 0, 0); PG8_LDB(B1, 0, 1); PG8_SCHED; PG8_LDA(At, 0, 0); PG8_STAGE(PG8_SA(1, 1), a1 + hstep, voffA);
            PG8_WAIT_V(8); PG8_WAIT_L(0); PG8_BAR; PG8_MMA(0, 0, At, B0); PG8_MMA(0, 1, At, B1); PG8_BAR; PG8_SCHED;
            PG8_LDA(At, 0, 1); PG8_STAGE(PG8_SB(0, 0), b2, voffB); PG8_STAGE(PG8_SB(0, 1), b2 + hstep, voffB); PG8_STAGE(PG8_SA(0, 0), a2, voffA);
            PG8_WAIT_V(8); PG8_WAIT_L(0); PG8_BAR; PG8_MMA(1, 0, At, B0); PG8_MMA(1, 1, At, B1); PG8_BAR; PG8_SCHED;
            PG8_LDB(B0, 1, 0); PG8_LDB(B1, 1, 1); PG8_SCHED; PG8_LDA(At, 1, 0); PG8_STAGE(PG8_SA(0, 1), a2 + hstep, voffA);
            PG8_WAIT_V(8); PG8_WAIT_L(0); PG8_BAR; PG8_MMA(0, 0, At, B0); PG8_MMA(0, 1, At, B1); PG8_BAR; PG8_SCHED;
            PG8_LDA(At, 1, 1); PG8_STAGE(PG8_SB(1, 0), b3, voffB); PG8_STAGE(PG8_SB(1, 1), b3 + hstep, voffB); PG8_STAGE(PG8_SA(1, 0), a3, voffA);
            PG8_WAIT_V(8); PG8_WAIT_L(0); PG8_BAR; PG8_MMA(1, 0, At, B0); PG8_MMA(1, 1, At, B1); PG8_BAR; PG8_SCHED;
            } else {
            PG8_LDB(B0, 0, 0); PG8_SCHED; PG8_LDA(At, 0, 0); PG8_STAGE(PG8_SA(1, 1), a1 + hstep, voffA);
            PG8_WAIT_L(8); PG8_BAR; PG8_WAIT_L(0); PG8_MMA(0, 0, At, B0); PG8_BAR; PG8_SCHED;
            PG8_LDB(B1, 0, 1); PG8_STAGE(PG8_SB(0, 0), b2, voffB);
            PG8_BAR; PG8_WAIT_L(0); PG8_MMA(0, 1, At, B1); PG8_BAR;
            PG8_LDA(At, 0, 1); PG8_STAGE(PG8_SA(0, 0), a2, voffA);
            PG8_BAR; PG8_WAIT_L(0); PG8_MMA(1, 0, At, B0); PG8_BAR; PG8_SCHED;
            PG8_STAGE(PG8_SB(0, 1), b2 + hstep, voffB);
            PG8_WAIT_V(6); PG8_BAR; PG8_MMA(1, 1, At, B1); PG8_BAR;
            PG8_LDB(B0, 1, 0); PG8_SCHED; PG8_LDA(At, 1, 0); PG8_STAGE(PG8_SA(0, 1), a2 + hstep, voffA);
            PG8_WAIT_L(8); PG8_BAR; PG8_WAIT_L(0); PG8_MMA(0, 0, At, B0); PG8_BAR; PG8_SCHED;
            PG8_LDB(B1, 1, 1); PG8_STAGE(PG8_SB(1, 0), b3, voffB);
            PG8_BAR; PG8_WAIT_L(0); PG8_MMA(0, 1, At, B1); PG8_BAR;
            PG8_LDA(At, 1, 1); PG8_STAGE(PG8_SA(1, 0), a3, voffA);
            PG8_BAR; PG8_WAIT_L(0); PG8_MMA(1, 0, At, B0); PG8_BAR; PG8_SCHED;
            PG8_STAGE(PG8_SB(1, 1), b3 + hstep, voffB);
            PG8_WAIT_V(6); PG8_BAR; PG8_MMA(1, 1, At, B1); PG8_BAR;
            }
        }
        if constexpr (ALIGN_EPI) { if (wr == 0) PG8_BAR; }
        if constexpr (!Epi::AFTER_DRAIN) { E(acc, cur, wr, wc, fr, fq); S.done(cur); }
        if (!has_next) break;
#pragma unroll
        for (int a = 0; a < 2; ++a)
#pragma unroll
            for (int b = 0; b < 2; ++b)
#pragma unroll
                for (int m = 0; m < 4; ++m)
#pragma unroll
                    for (int n = 0; n < 2; ++n) acc[a][b][m][n] = (f32x4){0.f, 0.f, 0.f, 0.f};
        cur = nxt; cA = nA; cB = nB; ++ui;
        if constexpr (ALIGN_EPI) { if (wr == 1) PG8_BAR; }
    }
    PG8_WAIT_V(0);
    if constexpr (!ALIGN_EPI) { if (wr == 0) PG8_BAR; }
    PG8_BAR;
#undef PG8_SA
#undef PG8_SB
#undef PG8_STAGE
#undef PG8_LDA
#undef PG8_LDB
#undef PG8_MMA
#undef PG8_WAIT_V
#undef PG8_WAIT_L
#undef PG8_BAR
#undef PG8_SCHED
}
}

#include <hip/hip_cooperative_groups.h>
namespace mk {
namespace cg = cooperative_groups;
#define LAS __attribute__((address_space(3)))
#define GAS __attribute__((address_space(1)))
typedef unsigned short bf16;
typedef float f32x4 __attribute__((ext_vector_type(4)));
typedef float f32x16 __attribute__((ext_vector_type(16)));
typedef unsigned u32x4 __attribute__((ext_vector_type(4)));
typedef unsigned u32x2 __attribute__((ext_vector_type(2)));
typedef short bf16x8 __attribute__((ext_vector_type(8)));
typedef short s16x4 __attribute__((ext_vector_type(4)));
typedef short v4i16_t __attribute__((ext_vector_type(4)));

constexpr int NWAVES = 8, NTHR = 512;
constexpr int D = 1024, NP = 16384, NS = 1024, NT = NP + NS, NIN = 8208, NZ = 8192, FF = 4096, NMEM = 2048;
constexpr size_t O_YP = 0, O_YS = 16777216, O_SGP = 17825792, O_SRP = 18874368, O_MK = 19922944, O_MV = 22020096, O_SGS = 24117248, O_SRS = 40894464, O_END = 57671680;
constexpr int ZC_GQ = 0, ZC_GK = 512, ZC_GV = 1024, ZC_GR = 2048, ZC_RQ = 3072, ZC_RK = 3584, ZC_RV = 4096, ZC_RG = 5120, ZC_GA = 6144, ZC_GB = 7168;
constexpr size_t MiB = 1u << 20;
constexpr size_t WS_CTL = 0, WS_WIN = 1 * MiB, WS_WMO = 17 * MiB, WS_WXQ = 21 * MiB, WS_WXKV = 23 * MiB, WS_WXO = 27 * MiB, WS_WUP = 29 * MiB, WS_WDN = 37 * MiB, WS_ROPE = 45 * MiB, WS_GAL = 47 * MiB,
                 WS_MB = 49 * MiB, WS_MKB = 53 * MiB, WS_MVB = 57 * MiB, WS_H = 61 * MiB, WS_Z = 95 * MiB, WS_Q = WS_Z, WS_O = WS_Z + 34 * MiB, WS_U = WS_Z + 68 * MiB, WS_MG = 367 * MiB, WS_T = 435 * MiB, WS_END = 540 * MiB;
constexpr int LDS_BYTES = 147456, MISC_OFF = LDS_BYTES - 64;
constexpr float EPS = 1e-6f;

__device__ __forceinline__ unsigned pk2(float lo, float hi) { return pg8::cvt_pk_bf16(lo, hi); }
__device__ __forceinline__ float bf2f(unsigned short u) { return __uint_as_float((unsigned)u << 16); }
__device__ __forceinline__ float bflo(unsigned w) { return __uint_as_float(w << 16); }
__device__ __forceinline__ float bfhi(unsigned w) { return __uint_as_float(w & 0xffff0000u); }
__device__ __forceinline__ unsigned short f2bf(float f) { return (unsigned short)(pk2(f, 0.f) & 0xffffu); }
__device__ __forceinline__ float wave_sum(float v) {
#pragma unroll
    for (int o = 1; o < 64; o <<= 1) v += __shfl_xor(v, o);
    return v;
}
#define MFMA32(a, b, c) __builtin_amdgcn_mfma_f32_32x32x16_bf16((a), (b), (c), 0, 0, 0)
__device__ __forceinline__ int crow(int reg, int h) { return (reg & 3) + 8 * (reg >> 2) + 4 * h; }
__device__ __forceinline__ bf16x8 pack8(const f32x16& x, int s) {
    u32x4 p; p.x = pk2(x[8 * s + 0], x[8 * s + 1]); p.y = pk2(x[8 * s + 2], x[8 * s + 3]); p.z = pk2(x[8 * s + 4], x[8 * s + 5]); p.w = pk2(x[8 * s + 6], x[8 * s + 7]);
    return __builtin_bit_cast(bf16x8, p);
}
__device__ __forceinline__ s16x4 vtr(const LAS unsigned char* p) { return __builtin_bit_cast(s16x4, __builtin_amdgcn_ds_read_tr16_b64_v4i16((LAS v4i16_t*)p)); }
__device__ __forceinline__ bf16x8 cat8(s16x4 lo, s16x4 hi) { return __builtin_shufflevector(lo, hi, 0, 1, 2, 3, 4, 5, 6, 7); }

struct Params {
    const float* in[26];
    float* out; unsigned char* ws; float* yout;
    int stop_after;
    int pad;
};
enum { I_XP = 0, I_XS, I_SG, I_SR, I_CK, I_CV, I_MEM, I_WIN, I_WA2, I_BA, I_GGLA, I_GRET, I_WMO, I_WXQ, I_WXK, I_WXV, I_WXO, I_GMEM, I_WUP, I_WDN, I_GPM, I_GQM, I_GPX, I_GQX, I_GPF, I_GQF };

__device__ __forceinline__ void transpose_item(const float* W, int ldw, int col_off, int N, bf16* WT, int ldt, int row_off, int kcol_off, LAS float* scr, int item, int lane) {
    const int nblk = N / 64, kb = item / nblk, nb = item % nblk, k0 = 32 * kb, n0 = 64 * nb;
    const int lr = lane >> 4, lc = (lane & 15) * 4;
    f32x4 v[8];
#pragma unroll
    for (int i = 0; i < 8; ++i) v[i] = *(const f32x4*)(W + (size_t)(k0 + 4 * i + lr) * ldw + col_off + n0 + lc);
#pragma unroll
    for (int i = 0; i < 8; ++i) { LAS float* d = scr + (4 * i + lr) * 65 + lc; d[0] = v[i].x; d[1] = v[i].y; d[2] = v[i].z; d[3] = v[i].w; }
    asm volatile("s_waitcnt lgkmcnt(0)" ::: "memory");
    unsigned o[16];
#pragma unroll
    for (int j = 0; j < 16; ++j) o[j] = pk2(scr[(2 * j) * 65 + lane], scr[(2 * j + 1) * 65 + lane]);
    bf16* dst = WT + (size_t)(row_off + n0 + lane) * ldt + kcol_off + k0;
#pragma unroll
    for (int j = 0; j < 4; ++j) *(u32x4*)(dst + 8 * j) = (u32x4){o[4 * j], o[4 * j + 1], o[4 * j + 2], o[4 * j + 3]};
    asm volatile("s_waitcnt lgkmcnt(0)" ::: "memory");
}

template <bool GA>
__device__ __forceinline__ void rms_row_bf16(const float* xrow, const float* g, bf16* orow, const LAS float* wga, float* garow, int lane) {
    f32x4 v[4]; float s = 0.f;
#pragma unroll
    for (int j = 0; j < 4; ++j) { v[j] = ((const f32x4*)xrow)[lane + 64 * j]; s += (v[j].x * v[j].x + v[j].y * v[j].y) + (v[j].z * v[j].z + v[j].w * v[j].w); }
    const float rs = 1.0f / sqrtf(wave_sum(s) * (1.f / D) + EPS);
#pragma unroll
    for (int j = 0; j < 4; ++j) { const f32x4 gg = ((const f32x4*)g)[lane + 64 * j]; v[j] = v[j] * rs * gg; }
#pragma unroll
    for (int j = 0; j < 4; ++j) { u32x2 w; w.x = pk2(v[j].x, v[j].y); w.y = pk2(v[j].z, v[j].w); ((u32x2*)orow)[lane + 64 * j] = w; }
    if (GA) {
        float mine = 0.f;
#pragma unroll
        for (int r = 0; r < 16; ++r) {
            float a = 0.f;
#pragma unroll
            for (int j = 0; j < 4; ++j) { const f32x4 w = ((const LAS f32x4*)(wga + r * 1024))[lane + 64 * j]; a += (v[j].x * w.x + v[j].y * w.y) + (v[j].z * w.z + v[j].w * w.w); }
            a = wave_sum(a);
            if (lane == r) mine = a;
        }
        if (lane < 16) garow[lane] = mine;
    }
}

__device__ __forceinline__ void phase0(const Params& P, LAS unsigned char* lds, int vcu, int G) {
    int tid = threadIdx.x; asm volatile("" : "+v"(tid));
    const int lane = tid & 63, wave = __builtin_amdgcn_readfirstlane(tid >> 6);
    unsigned char* ws = P.ws;
    LAS float* wga = (LAS float*)lds;
    LAS float* scr = (LAS float*)(lds + 65536 + wave * 8704);
    { const float* W = P.in[I_WIN];
      for (int k = tid; k < 1024; k += NTHR) {
#pragma unroll
          for (int q = 0; q < 4; ++q) { const f32x4 w = *(const f32x4*)(W + (size_t)k * NIN + 3072 + 4 * q); wga[(4 * q + 0) * 1024 + k] = w.x; wga[(4 * q + 1) * 1024 + k] = w.y; wga[(4 * q + 2) * 1024 + k] = w.z; wga[(4 * q + 3) * 1024 + k] = w.w; } } }
    const int gw = vcu * NWAVES + wave, NGW = G * NWAVES;
    constexpr int I_IN = (D / 32) * (NZ / 64), I_SQ = (D / 32) * (D / 64), I_UP = (D / 32) * (FF / 64), I_DN = (FF / 32) * (D / 64);
    constexpr int NITEMS = I_IN + 5 * I_SQ + I_UP + I_DN;
    for (int it = gw; it < NITEMS; it += NGW) {
        int r = it;
        if (r < I_IN) { const int nb = r % (NZ / 64); const int coff = (nb * 64 >= 3072) ? 16 : 0;
            transpose_item(P.in[I_WIN], NIN, coff, NZ, (bf16*)(ws + WS_WIN), D, 0, 0, scr, r, lane); continue; } r -= I_IN;
        if (r < I_SQ) { transpose_item(P.in[I_WMO], D, 0, D, (bf16*)(ws + WS_WMO), D, 0, 0, scr, r, lane); continue; } r -= I_SQ;
        if (r < I_SQ) { transpose_item(P.in[I_WXQ], D, 0, D, (bf16*)(ws + WS_WXQ), D, 0, 0, scr, r, lane); continue; } r -= I_SQ;
        if (r < I_SQ) { transpose_item(P.in[I_WXK], D, 0, D, (bf16*)(ws + WS_WXKV), D, 0, 0, scr, r, lane); continue; } r -= I_SQ;
        if (r < I_SQ) { transpose_item(P.in[I_WXV], D, 0, D, (bf16*)(ws + WS_WXKV), D, D, 0, scr, r, lane); continue; } r -= I_SQ;
        if (r < I_SQ) { transpose_item(P.in[I_WXO], D, 0, D, (bf16*)(ws + WS_WXO), D, 0, 0, scr, r, lane); continue; } r -= I_SQ;
        if (r < I_UP) { transpose_item(P.in[I_WUP], FF, 0, FF, (bf16*)(ws + WS_WUP), D, 0, 0, scr, r, lane); continue; } r -= I_UP;
        transpose_item(P.in[I_WDN], D, 0, D, (bf16*)(ws + WS_WDN), FF, 0, 0, scr, r, lane);
    }
    { float* tab = (float*)(ws + WS_ROPE);
      for (int e = (vcu * NTHR + tid); e < 2056 * 64; e += G * NTHR) { const int p = e >> 6, i = e & 63; const int pos = p < 2048 ? p : 16384 + (p - 2048);
          const float inv = (float)pow(10000.0, -(double)i / 64.0); const float ang = (float)pos * inv;
          tab[2 * e] = (float)cos((double)ang); tab[2 * e + 1] = (float)sin((double)ang); } }
    __syncthreads();
    for (int m = gw; m < NT + NMEM; m += NGW) {
        if (m < NT) { const float* xr = m < NP ? P.in[I_XP] + (size_t)m * D : P.in[I_XS] + (size_t)(m - NP) * D;
            rms_row_bf16<true>(xr, P.in[I_GPM], (bf16*)(ws + WS_H) + (size_t)m * D, wga, (float*)(ws + WS_GAL) + (size_t)m * 16, lane); }
        else { const int r = m - NT; rms_row_bf16<false>(P.in[I_MEM] + (size_t)r * D, P.in[I_GMEM], (bf16*)(ws + WS_MB) + (size_t)r * D, wga, nullptr, lane); }
    }
}

__device__ __forceinline__ void row_phase(const float* xop, const float* xos, const float* t, const float* g1, float* xnew, const float* g2, bf16* hn, int vcu, int G) {
    int tid = threadIdx.x; asm volatile("" : "+v"(tid));
    const int lane = tid & 63, wave = __builtin_amdgcn_readfirstlane(tid >> 6);
    const int gw = vcu * NWAVES + wave, NGW = G * NWAVES;
    for (int m = gw; m < NT; m += NGW) {
        const float* xo = (xos && m >= NP) ? xos + (size_t)(m - NP) * D : xop + (size_t)m * D;
        f32x4 tv[4], xv[4]; float s = 0.f;
#pragma unroll
        for (int j = 0; j < 4; ++j) { tv[j] = ((const f32x4*)(t + (size_t)m * D))[lane + 64 * j]; xv[j] = ((const f32x4*)xo)[lane + 64 * j]; s += (tv[j].x * tv[j].x + tv[j].y * tv[j].y) + (tv[j].z * tv[j].z + tv[j].w * tv[j].w); }
        const float rs = 1.0f / sqrtf(wave_sum(s) * (1.f / D) + EPS);
        float s2 = 0.f;
#pragma unroll
        for (int j = 0; j < 4; ++j) { const f32x4 gg = ((const f32x4*)g1)[lane + 64 * j]; xv[j] = xv[j] + tv[j] * rs * gg; ((f32x4*)(xnew + (size_t)m * D))[lane + 64 * j] = xv[j];
            s2 += (xv[j].x * xv[j].x + xv[j].y * xv[j].y) + (xv[j].z * xv[j].z + xv[j].w * xv[j].w); }
        if (hn) {
            const float rs2 = 1.0f / sqrtf(wave_sum(s2) * (1.f / D) + EPS);
#pragma unroll
            for (int j = 0; j < 4; ++j) { const f32x4 gg = ((const f32x4*)g2)[lane + 64 * j]; const f32x4 o = xv[j] * rs2 * gg; u32x2 w; w.x = pk2(o.x, o.y); w.y = pk2(o.z, o.w); ((u32x2*)(hn + (size_t)m * D))[lane + 64 * j] = w; }
        }
    }
}


#define XB_TMO      128
#define XB_XCNT(j)  (256  + 64 * (j))
#define XB_XSUB(j)  (1280 + 64 * (j))
#define XB_XGEN(j)  (2304 + 64 * (j))
#define XB_TOP      3328
#define XB_TOPGEN   3392
#define XCD_BAR_WORDS 3456
#define XB_SPIN_CAP (1u << 22)
__device__ __forceinline__ unsigned xb_ld(unsigned* p)              { return __hip_atomic_load(p, __ATOMIC_RELAXED, __HIP_MEMORY_SCOPE_AGENT); }
__device__ __forceinline__ unsigned xb_add(unsigned* p, unsigned v) { return __hip_atomic_fetch_add(p, v, __ATOMIC_RELAXED, __HIP_MEMORY_SCOPE_AGENT); }
__device__ __forceinline__ unsigned xb_xcc_id() { return (unsigned)__builtin_amdgcn_s_getreg((3 << 11) | 20) & 0xFu; }
#define XB_SPIN(cond, bar) do { unsigned _sp = 0; while (cond) { __builtin_amdgcn_s_sleep(1); \
    if ((++_sp & 255u) == 0u) { if (xb_ld(&(bar)[XB_TMO])) break; if (_sp > XB_SPIN_CAP) { atomicAdd(&(bar)[XB_TMO], 1u); break; } } } } while (0)
struct XcdBarrier { unsigned* bar; unsigned x; volatile LAS unsigned* st; };
__device__ __forceinline__ XcdBarrier xcd_barrier_post(unsigned* bar, volatile LAS unsigned* st) {
    XcdBarrier b; b.bar = bar; b.x = xb_xcc_id(); b.st = st;
    if (threadIdx.x == 0) (void)xb_add(&bar[XB_XCNT(b.x)], 1u);
    return b;
}
__device__ __forceinline__ void xcd_barrier_complete(unsigned* bar, unsigned x, unsigned& nloc, unsigned& nx) {
    const unsigned G = gridDim.x * gridDim.y * gridDim.z;
    unsigned sum, cnt, mine, sp = 0u;
    for (;;) {
        sum = 0u; cnt = 0u; mine = 0u;
#pragma unroll
        for (unsigned j = 0; j < 16; ++j) { const unsigned c = xb_ld(&bar[XB_XCNT(j)]); sum += c; cnt += (c > 0u) ? 1u : 0u; mine = (j == x) ? c : mine; }
        if (sum == G) break;
        __builtin_amdgcn_s_sleep(1);
        if ((++sp & 255u) == 0u) { if (xb_ld(&bar[XB_TMO])) break; if (sp > XB_SPIN_CAP) { atomicAdd(&bar[XB_TMO], 1u); break; } }
    }
    nloc = mine > 0u ? mine : 1u; nx = cnt > 0u ? cnt : 1u;
}
__device__ __forceinline__ void xcd_barrier(const XcdBarrier& b) {
    asm volatile("s_waitcnt vmcnt(0)" ::: "memory");
    __syncthreads();
    if (threadIdx.x == 0) {
        unsigned* bar = b.bar;
        __builtin_amdgcn_s_waitcnt(0);
        unsigned nloc = b.st[0], nx = b.st[1];
        if (nloc == 0u) { xcd_barrier_complete(bar, b.x, nloc, nx); b.st[0] = nloc; b.st[1] = nx; }
        const unsigned old = xb_add(&bar[XB_XSUB(b.x)], 1u);
        const unsigned gen = old / nloc;
        if (old + 1u == (gen + 1u) * nloc) {
            __builtin_amdgcn_fence(__ATOMIC_RELEASE, "agent");
            asm volatile("s_waitcnt vmcnt(0)" ::: "memory");
            const unsigned og = xb_add(&bar[XB_TOP], 1u);
            const unsigned tg = og / nx;
            if (og + 1u == (tg + 1u) * nx) xb_add(&bar[XB_TOPGEN], 1u);
            else XB_SPIN(xb_ld(&bar[XB_TOPGEN]) == tg, bar);
            __builtin_amdgcn_fence(__ATOMIC_ACQUIRE, "agent");
            xb_add(&bar[XB_XGEN(b.x)], 1u);
            asm volatile("s_waitcnt vmcnt(0)" ::: "memory");
        } else {
            XB_SPIN(xb_ld(&bar[XB_XGEN(b.x)]) == gen, bar);
            __builtin_amdgcn_fence(__ATOMIC_ACQUIRE, "agent");
            asm volatile("s_waitcnt vmcnt(0)" ::: "memory");
        }
    }
    __syncthreads();
}

constexpr int SG_SLAB = 16384;
static_assert(8 * SG_SLAB <= MISC_OFF, "small-gemm LDS");
struct SEpiF32 { float* O; int ldc;
    __device__ __forceinline__ void operator()(int row, int col, float v) const { O[(size_t)row * ldc + col] = v; } };
struct SEpiBf16 { bf16* O; int ldc;
    __device__ __forceinline__ void operator()(int row, int col, float v) const { O[(size_t)row * ldc + col] = f2bf(v); } };
template <class SEpi>
__device__ __forceinline__ void small_gemm(LAS unsigned char* lds, const bf16* A, const bf16* Bt, int K, int N, int vcu, int G, const SEpi& E) {
    int tid = threadIdx.x; asm volatile("" : "+v"(tid));
    const int lane = tid & 63, w = __builtin_amdgcn_readfirstlane(tid >> 6), r32 = lane & 31, hh = lane >> 5;
    const int nun = 16 * (N / 64), kw = K / 8;
    for (int u = vcu; u < nun; u += G) {
        const int tm = u & 15, tn = u >> 4;
        f32x16 acc[2][2];
#pragma unroll
        for (int i = 0; i < 2; ++i)
#pragma unroll
            for (int j = 0; j < 2; ++j)
#pragma unroll
                for (int rg = 0; rg < 16; ++rg) acc[i][j][rg] = 0.f;
        const bf16* Ap = A + (size_t)(tm * 64 + r32) * K + w * kw + 8 * hh;
        const bf16* Bp = Bt + (size_t)(tn * 64 + r32) * K + w * kw + 8 * hh;
        const size_t r32k = (size_t)32 * K;
        for (int k0 = 0; k0 < kw; k0 += 128) {
            bf16x8 a0[8], a1[8], b0[8], b1[8];
#pragma unroll
            for (int ks = 0; ks < 8; ++ks) { a0[ks] = *(const bf16x8*)(Ap + k0 + ks * 16); a1[ks] = *(const bf16x8*)(Ap + r32k + k0 + ks * 16); b0[ks] = *(const bf16x8*)(Bp + k0 + ks * 16); b1[ks] = *(const bf16x8*)(Bp + r32k + k0 + ks * 16); }
#pragma unroll
            for (int ks = 0; ks < 8; ++ks) { acc[0][0] = MFMA32(a0[ks], b0[ks], acc[0][0]); acc[0][1] = MFMA32(a0[ks], b1[ks], acc[0][1]); acc[1][0] = MFMA32(a1[ks], b0[ks], acc[1][0]); acc[1][1] = MFMA32(a1[ks], b1[ks], acc[1][1]); }
        }
#pragma unroll
        for (int i = 0; i < 2; ++i)
#pragma unroll
            for (int j = 0; j < 2; ++j)
#pragma unroll
                for (int g = 0; g < 4; ++g) *(LAS f32x4*)(lds + w * SG_SLAB + ((((i * 2 + j) * 4 + g) * 64 + lane) * 16)) = (f32x4){acc[i][j][4 * g], acc[i][j][4 * g + 1], acc[i][j][4 * g + 2], acc[i][j][4 * g + 3]};
        __syncthreads();
#pragma unroll
        for (int q = 0; q < 2; ++q) { const int p = tid + 512 * q, ij = p >> 8, g = (p >> 6) & 3, ln = p & 63;
            f32x4 s = (f32x4){0.f, 0.f, 0.f, 0.f};
#pragma unroll
            for (int ww = 0; ww < 8; ++ww) s += *(const LAS f32x4*)(lds + ww * SG_SLAB + p * 16);
            const int row = tm * 64 + 32 * (ij >> 1) + 8 * g + 4 * (ln >> 5), col = tn * 64 + 32 * (ij & 1) + (ln & 31);
            E(row, col, s.x); E(row + 1, col, s.y); E(row + 2, col, s.z); E(row + 3, col, s.w); }
        __syncthreads();
    }
}

constexpr int L_QT = 0, L_KT = 17408, L_KHT = 34816, L_EBL = 53248, L_IMG = 53760;
constexpr int QT_STR = 272, KHT_STR = 144, P_STR = 144, V_STR = 576;
constexpr int LA_RQ = 53760, LA_RK = 70144, LA_GAL = 86528, LA_PRE = 90624, LA_END = 92672;
constexpr int LB_P = 53760, LB_V = 62976, LB_END = 99840;
constexpr int REC_BYTES = L_IMG, REC_CHUNKS = REC_BYTES / 16  , SREC_BYTES = 6912, SREC_CHUNKS = 432;
constexpr size_t WS_REC = WS_T, WS_SREC = WS_H;
static_assert(WS_REC + (size_t)2048 * REC_BYTES <= WS_END && (size_t)1024 * SREC_BYTES <= 34 * MiB, "record space");
__device__ __forceinline__ int dperm(int d) { return (d & ~12) | ((d & 4) << 1) | ((d & 8) >> 1); }
#define LAUNDER(x) asm volatile("" : "+v"(x))
__device__ __forceinline__ u32x4 mask4(u32x4 v, int t, int Tv) { const unsigned m = (unsigned)((t - Tv) >> 31); return (u32x4){v.x & m, v.y & m, v.z & m, v.w & m}; }

template <int BR>
__device__ __forceinline__ void prep_unit(const Params& P, LAS unsigned char* lds, int h, int rowc, int Tv, int pidx, unsigned char* rec, bool compact) {
    const int tid0 = threadIdx.x;
    const bf16* Z = (const bf16*)(P.ws + WS_Z);
    const float* GAL = (const float*)(P.ws + WS_GAL);
    const float* ROPE = (const float*)(P.ws + WS_ROPE);
    const int cq = (BR == 0 ? ZC_GQ : ZC_RQ) + h * 128, ck = (BR == 0 ? ZC_GK : ZC_RK) + h * 128;
    const float scale = 0.08838834764831845f;
    const float lg = BR == 1 ? log1pf(-exp2f(-5.0f - (float)h)) : 0.f;
    __syncthreads();
    {
        int tid = tid0; LAUNDER(tid); const int pd = tid & 127, ptq = tid >> 7;
        const int pp = dperm(pd);
        const bool work = (16 * ptq) < Tv;
        unsigned kh[8];
#pragma unroll
        for (int i = 0; i < 8; ++i) kh[i] = 0u;
        if (BR == 0) {
            float la[16];
#pragma unroll
            for (int i = 0; i < 16; ++i) la[i] = 0.f;
            if (work) {
                float w2r[16];
#pragma unroll
                for (int r = 0; r < 16; ++r) w2r[r] = P.in[I_WA2][r * 512 + h * 128 + pd];
                const float bias = P.in[I_BA][h * 128 + pd];
#pragma unroll
                for (int i = 0; i < 16; ++i) { const int t = 16 * ptq + i;
                    float x = bias;
#pragma unroll
                    for (int q4 = 0; q4 < 4; ++q4) { const f32x4 g = *(const LAS f32x4*)(lds + LA_GAL + t * 64 + q4 * 16); x += g.x * w2r[4 * q4] + g.y * w2r[4 * q4 + 1] + g.z * w2r[4 * q4 + 2] + g.w * w2r[4 * q4 + 3]; }
                    const float ls = fminf(x, 0.f) - __logf(1.0f + __expf(-fabsf(x)));
                    la[i] = t < Tv ? ls * (1.0f / 16.0f) : 0.f; }
#pragma unroll
                for (int i = 1; i < 16; ++i) la[i] += la[i - 1];
            }
            ((LAS float*)(lds + LA_PRE))[ptq * 128 + pd] = la[15];
            __syncthreads();
            float base = 0.f, btot = 0.f;
#pragma unroll
            for (int q = 0; q < 4; ++q) { const float v = ((const LAS float*)(lds + LA_PRE))[q * 128 + pd]; btot += v; if (q < ptq) base += v; }
            if (ptq == 0) ((LAS float*)(lds + L_EBL))[pd] = __expf(btot);
            if (work) {
#pragma unroll
                for (int i = 0; i < 16; ++i) { const int t = 16 * ptq + i; const float bt = base + la[i];
                    const float qv = bf2f(*(const LAS unsigned short*)(lds + LA_RQ + t * 256 + pd * 2)), kv = bf2f(*(const LAS unsigned short*)(lds + LA_RK + t * 256 + pd * 2));
                    *(LAS unsigned short*)(lds + L_QT + t * QT_STR + pp * 2) = f2bf(qv * (__expf(bt) * scale));
                    *(LAS unsigned short*)(lds + L_KT + t * QT_STR + pp * 2) = f2bf(kv * __expf(-bt));
                    const float k3 = kv * __expf(btot - bt);
                    if (i & 1) kh[i >> 1] = (kh[i >> 1] & 0xffffu) | ((unsigned)f2bf(k3) << 16); else kh[i >> 1] = (unsigned)f2bf(k3); }
            }
        } else {
            const float btot = (float)Tv * lg;
            if (ptq == 0) ((LAS float*)(lds + L_EBL))[pd] = __expf(btot);
            if (work) {
                const int fi = pd & 63; const float sgn = pd < 64 ? -1.f : 1.f;
#pragma unroll
                for (int i = 0; i < 16; ++i) { const int t = 16 * ptq + i;
                    const float bt = (float)(t < Tv ? t + 1 : Tv) * lg;
                    const int pi = pidx + (t < Tv ? t : 0);
                    const float cs = ROPE[(size_t)(pi * 64 + fi) * 2], sn = ROPE[(size_t)(pi * 64 + fi) * 2 + 1];
                    const float q1 = bf2f(*(const LAS unsigned short*)(lds + LA_RQ + t * 256 + pd * 2)), q2 = bf2f(*(const LAS unsigned short*)(lds + LA_RQ + t * 256 + (pd ^ 64) * 2));
                    const float k1 = bf2f(*(const LAS unsigned short*)(lds + LA_RK + t * 256 + pd * 2)), k2 = bf2f(*(const LAS unsigned short*)(lds + LA_RK + t * 256 + (pd ^ 64) * 2));
                    const float qv = q1 * cs + sgn * q2 * sn, kv = k1 * cs + sgn * k2 * sn;
                    *(LAS unsigned short*)(lds + L_QT + t * QT_STR + pp * 2) = f2bf(qv * __expf(bt));
                    *(LAS unsigned short*)(lds + L_KT + t * QT_STR + pp * 2) = f2bf(kv * (__expf(-bt) * scale));
                    const float k3 = kv * (__expf(btot - bt) * scale);
                    if (i & 1) kh[i >> 1] = (kh[i >> 1] & 0xffffu) | ((unsigned)f2bf(k3) << 16); else kh[i >> 1] = (unsigned)f2bf(k3); }
            }
        }
        if (work) {
            *(LAS u32x4*)(lds + L_KHT + pd * KHT_STR + ptq * 32) = (u32x4){kh[0], kh[1], kh[2], kh[3]};
            *(LAS u32x4*)(lds + L_KHT + pd * KHT_STR + ptq * 32 + 16) = (u32x4){kh[4], kh[5], kh[6], kh[7]};
        }
    }
    __syncthreads();
    { int tid = tid0; LAUNDER(tid);
      if (!compact) {
#pragma unroll
          for (int i = 0; i < 7; ++i) { const int ch = tid + 512 * i; if (ch < REC_CHUNKS) *(u32x4*)(rec + (size_t)ch * 16) = *(const LAS u32x4*)(lds + ch * 16); }
      } else if (tid < SREC_CHUNKS) {
          int src;
          if (tid < 136) src = L_QT + tid * 16; else if (tid < 272) src = L_KT + (tid - 136) * 16; else if (tid < 400) src = L_KHT + (tid - 272) * KHT_STR; else src = L_EBL + (tid - 400) * 16;
          *(u32x4*)(rec + (size_t)tid * 16) = *(const LAS u32x4*)(lds + src);
      } }
}
__device__ __forceinline__ void phase2a(const Params& P, LAS unsigned char* lds, int vcu, int G) {
    const int tid0 = threadIdx.x;
    const bf16* Z = (const bf16*)(P.ws + WS_Z);
    const float* GAL = (const float*)(P.ws + WS_GAL);
#define P2A_UNIT(u_, sfx) \
    const bool prompt##sfx = (u_) < 2048; const int v##sfx = prompt##sfx ? (u_) : (u_) - 2048; \
    const int c##sfx = prompt##sfx ? (v##sfx & 31) : 0, br##sfx = prompt##sfx ? ((v##sfx >> 5) & 1) : (v##sfx & 1), h##sfx = prompt##sfx ? ((v##sfx >> 6) & 3) : ((v##sfx >> 1) & 3), b##sfx = prompt##sfx ? (v##sfx >> 8) : (v##sfx >> 3); \
    const int rowc##sfx = prompt##sfx ? b##sfx * 2048 + c##sfx * 64 : NP + b##sfx * 8, Tv##sfx = prompt##sfx ? 64 : 8, pidx##sfx = prompt##sfx ? c##sfx * 64 : 2048;
    u32x4 rq[2], rk[2], rg;
#define P2A_LOAD(u_) do { P2A_UNIT(u_, L) (void)pidxL; int tid = tid0; LAUNDER(tid); \
    const int cq_ = (brL == 0 ? ZC_GQ : ZC_RQ) + hL * 128, ck_ = (brL == 0 ? ZC_GK : ZC_RK) + hL * 128; \
    _Pragma("unroll") for (int i = 0; i < 2; ++i) { const int ch = tid + 512 * i, t = ch >> 4, c8 = ch & 15; const int tt = t < TvL ? t : 0; \
        rq[i] = *(const u32x4*)(Z + (size_t)(rowcL + tt) * NZ + cq_ + c8 * 8); rk[i] = *(const u32x4*)(Z + (size_t)(rowcL + tt) * NZ + ck_ + c8 * 8); } \
    { const int t = (tid >> 2) & 63, c4 = tid & 3; const int tt = t < TvL ? t : 0; rg = *(const u32x4*)(GAL + (size_t)(rowcL + tt) * 16 + c4 * 4); } } while (0)
    if (vcu < 3072) P2A_LOAD(vcu);
    for (int u = vcu; u < 2048 + 1024; u += G) {
        P2A_UNIT(u, )
        { int tid = tid0; LAUNDER(tid);
#pragma unroll
          for (int i = 0; i < 2; ++i) { const int ch = tid + 512 * i, t = ch >> 4, c8 = ch & 15;
              *(LAS u32x4*)(lds + LA_RQ + t * 256 + c8 * 16) = mask4(rq[i], t, Tv); *(LAS u32x4*)(lds + LA_RK + t * 256 + c8 * 16) = mask4(rk[i], t, Tv); }
          if (tid < 256) *(LAS u32x4*)(lds + LA_GAL + tid * 16) = mask4(rg, tid >> 2, Tv); }
        asm volatile("" ::: "memory");
        { const int un = u + G < 3072 ? u + G : u; P2A_LOAD(un); }
        unsigned char* rec = prompt ? P.ws + WS_REC + (size_t)v * REC_BYTES : P.ws + WS_SREC + (size_t)v * SREC_BYTES;
        if (br == 0) prep_unit<0>(P, lds, h, rowc, Tv, pidx, rec, !prompt); else prep_unit<1>(P, lds, h, rowc, Tv, pidx, rec, !prompt);
        __syncthreads();
    }
#undef P2A_LOAD
#undef P2A_UNIT
}

constexpr int LC_P = 53760, LC_V = 62976, VQ_STR = 192, LC_RED = 75264, LC_END = LC_RED + 65536;
static_assert(LC_END <= MISC_OFF, "P2b LDS map");
__device__ __forceinline__ void chain_run(const Params& P, LAS unsigned char* lds, int vcu, int G, bool sample) {
    const int tid0 = threadIdx.x, w = __builtin_amdgcn_readfirstlane(tid0 >> 6), nt = w & 1, T = w >> 1;
    const bf16* Z = (const bf16*)(P.ws + WS_Z);
    bf16* MG = (bf16*)(P.ws + WS_MG);
    const int Tv = sample ? 8 : 64;
    const int nsteps = sample ? (4096 - vcu + G - 1) / G : (vcu < 256 ? 32 : 0);
    const int nchunks = sample ? SREC_CHUNKS : REC_CHUNKS;
    const bool probe = (P.pad & 0xff00) != 0;
#define STEP_UNIT(stp_, br_, b_, h_, qd_, rowc_, rec_) \
    const int uu_##stp_ = sample ? vcu + (stp_) * G : vcu; \
    const int qd_ = uu_##stp_ & 3, ch_##stp_ = uu_##stp_ >> 2, br_ = ch_##stp_ & 1, h_ = (ch_##stp_ >> 1) & 3, b_ = ch_##stp_ >> 3; \
    const int rowc_ = sample ? NP + b_ * 8 : b_ * 2048 + (stp_) * 64; \
    const unsigned char* rec_ = sample ? P.ws + WS_SREC + (size_t)ch_##stp_ * SREC_BYTES : P.ws + WS_REC + (size_t)(ch_##stp_ * 32 + ((P.pad & 0x100) ? 0 : (stp_))) * REC_BYTES;
    f32x16 S, Sn;
#pragma unroll
    for (int rg = 0; rg < 16; ++rg) { S[rg] = 0.f; Sn[rg] = 0.f; }
    u32x4 pr[7], pv;
    u32x2 ost[2];
    ost[0] = (u32x2){0u, 0u}; ost[1] = (u32x2){0u, 0u};
#define P2B_PREFETCH(stp_) do { STEP_UNIT(stp_, brp_, bp_, hp_, qdp_, rowp_, recp_) \
    int tid = tid0; LAUNDER(tid); \
    _Pragma("unroll") for (int i = 0; i < 7; ++i) { const int ch = tid + 512 * i; const int cl = ch < nchunks ? ch : nchunks - 1; pr[i] = *(const u32x4*)(recp_ + (size_t)cl * 16); } \
    { const int t = tid >> 3, c8 = tid & 7; const int tt = t < Tv ? t : 0; \
      pv = *(const u32x4*)(Z + (size_t)(rowp_ + tt) * NZ + (brp_ == 0 ? ZC_GV : ZC_RV) + hp_ * 256 + 64 * qdp_ + c8 * 8); } \
    if (sample) { const float* s0_ = (brp_ == 0 ? P.in[I_SG] : P.in[I_SR]); const int r32_ = tid & 31, hh_ = (tid >> 5) & 1; \
        _Pragma("unroll") for (int rg = 0; rg < 16; ++rg) Sn[rg] = s0_[((size_t)(bp_ * 4 + hp_) * 128 + 32 * T + crow(rg, hh_)) * 256 + 64 * qdp_ + 32 * nt + r32_]; } } while (0)
#define P2B_STORE_O(stp_) do { STEP_UNIT(stp_, brs_, bs_, hs_, qds_, rows_, recs_) (void)recs_; \
    int ln_ = tid0 & 63; LAUNDER(ln_); const int r32_ = ln_ & 31, hh_ = ln_ >> 5; const int t = 32 * (T >> 1) + r32_; \
    if (t < Tv) { bf16* orow = MG + (size_t)(rows_ + t) * 2048 + brs_ * 1024 + hs_ * 256 + 64 * qds_ + 32 * nt + 16 * (T & 1) + 4 * hh_; \
        *(u32x2*)(orow) = ost[0]; *(u32x2*)(orow + 8) = ost[1]; } } while (0)
    if (nsteps > 0) P2B_PREFETCH(0);
    for (int c = 0; c < nsteps; ++c) {
        STEP_UNIT(c, br, b, h, qd, rowc, rec) (void)rec; (void)rowc;
        if (sample) {
#pragma unroll
            for (int rg = 0; rg < 16; ++rg) S[rg] = Sn[rg]; }
        { int tid = tid0; LAUNDER(tid);
          if (!sample) {
#pragma unroll
              for (int i = 0; i < 7; ++i) { const int ch = tid + 512 * i; *(LAS u32x4*)(lds + ch * 16) = pr[i]; }
          } else if (tid < SREC_CHUNKS) {
              int dst;
              if (tid < 136) dst = L_QT + tid * 16; else if (tid < 272) dst = L_KT + (tid - 136) * 16; else if (tid < 400) dst = L_KHT + (tid - 272) * KHT_STR; else dst = L_EBL + (tid - 400) * 16;
              *(LAS u32x4*)(lds + dst) = pr[0];
          }
          { const int t = tid >> 3, c8 = tid & 7; *(LAS u32x4*)(lds + LC_V + t * VQ_STR + c8 * 16) = mask4(pv, t, Tv); } }
        asm volatile("" ::: "memory");
        { const int cn = c + 1 < nsteps ? c + 1 : c; P2B_PREFETCH(cn); }
        if (c > 0) { const int cp = c - 1; P2B_STORE_O(cp); }
        __syncthreads();
        int lane = tid0 & 63; LAUNDER(lane); const int r32 = lane & 31, hh = lane >> 5;
        if (!(P.pad & 0x1000)) {
            const int fr = lane & 15, fq = lane >> 4, tb = w >> 1;
#pragma unroll
            for (int j = 0; j < 2; ++j) { const int sb = 2 * (w & 1) + j;
                pg8::f32x4 acc = (pg8::f32x4){0.f, 0.f, 0.f, 0.f};
                if (sb <= tb) {
#pragma unroll
                    for (int ks = 0; ks < 4; ++ks) {
                        const bf16x8 kf = *(const LAS bf16x8*)(lds + L_KT + (16 * sb + fr) * QT_STR + (32 * ks + 8 * fq) * 2);
                        const bf16x8 qf = *(const LAS bf16x8*)(lds + L_QT + (16 * tb + fr) * QT_STR + (32 * ks + 8 * fq) * 2);
                        acc = __builtin_amdgcn_mfma_f32_16x16x32_bf16(kf, qf, acc, 0, 0, 0);
                    }
                }
                const int tg = 16 * tb + fr;
                float v[4];
#pragma unroll
                for (int e = 0; e < 4; ++e) { const int sg = 16 * sb + 4 * fq + e; v[e] = sg <= tg ? acc[e] : 0.f; }
                u32x2 o; o.x = pk2(v[0], v[1]); o.y = pk2(v[2], v[3]);
                *(LAS u32x2*)(lds + LC_P + tg * P_STR + (16 * sb + 4 * fq) * 2) = o;
            }
        }
        bf16x8 vf[4], qf[2][2], kf[4]; f32x4 eb[4];
        { const int g16 = (lane >> 4) & 1, i16 = lane & 15, q_ = i16 >> 2, p_ = i16 & 3;
          const LAS unsigned char* vb = lds + LC_V + (8 * hh + q_) * VQ_STR + (32 * nt + 16 * g16 + 4 * p_) * 2;
#pragma unroll
          for (int ks = 0; ks < 4; ++ks) vf[ks] = cat8(vtr(vb + (16 * ks) * VQ_STR), vtr(vb + (16 * ks + 4) * VQ_STR)); }
#pragma unroll
        for (int s = 0; s < 2; ++s)
#pragma unroll
            for (int mi = 0; mi < 2; ++mi) qf[s][mi] = *(const LAS bf16x8*)(lds + L_QT + (32 * mi + r32) * QT_STR + (32 * T + 16 * s + 8 * hh) * 2);
#pragma unroll
        for (int ks = 0; ks < 4; ++ks) kf[ks] = *(const LAS bf16x8*)(lds + L_KHT + (32 * T + r32) * KHT_STR + (16 * ks + 8 * hh) * 2);
#pragma unroll
        for (int g = 0; g < 4; ++g) eb[g] = *(const LAS f32x4*)(lds + L_EBL + (32 * T + 8 * g + 4 * hh) * 4);
        f32x16 OT[2];
#pragma unroll
        for (int mi = 0; mi < 2; ++mi) {
#pragma unroll
            for (int rg = 0; rg < 16; ++rg) OT[mi][rg] = 0.f; }
#pragma unroll
        for (int s = 0; s < 2; ++s) { const bf16x8 sa = pack8(S, s);
#pragma unroll
            for (int mi = 0; mi < 2; ++mi) OT[mi] = MFMA32(sa, qf[s][mi], OT[mi]); }
#pragma unroll
        for (int g = 0; g < 4; ++g) { S[4 * g] *= eb[g].x; S[4 * g + 1] *= eb[g].y; S[4 * g + 2] *= eb[g].z; S[4 * g + 3] *= eb[g].w; }
#pragma unroll
        for (int ks = 0; ks < 4; ++ks) S = MFMA32(kf[ks], vf[ks], S);
        __syncthreads();
        { const bf16x8 vT = T == 0 ? vf[0] : T == 1 ? vf[1] : T == 2 ? vf[2] : vf[3];
          const bf16x8 pf1 = *(const LAS bf16x8*)(lds + LC_P + (32 + r32) * P_STR + (16 * T + 8 * hh) * 2);
          OT[1] = MFMA32(vT, pf1, OT[1]);
          if (T < 2) { const bf16x8 pf0 = *(const LAS bf16x8*)(lds + LC_P + r32 * P_STR + (16 * T + 8 * hh) * 2); OT[0] = MFMA32(vT, pf0, OT[0]); } }
        if (!(P.pad & 0x800))
#pragma unroll
        for (int mi = 0; mi < 2; ++mi)
#pragma unroll
            for (int g = 0; g < 4; ++g) *(LAS f32x4*)(lds + LC_RED + ((((nt * 4 + T) * 2 + mi) * 4 + g) * 64 + lane) * 16) = (f32x4){OT[mi][4 * g], OT[mi][4 * g + 1], OT[mi][4 * g + 2], OT[mi][4 * g + 3]};
        __syncthreads();
        if (!(P.pad & 0x800)) { const int mir = T >> 1, g0 = 2 * (T & 1);
#pragma unroll
          for (int gg = 0; gg < 2; ++gg) { f32x4 a = (f32x4){0.f, 0.f, 0.f, 0.f};
#pragma unroll
              for (int Tp = 0; Tp < 4; ++Tp) a += *(const LAS f32x4*)(lds + LC_RED + ((((nt * 4 + Tp) * 2 + mir) * 4 + g0 + gg) * 64 + lane) * 16);
              ost[gg].x = pk2(a.x, a.y); ost[gg].y = pk2(a.z, a.w); } }
        if (sample) {
            float* so = (probe ? (float*)(P.ws + WS_Z) : P.out) + (br == 0 ? O_SGS : O_SRS);
#pragma unroll
            for (int rg = 0; rg < 16; ++rg) so[((size_t)(b * 4 + h) * 128 + 32 * T + crow(rg, hh)) * 256 + 64 * qd + 32 * nt + r32] = S[rg];
        }
    }
    if (nsteps > 0) {
        { const int cl = nsteps - 1; P2B_STORE_O(cl); }
        if (!sample) { STEP_UNIT(0, br, b, h, qd, rowc, rec) (void)rec; (void)rowc;
            int t0 = tid0; LAUNDER(t0); const int r32 = t0 & 31, hh = (t0 >> 5) & 1;
            float* so = (probe ? (float*)(P.ws + WS_Z) : P.out) + (br == 0 ? O_SGP : O_SRP);
#pragma unroll
            for (int rg = 0; rg < 16; ++rg) so[((size_t)(b * 4 + h) * 128 + 32 * T + crow(rg, hh)) * 256 + 64 * qd + 32 * nt + r32] = S[rg]; }
    }
#undef P2B_PREFETCH
#undef P2B_STORE_O
#undef STEP_UNIT
}
__device__ __forceinline__ void phase2b(const Params& P, LAS unsigned char* lds, int vcu, int G) {
    if (!(P.pad & 0x400)) chain_run(P, lds, vcu, G, false);
    __syncthreads();
    for (int i = threadIdx.x; i < L_IMG / 16; i += NTHR) *(LAS u32x4*)(lds + i * 16) = (u32x4){0u, 0u, 0u, 0u};
    __syncthreads();
    if (!(P.pad & 0x200)) chain_run(P, lds, vcu, G, true);
}

__device__ __forceinline__ void phase2c(const Params& P, int vcu, int G) {
    int tid = threadIdx.x; LAUNDER(tid);
    const int lane = tid & 63, wave = __builtin_amdgcn_readfirstlane(tid >> 6);
    const int gw = vcu * NWAVES + wave, NGW = G * NWAVES;
    const bf16* Z = (const bf16*)(P.ws + WS_Z); const bf16* MG = (const bf16*)(P.ws + WS_MG); bf16* MO = (bf16*)(P.ws + WS_H);
    for (int row = gw; row < NT; row += NGW) {
        const bf16* mrow = MG + (size_t)row * 2048 + 4 * lane;
        const bf16* zr = Z + (size_t)row * NZ + 4 * lane;
        u32x2 og[4], orr[4], g1[4], g2[4], r1[4], r2[4]; f32x4 hg[4], hr[4];
#pragma unroll
        for (int h = 0; h < 4; ++h) { og[h] = *(const u32x2*)(mrow + h * 256); orr[h] = *(const u32x2*)(mrow + 1024 + h * 256);
            g1[h] = *(const u32x2*)(zr + ZC_GR + h * 256); g2[h] = *(const u32x2*)(zr + ZC_GA + h * 256); r1[h] = *(const u32x2*)(zr + ZC_RG + h * 256); r2[h] = *(const u32x2*)(zr + ZC_GB + h * 256);
            hg[h] = *(const f32x4*)(P.in[I_GGLA] + h * 256 + 4 * lane); hr[h] = *(const f32x4*)(P.in[I_GRET] + h * 256 + 4 * lane); }
#pragma unroll
        for (int h = 0; h < 4; ++h) {
            float a[4] = {bflo(og[h].x), bfhi(og[h].x), bflo(og[h].y), bfhi(og[h].y)};
            float r[4] = {bflo(orr[h].x), bfhi(orr[h].x), bflo(orr[h].y), bfhi(orr[h].y)};
            const float mu = wave_sum((r[0] + r[1]) + (r[2] + r[3])) * (1.0f / 256.0f);
#pragma unroll
            for (int e = 0; e < 4; ++e) r[e] -= mu;
            const float qa = wave_sum((a[0] * a[0] + a[1] * a[1]) + (a[2] * a[2] + a[3] * a[3]));
            const float qr = wave_sum((r[0] * r[0] + r[1] * r[1]) + (r[2] * r[2] + r[3] * r[3]));
            const float sa = __builtin_amdgcn_rsqf(qa * (1.0f / 256.0f) + EPS), sr = __builtin_amdgcn_rsqf(qr * (1.0f / 256.0f) + EPS);
            const float ga1[4] = {bflo(g1[h].x), bfhi(g1[h].x), bflo(g1[h].y), bfhi(g1[h].y)}, ga2[4] = {bflo(g2[h].x), bfhi(g2[h].x), bflo(g2[h].y), bfhi(g2[h].y)};
            const float gr1[4] = {bflo(r1[h].x), bfhi(r1[h].x), bflo(r1[h].y), bfhi(r1[h].y)}, gr2[4] = {bflo(r2[h].x), bfhi(r2[h].x), bflo(r2[h].y), bfhi(r2[h].y)};
            const float wg[4] = {hg[h].x, hg[h].y, hg[h].z, hg[h].w}, wr[4] = {hr[h].x, hr[h].y, hr[h].z, hr[h].w};
            float res[4];
#pragma unroll
            for (int e = 0; e < 4; ++e) {
                const float yg = a[e] * sa * wg[e] * ga1[e] * __builtin_amdgcn_rcpf((1.0f + __expf(-ga1[e])) * (1.0f + __expf(-ga2[e])));
                const float yr = r[e] * sr * wr[e] * gr1[e] * __builtin_amdgcn_rcpf((1.0f + __expf(-gr1[e])) * (1.0f + __expf(-gr2[e])));
                res[e] = yg + yr; }
            u32x2 w; w.x = pk2(res[0], res[1]); w.y = pk2(res[2], res[3]);
            *(u32x2*)(MO + (size_t)row * D + h * 256 + 4 * lane) = w;
        }
    }
}

constexpr int A_K = 0, AK_STR = 272, A_V = 34816, AV_STR = 320, A_END = 34816 + 40960;
#define P6_STAGE(src_, mt_, ch_, lbase_, lstr_) do { \
    _Pragma("unroll") for (int i = 0; i < 4; ++i) { const int ch = tid + 512 * i, m = ch >> 4, c8 = ch & 15; \
        const size_t off = (((size_t)b * 256 + 128 * (mt_) + m) * 4 + h) * 256 + 128 * (ch_) + c8 * 8; \
        u32x4 v; \
        if (F32SRC) { const f32x4 a = *(const f32x4*)((const float*)(src_) + off), c = *(const f32x4*)((const float*)(src_) + off + 4); v.x = pk2(a.x, a.y); v.y = pk2(a.z, a.w); v.z = pk2(c.x, c.y); v.w = pk2(c.z, c.w); } \
        else v = *(const u32x4*)((const bf16*)(src_) + off); \
        *(LAS u32x4*)(lds + (lbase_) + m * (lstr_) + c8 * 16) = v; } } while (0)

template <bool F32SRC>
__device__ __forceinline__ void attn_unit(const Params& P, LAS unsigned char* lds, int b, int h, int row0, int nq, const void* Kp, const void* Vp) {
    int tid = threadIdx.x; asm volatile("" : "+v"(tid));
    const int lane = tid & 63, w = __builtin_amdgcn_readfirstlane(tid >> 6), r32 = lane & 31, hh = lane >> 5;
    const bf16* Q = (const bf16*)(P.ws + WS_Q); bf16* Oo = (bf16*)(P.ws + WS_O);
    const bool active = (32 * w) < nq;
    const int t = 32 * w + r32; const bool tok = t < nq;
    f32x16 sT[8];
#pragma unroll
    for (int i = 0; i < 8; ++i)
#pragma unroll
        for (int rg = 0; rg < 16; ++rg) sT[i][rg] = 0.f;
#pragma unroll
    for (int dh = 0; dh < 2; ++dh) {
        bf16x8 qf[8];
#pragma unroll
        for (int ks = 0; ks < 8; ++ks) qf[ks] = *(const bf16x8*)(Q + (size_t)(row0 + (tok ? t : 0)) * D + h * 256 + 128 * dh + 16 * ks + 8 * hh);
#pragma unroll
        for (int mt = 0; mt < 2; ++mt) {
            P6_STAGE(Kp, mt, dh, A_K, AK_STR);
            __syncthreads();
            if (active) {
#pragma unroll
                for (int mi = 0; mi < 4; ++mi)
#pragma unroll
                    for (int ks = 0; ks < 8; ++ks) { const bf16x8 kf = *(const LAS bf16x8*)(lds + A_K + (32 * mi + r32) * AK_STR + (16 * ks + 8 * hh) * 2);
                        sT[4 * mt + mi] = MFMA32(kf, qf[ks], sT[4 * mt + mi]); }
            }
            __syncthreads();
        }
    }
    float mx = -3.0e38f;
#pragma unroll
    for (int i = 0; i < 8; ++i)
#pragma unroll
        for (int rg = 0; rg < 16; ++rg) mx = fmaxf(mx, sT[i][rg]);
    mx = fmaxf(mx, __shfl_xor(mx, 32));
    const float c2 = 0.0625f * 1.4426950408889634f;
    float sum = 0.f;
    bf16x8 pf[8][2];
#pragma unroll
    for (int i = 0; i < 8; ++i) {
#pragma unroll
        for (int rg = 0; rg < 16; ++rg) { const float p = __builtin_amdgcn_exp2f((sT[i][rg] - mx) * c2); sT[i][rg] = p; sum += p; }
        pf[i][0] = pack8(sT[i], 0); pf[i][1] = pack8(sT[i], 1); }
    sum += __shfl_xor(sum, 32);
    const float rinv = 1.0f / sum;
    const int g16 = (lane >> 4) & 1, i16 = lane & 15, q_ = i16 >> 2, p_ = i16 & 3;
#pragma unroll
    for (int nh = 0; nh < 2; ++nh) {
        f32x16 oT[4];
#pragma unroll
        for (int i = 0; i < 4; ++i)
#pragma unroll
            for (int rg = 0; rg < 16; ++rg) oT[i][rg] = 0.f;
#pragma unroll
        for (int mt = 0; mt < 2; ++mt) {
            P6_STAGE(Vp, mt, nh, A_V, AV_STR);
            __syncthreads();
            if (active) {
#pragma unroll
                for (int mi = 0; mi < 4; ++mi)
#pragma unroll
                    for (int s = 0; s < 2; ++s) {
                        const bf16x8 pb = pf[4 * mt + mi][s];
#pragma unroll
                        for (int nt = 0; nt < 4; ++nt) {
                            const LAS unsigned char* vb = lds + A_V + (32 * mi + 16 * s + 4 * hh + q_) * AV_STR + (32 * nt + 16 * g16 + 4 * p_) * 2;
                            const bf16x8 va = cat8(vtr(vb), vtr(vb + 8 * AV_STR));
                            oT[nt] = MFMA32(va, pb, oT[nt]);
                        }
                    }
            }
            __syncthreads();
        }
        if (tok) {
            bf16* orow = Oo + (size_t)(row0 + t) * D + h * 256 + 128 * nh;
#pragma unroll
            for (int nt = 0; nt < 4; ++nt)
#pragma unroll
                for (int g = 0; g < 4; ++g) { u32x2 o; o.x = pk2(oT[nt][4 * g] * rinv, oT[nt][4 * g + 1] * rinv); o.y = pk2(oT[nt][4 * g + 2] * rinv, oT[nt][4 * g + 3] * rinv);
                    *(u32x2*)(orow + 32 * nt + 8 * g + 4 * hh) = o; }
        }
    }
}
__device__ __forceinline__ void phase6(const Params& P, LAS unsigned char* lds, int vcu, int G) {
    for (int u = vcu; u < 256 + 512; u += G) {
        if (u < 256) { const int qb = u & 7, h = (u >> 3) & 3, b = u >> 5; attn_unit<false>(P, lds, b, h, b * 2048 + qb * 256, 256, P.ws + WS_MKB, P.ws + WS_MVB); }
        else { const int v = u - 256, h = v & 3, b = v >> 2; attn_unit<true>(P, lds, b, h, NP + b * 8, 8, P.in[I_CK], P.in[I_CV]); }
    }
}

__global__ void __launch_bounds__(NTHR, 2) mega_fwd(Params P) {
    extern __shared__ __attribute__((aligned(16))) unsigned char lds_raw[];
    LAS unsigned char* lds = (LAS unsigned char*)lds_raw;
    cg::grid_group grid = cg::this_grid();
    if (threadIdx.x < 16) ((LAS unsigned*)(lds + MISC_OFF))[threadIdx.x] = 0u;
    __syncthreads();
    const XcdBarrier xbar = xcd_barrier_post((unsigned*)(P.ws + WS_CTL) + 1024, (volatile LAS unsigned*)(lds + MISC_OFF));
    const int G = gridDim.x; const int bx = blockIdx.x; const int vcu = (G % 8 == 0) ? (bx % 8) * (G / 8) + bx / 8 : bx;
    unsigned char* ws = P.ws;
    const int stop = P.stop_after;
    if (stop < 0) grid.sync();
#define SEAM(k) do { if (stop <= (k)) return; xcd_barrier(xbar); } while (0)
#ifndef NO_P0
    phase0(P, lds, vcu, G);
#endif
    SEAM(0);
    { pg8::Gemm g{(const bf16*)(ws + WS_H), (const bf16*)(ws + WS_WIN), NT, NZ, D}; pg8::StaticOrder S; S.init(NT, NZ, G, bx);
      pg8::EpiBf16<0> E{(bf16*)(ws + WS_Z), NZ};
      pg8::gemm_phase<pg8::EpiBf16<0>, pg8::StaticOrder, true, true>(lds, g, S, E); }
    { pg8::Gemm g{(const bf16*)(ws + WS_MB), (const bf16*)(ws + WS_WXKV), NMEM, 2 * D, D}; pg8::StaticOrder S; S.init(NMEM, 2 * D, G, (bx >= G / 2) ? bx - G / 2 : -1);
      pg8::EpiKV E{P.out + O_MK, P.out + O_MV, (bf16*)(ws + WS_MKB), (bf16*)(ws + WS_MVB)};
      pg8::gemm_phase<pg8::EpiKV, pg8::StaticOrder, true, true>(lds, g, S, E); }
    SEAM(1);
#ifndef NO_P2
    phase2a(P, lds, vcu, G);
    if (stop == 2 && (P.pad & 0xff) == 1) return;
    xcd_barrier(xbar);
    phase2b(P, lds, vcu, G);
    if (stop == 2 && (P.pad & 0xff) == 2) return;
    xcd_barrier(xbar);
    phase2c(P, vcu, G);
#endif
    SEAM(2);
    { pg8::Gemm g{(const bf16*)(ws + WS_H), (const bf16*)(ws + WS_WMO), NP, D, D}; pg8::StaticOrder S; S.init(NP, D, G, bx);
      pg8::EpiF32 E{(float*)(ws + WS_T), D};
      pg8::gemm_phase<pg8::EpiF32, pg8::StaticOrder, true, true>(lds, g, S, E); }
    small_gemm(lds, (const bf16*)(ws + WS_H) + (size_t)NP * D, (const bf16*)(ws + WS_WMO), D, D, vcu, G, SEpiF32{(float*)(ws + WS_T) + (size_t)NP * D, D});
    SEAM(3);
    row_phase(P.in[I_XP], P.in[I_XS], (const float*)(ws + WS_T), P.in[I_GQM], P.yout, P.in[I_GPX], (bf16*)(ws + WS_H), vcu, G);
    SEAM(4);
    { pg8::Gemm g{(const bf16*)(ws + WS_H), (const bf16*)(ws + WS_WXQ), NP, D, D}; pg8::StaticOrder S; S.init(NP, D, G, bx);
      pg8::EpiBf16<0> E{(bf16*)(ws + WS_Q), D};
      pg8::gemm_phase<pg8::EpiBf16<0>, pg8::StaticOrder, true, true>(lds, g, S, E); }
    small_gemm(lds, (const bf16*)(ws + WS_H) + (size_t)NP * D, (const bf16*)(ws + WS_WXQ), D, D, vcu, G, SEpiBf16{(bf16*)(ws + WS_Q) + (size_t)NP * D, D});
    SEAM(5);
#ifndef NO_P6
    phase6(P, lds, vcu, G);
#endif
    SEAM(6);
    { pg8::Gemm g{(const bf16*)(ws + WS_O), (const bf16*)(ws + WS_WXO), NP, D, D}; pg8::StaticOrder S; S.init(NP, D, G, bx);
      pg8::EpiF32 E{(float*)(ws + WS_T), D};
      pg8::gemm_phase<pg8::EpiF32, pg8::StaticOrder, true, true>(lds, g, S, E); }
    small_gemm(lds, (const bf16*)(ws + WS_O) + (size_t)NP * D, (const bf16*)(ws + WS_WXO), D, D, vcu, G, SEpiF32{(float*)(ws + WS_T) + (size_t)NP * D, D});
    SEAM(7);
    row_phase(P.yout, nullptr, (const float*)(ws + WS_T), P.in[I_GQX], P.yout, P.in[I_GPF], (bf16*)(ws + WS_H), vcu, G);
    SEAM(8);
    { pg8::Gemm g{(const bf16*)(ws + WS_H), (const bf16*)(ws + WS_WUP), NT, FF, D}; pg8::StaticOrder S; S.init(NT, FF, G, bx);
      pg8::EpiBf16<2> E{(bf16*)(ws + WS_U), FF};
      pg8::gemm_phase<pg8::EpiBf16<2>, pg8::StaticOrder, true, true>(lds, g, S, E); }
    SEAM(9);
    { pg8::Gemm g{(const bf16*)(ws + WS_U), (const bf16*)(ws + WS_WDN), NP, D, FF}; pg8::StaticOrder S; S.init(NP, D, G, bx);
      pg8::EpiF32 E{(float*)(ws + WS_T), D};
      pg8::gemm_phase<pg8::EpiF32, pg8::StaticOrder, true, true>(lds, g, S, E); }
    small_gemm(lds, (const bf16*)(ws + WS_U) + (size_t)NP * FF, (const bf16*)(ws + WS_WDN), FF, D, vcu, G, SEpiF32{(float*)(ws + WS_T) + (size_t)NP * D, D});
    SEAM(10);
    row_phase(P.yout, nullptr, (const float*)(ws + WS_T), P.in[I_GQF], P.yout, nullptr, nullptr, vcu, G);
#undef SEAM
}
}


#ifndef HYBRID
#define HYBRID 0
#endif
extern "C" void kernel_launch(void* const* d_in, const int* in_sizes, int n_in, void* d_out, int out_size, void* d_ws, size_t ws_size, hipStream_t stream) {
    static int grid = 0;
    if (grid == 0) {
        if (n_in != 26 || out_size != (int)mk::O_END || ws_size < mk::WS_END) { fprintf(stderr, "kernel_launch: unexpected sizes n_in %d out %d ws %zu\n", n_in, out_size, ws_size); grid = -1; return; }
        int dev = 0, cus = 0, per_cu = 0;
        if (hipGetDevice(&dev) != hipSuccess || hipDeviceGetAttribute(&cus, hipDeviceAttributeMultiprocessorCount, dev) != hipSuccess) { grid = -1; return; }
        if (hipFuncSetAttribute((const void*)mk::mega_fwd, hipFuncAttributeMaxDynamicSharedMemorySize, mk::LDS_BYTES) != hipSuccess) { fprintf(stderr, "kernel_launch: hipFuncSetAttribute failed\n"); grid = -1; return; }
        if (hipOccupancyMaxActiveBlocksPerMultiprocessor(&per_cu, (const void*)mk::mega_fwd, mk::NTHR, mk::LDS_BYTES) != hipSuccess || per_cu < 1) { fprintf(stderr, "kernel_launch: occupancy query says %d\n", per_cu); grid = -1; (void)hipGetLastError(); return; }
        grid = cus;
    }
    if (grid < 0) return;
    if (hipMemsetAsync((char*)d_ws + mk::WS_CTL, 0, 65536, stream) != hipSuccess) { fprintf(stderr, "kernel_launch: memset failed\n"); return; }
    mk::Params p{};
    for (int i = 0; i < 26; ++i) p.in[i] = (const float*)d_in[i];
    p.out = (float*)d_out; p.ws = (unsigned char*)d_ws; p.yout = (float*)d_out + mk::O_YP; p.stop_after = 100; p.pad = 0;
    void* args[] = {&p};
    hipError_t e = hipLaunchCooperativeKernel((const void*)mk::mega_fwd, dim3(grid), dim3(mk::NTHR), args, mk::LDS_BYTES, stream);
    if (e != hipSuccess) fprintf(stderr, "cooperative launch failed: %s (grid %d)\n", hipGetErrorString(e), grid);
#ifdef PROBE_STOP
    if (hipMemsetAsync((char*)d_ws + mk::WS_CTL, 0, 65536, stream) != hipSuccess) return;
    mk::Params p2 = p; p2.stop_after = PROBE_STOP;
#ifdef PROBE_SUB
    p2.pad = PROBE_SUB;
#endif
#ifdef PROBE_FLAGS
    p2.pad |= PROBE_FLAGS;
#endif
    p2.yout = (float*)((unsigned char*)d_ws + mk::WS_MG);
    void* args2[] = {&p2};
    e = hipLaunchCooperativeKernel((const void*)mk::mega_fwd, dim3(grid), dim3(mk::NTHR), args2, mk::LDS_BYTES, stream);
    if (e != hipSuccess) fprintf(stderr, "cooperative launch 2 failed: %s\n", hipGetErrorString(e));
#endif
}
```
